# Optimizing an MI355X kernel written in HIP

```python
import numpy as np
import jax
import jax.numpy as jnp
from jax import lax

D_MODEL = 2048
BATCH = 8
SEQ = 4096
DEPTH = 2

RMS_EPS = 1e-6
MIX_WIDTH = D_MODEL

S5_WIDTH = D_MODEL // 4
S5_GROUP_CH = 16
S5_GROUPS = S5_WIDTH // S5_GROUP_CH
S5_STATE = 64

SSD_WIDTH = MIX_WIDTH - S5_WIDTH
SSD_HEADDIM = 64
SSD_HEADS = SSD_WIDTH // SSD_HEADDIM
SSD_GROUPS = 4
SSD_HPG = SSD_HEADS // SSD_GROUPS
SSD_STATE = 128
SSD_CONV = 4
SSD_CHUNK = 128
SSD_CONV_CH = SSD_WIDTH + 2 * SSD_GROUPS * SSD_STATE

SWA_HEADDIM = 64
SWA_WIDTH = MIX_WIDTH // 2
SWA_HEADS = SWA_WIDTH // SWA_HEADDIM
SWA_KV_HEADS = 4
SWA_HPG = SWA_HEADS // SWA_KV_HEADS
SWA_WINDOW = 128

GLA_VALUE_WIDTH = MIX_WIDTH - SWA_WIDTH
GLA_KEY_WIDTH = GLA_VALUE_WIDTH // 2
GLA_HEADS = 4
GLA_HEAD_K = GLA_KEY_WIDTH // GLA_HEADS
GLA_HEAD_V = GLA_VALUE_WIDTH // GLA_HEADS
GLA_GATE_RANK = 16
GLA_GATE_NORMALIZER = 16.0
GLA_CHUNK = 64

FFN_HIDDEN = -(-(8 * D_MODEL) // (3 * 256)) * 256

IN0_SIZES = (S5_WIDTH, SSD_WIDTH, SSD_CONV_CH, SSD_HEADS)
IN1_SIZES = (SWA_HEADS * SWA_HEADDIM, SWA_KV_HEADS * SWA_HEADDIM, SWA_KV_HEADS * SWA_HEADDIM,
             GLA_KEY_WIDTH, GLA_KEY_WIDTH, GLA_VALUE_WIDTH, GLA_VALUE_WIDTH, GLA_GATE_RANK)

kernel_name = "hybrid_s5_ssd_swa_gla_block"


def split_cols(t, sizes):
    return jnp.split(t, np.cumsum(sizes)[:-1].tolist(), axis=-1)


def rmsnorm(t, w):
    tf = t.astype(jnp.float32)
    y = tf * lax.rsqrt(jnp.mean(tf * tf, axis=-1, keepdims=True) + RMS_EPS)
    return (y * w.astype(jnp.float32)).astype(t.dtype)


def swiglu(t, w1, w3, w2):
    return (jax.nn.silu(t @ w1) * (t @ w3)) @ w2


def causal_depthwise_conv(t, w, bias):
    k_w, ch = w.shape
    out = lax.conv_general_dilated(t, w[:, None, :].astype(t.dtype), window_strides=(1,),
                                   padding=[(k_w - 1, 0)],
                                   dimension_numbers=('NWC', 'WIO', 'NWC'),
                                   feature_group_count=ch)
    return out + bias


def s5_mixer(u, A_re, A_im, log_dt, B_re, B_im, C_re, C_im, D, glu_w, glu_b):
    f32 = jnp.float32
    b, L, _ = u.shape
    uf = u.astype(f32)
    ug = uf.reshape(b, L, S5_GROUPS, S5_GROUP_CH)
    a_re, a_im = A_re.astype(f32), A_im.astype(f32)
    dt = jnp.exp(log_dt.astype(f32))[:, None]
    mag = jnp.exp(a_re * dt)
    ab_re = mag * jnp.cos(a_im * dt)
    ab_im = mag * jnp.sin(a_im * dt)
    e_re, e_im = ab_re - 1.0, ab_im
    den = a_re * a_re + a_im * a_im
    coef_re = (e_re * a_re + e_im * a_im) / den
    coef_im = (e_im * a_re - e_re * a_im) / den
    bu_re = jnp.einsum('blgc,gnc->blgn', ug, B_re.astype(f32))
    bu_im = jnp.einsum('blgc,gnc->blgn', ug, B_im.astype(f32))
    x_re = coef_re * bu_re - coef_im * bu_im
    x_im = coef_re * bu_im + coef_im * bu_re
    a_re_seq = jnp.broadcast_to(ab_re, (1, L) + ab_re.shape)
    a_im_seq = jnp.broadcast_to(ab_im, (1, L) + ab_im.shape)

    def combine(e1, e2):
        a1r, a1i, b1r, b1i = e1
        a2r, a2i, b2r, b2i = e2
        return (a2r * a1r - a2i * a1i,
                a2r * a1i + a2i * a1r,
                a2r * b1r - a2i * b1i + b2r,
                a2r * b1i + a2i * b1r + b2i)

    _, _, h_re, h_im = lax.associative_scan(combine, (a_re_seq, a_im_seq, x_re, x_im), axis=1)
    y = (jnp.einsum('blgn,gcn->blgc', h_re, C_re.astype(f32))
         - jnp.einsum('blgn,gcn->blgc', h_im, C_im.astype(f32)))
    y = y.reshape(b, L, S5_WIDTH) + D.astype(f32) * uf
    y = jax.nn.gelu(y)
    y = y * jax.nn.sigmoid(y @ glu_w.astype(f32) + glu_b.astype(f32))
    return y.astype(u.dtype)


def ssd_mixer(z, xbc, dt_raw, conv_w, conv_b, dt_bias, A_log, D, norm_w):
    f32 = jnp.float32
    b, L, _ = z.shape
    nc, Q = L // SSD_CHUNK, SSD_CHUNK
    G, R, P, N = SSD_GROUPS, SSD_HPG, SSD_HEADDIM, SSD_STATE
    xbc = jax.nn.silu(causal_depthwise_conv(xbc, conv_w, conv_b)).astype(f32)
    xs, Bm, Cm = split_cols(xbc, (SSD_WIDTH, G * N, G * N))
    xs = xs.reshape(b, nc, Q, G, R, P)
    Bm = Bm.reshape(b, nc, Q, G, N)
    Cm = Cm.reshape(b, nc, Q, G, N)
    dt = jax.nn.softplus(dt_raw.astype(f32) + dt_bias.astype(f32)).reshape(b, nc, Q, G, R)
    A = -jnp.exp(A_log.astype(f32)).reshape(G, R)
    cs = jnp.moveaxis(jnp.cumsum(dt * A, axis=2), 2, -1)
    xdt = xs * dt[..., None]
    pos = jnp.arange(Q)
    causal = pos[:, None] >= pos[None, :]
    seg = jnp.where(causal, cs[..., :, None] - cs[..., None, :], -jnp.inf)
    cb = jnp.einsum('bclgn,bcsgn->bcgls', Cm, Bm)
    y_diag = jnp.einsum('bcgls,bcgrls,bcsgrp->bclgrp', cb, jnp.exp(seg), xdt)
    cs_last = cs[..., -1:]
    states = jnp.einsum('bclgn,bcgrl,bclgrp->bcgrpn', Bm, jnp.exp(cs_last - cs), xdt)
    chunk_decay = jnp.exp(cs_last[..., 0])

    def step(S, inp):
        dec, st = inp
        return dec[..., None, None] * S + st, S

    S0 = jnp.zeros((b, G, R, P, N), f32)
    _, S_in = lax.scan(step, S0, (jnp.moveaxis(chunk_decay, 1, 0), jnp.moveaxis(states, 1, 0)))
    S_in = jnp.moveaxis(S_in, 0, 1)
    y_off = jnp.einsum('bclgn,bcgrpn,bcgrl->bclgrp', Cm, S_in, jnp.exp(cs))
    y = y_diag + y_off + D.astype(f32).reshape(G, R)[..., None] * xs
    y = y.reshape(b, L, SSD_WIDTH) * jax.nn.silu(z.astype(f32))
    y = rmsnorm(y.reshape(b, L, G, SSD_WIDTH // G), norm_w.reshape(G, SSD_WIDTH // G))
    return y.reshape(b, L, SSD_WIDTH).astype(z.dtype)


def swa_sink_attention(q, k, v, q_norm_w, k_norm_w, sinks):
    f32 = jnp.float32
    b, L, _ = q.shape
    blk = SWA_WINDOW
    nb = L // blk
    H, KV, R, HD = SWA_HEADS, SWA_KV_HEADS, SWA_HPG, SWA_HEADDIM
    q = rmsnorm(q.reshape(b, L, H, HD), q_norm_w).reshape(b, nb, blk, KV, R, HD)
    k = rmsnorm(k.reshape(b, L, KV, HD), k_norm_w).reshape(b, nb, blk, KV, HD)
    v = v.reshape(b, nb, blk, KV, HD)

    def with_prev(t):
        prev = jnp.concatenate([jnp.zeros_like(t[:, :1]), t[:, :-1]], axis=1)
        return jnp.concatenate([prev, t], axis=2)

    kw, vw = with_prev(k), with_prev(v)
    s = jnp.einsum('bnqhrd,bnkhd->bnhrqk', q, kw).astype(f32) * (HD ** -0.5)
    qpos = jnp.arange(blk)[:, None]
    kpos = jnp.arange(2 * blk)[None, :] - blk
    rel = qpos - kpos
    blk_start = (jnp.arange(nb) * blk)[:, None, None]
    valid = (rel >= 0) & (rel < SWA_WINDOW) & (blk_start + kpos >= 0)
    s = jnp.where(valid[None, :, None, None], s, -jnp.inf)
    sink = sinks.astype(f32).reshape(KV, R)[None, None, :, :, None, None]
    m = jnp.maximum(jnp.max(s, axis=-1, keepdims=True), sink)
    p = jnp.exp(s - m)
    denom = jnp.sum(p, axis=-1, keepdims=True) + jnp.exp(sink - m)
    o = jnp.einsum('bnhrqk,bnkhd->bnqhrd', (p / denom).astype(vw.dtype), vw)
    return o.reshape(b, L, SWA_WIDTH)


def gla_mixer(q, k, v, gout, g_lr, gate_w2, gate_b, norm_w):
    f32 = jnp.float32
    b, L, _ = q.shape
    C = GLA_CHUNK
    nc = L // C
    H, DK, DV = GLA_HEADS, GLA_HEAD_K, GLA_HEAD_V
    q = q.astype(f32).reshape(b, nc, C, H, DK) * (DK ** -0.5)
    k = k.astype(f32).reshape(b, nc, C, H, DK)
    v = v.astype(f32).reshape(b, nc, C, H, DV)
    gk = jax.nn.log_sigmoid((g_lr @ gate_w2 + gate_b).astype(f32)) / GLA_GATE_NORMALIZER
    bc = jnp.cumsum(gk.reshape(b, nc, C, H, DK), axis=2)
    q_t = q * jnp.exp(bc)
    k_t = k * jnp.exp(-bc)
    pos = jnp.arange(C)
    causal = pos[:, None] >= pos[None, :]
    att = jnp.where(causal, jnp.einsum('bclhd,bcshd->bchls', q_t, k_t), 0.0)
    o_intra = jnp.einsum('bchls,bcshv->bclhv', att, v)
    b_last = bc[:, :, -1:]
    chunk_kv = jnp.einsum('bclhd,bclhv->bchdv', k * jnp.exp(b_last - bc), v)
    chunk_decay = jnp.exp(b_last[:, :, 0])

    def step(S, inp):
        dec, kv = inp
        return dec[..., None] * S + kv, S

    S0 = jnp.zeros((b, H, DK, DV), f32)
    _, S_in = lax.scan(step, S0, (jnp.moveaxis(chunk_decay, 1, 0), jnp.moveaxis(chunk_kv, 1, 0)))
    S_in = jnp.moveaxis(S_in, 0, 1)
    o = o_intra + jnp.einsum('bclhd,bchdv->bclhv', q_t, S_in)
    o = rmsnorm(o, norm_w).reshape(b, L, GLA_VALUE_WIDTH)
    return (o * jax.nn.silu(gout.astype(f32))).astype(gout.dtype)


def setup_inputs(seed: int = 0) -> dict:
    key = jax.random.key(seed)
    ks = iter(jax.random.split(key, 48))
    f32 = jnp.float32

    def nrm(shape, scale):
        return jax.random.normal(next(ks), shape, f32) * scale

    def gain(shape):
        return 1.0 + nrm(shape, 0.01)

    def log_uniform(shape, lo, hi):
        u = jax.random.uniform(next(ks), shape, f32)
        return u * (np.log(hi) - np.log(lo)) + np.log(lo)

    x = nrm((BATCH, SEQ, D_MODEL), 1.0)
    norm0_mix = gain((D_MODEL,))
    w_in0 = nrm((D_MODEL, sum(IN0_SIZES)), D_MODEL ** -0.5)
    s5_A_re = -0.5 + nrm((S5_GROUPS, S5_STATE), 0.01)
    s5_A_im = jnp.pi * jnp.arange(S5_STATE, dtype=f32)[None, :] + nrm((S5_GROUPS, S5_STATE), 0.01)
    s5_log_dt = log_uniform((S5_GROUPS,), 1e-3, 1e-1)
    s5_B_re = nrm((S5_GROUPS, S5_STATE, S5_GROUP_CH), (2 * S5_GROUP_CH) ** -0.5)
    s5_B_im = nrm((S5_GROUPS, S5_STATE, S5_GROUP_CH), (2 * S5_GROUP_CH) ** -0.5)
    s5_C_re = nrm((S5_GROUPS, S5_GROUP_CH, S5_STATE), S5_STATE ** -0.5)
    s5_C_im = nrm((S5_GROUPS, S5_GROUP_CH, S5_STATE), S5_STATE ** -0.5)
    s5_D = nrm((S5_WIDTH,), 1.0)
    s5_glu_w = nrm((S5_WIDTH, S5_WIDTH), S5_WIDTH ** -0.5)
    s5_glu_b = nrm((S5_WIDTH,), 0.01)
    ssd_conv_w = nrm((SSD_CONV, SSD_CONV_CH), SSD_CONV ** -0.5)
    ssd_conv_b = nrm((SSD_CONV_CH,), 0.01)
    dt0 = jnp.exp(log_uniform((SSD_HEADS,), 1e-3, 1e-1))
    ssd_dt_bias = dt0 + jnp.log(-jnp.expm1(-dt0))
    ssd_A_log = jnp.log(jax.random.uniform(next(ks), (SSD_HEADS,), f32, 1.0, 16.0))
    ssd_D = gain((SSD_HEADS,))
    ssd_norm_w = gain((SSD_WIDTH,))
    w_out0 = nrm((MIX_WIDTH, D_MODEL), MIX_WIDTH ** -0.5)
    norm0_ffn = gain((D_MODEL,))
    ffn0_w1 = nrm((D_MODEL, FFN_HIDDEN), D_MODEL ** -0.5)
    ffn0_w3 = nrm((D_MODEL, FFN_HIDDEN), D_MODEL ** -0.5)
    ffn0_w2 = nrm((FFN_HIDDEN, D_MODEL), FFN_HIDDEN ** -0.5)
    norm1_mix = gain((D_MODEL,))
    w_in1 = nrm((D_MODEL, sum(IN1_SIZES)), D_MODEL ** -0.5)
    swa_q_norm = gain((SWA_HEADDIM,))
    swa_k_norm = gain((SWA_HEADDIM,))
    swa_sinks = nrm((SWA_HEADS,), 0.5)
    gla_gate_w2 = nrm((GLA_GATE_RANK, GLA_KEY_WIDTH), GLA_GATE_RANK ** -0.5)
    gla_gate_b = nrm((GLA_KEY_WIDTH,), 0.01)
    gla_norm_w = gain((GLA_HEAD_V,))
    w_out1 = nrm((MIX_WIDTH, D_MODEL), MIX_WIDTH ** -0.5)
    norm1_ffn = gain((D_MODEL,))
    ffn1_w1 = nrm((D_MODEL, FFN_HIDDEN), D_MODEL ** -0.5)
    ffn1_w3 = nrm((D_MODEL, FFN_HIDDEN), D_MODEL ** -0.5)
    ffn1_w2 = nrm((FFN_HIDDEN, D_MODEL), FFN_HIDDEN ** -0.5)
    return {
        'x': x,
        'norm0_mix': norm0_mix, 'w_in0': w_in0,
        's5_A_re': s5_A_re, 's5_A_im': s5_A_im, 's5_log_dt': s5_log_dt,
        's5_B_re': s5_B_re, 's5_B_im': s5_B_im, 's5_C_re': s5_C_re, 's5_C_im': s5_C_im,
        's5_D': s5_D, 's5_glu_w': s5_glu_w, 's5_glu_b': s5_glu_b,
        'ssd_conv_w': ssd_conv_w, 'ssd_conv_b': ssd_conv_b, 'ssd_dt_bias': ssd_dt_bias,
        'ssd_A_log': ssd_A_log, 'ssd_D': ssd_D, 'ssd_norm_w': ssd_norm_w,
        'w_out0': w_out0, 'norm0_ffn': norm0_ffn,
        'ffn0_w1': ffn0_w1, 'ffn0_w3': ffn0_w3, 'ffn0_w2': ffn0_w2,
        'norm1_mix': norm1_mix, 'w_in1': w_in1,
        'swa_q_norm': swa_q_norm, 'swa_k_norm': swa_k_norm, 'swa_sinks': swa_sinks,
        'gla_gate_w2': gla_gate_w2, 'gla_gate_b': gla_gate_b, 'gla_norm_w': gla_norm_w,
        'w_out1': w_out1, 'norm1_ffn': norm1_ffn,
        'ffn1_w1': ffn1_w1, 'ffn1_w3': ffn1_w3, 'ffn1_w2': ffn1_w2,
    }


def reference(x, norm0_mix, w_in0, s5_A_re, s5_A_im, s5_log_dt, s5_B_re, s5_B_im, s5_C_re,
              s5_C_im, s5_D, s5_glu_w, s5_glu_b, ssd_conv_w, ssd_conv_b, ssd_dt_bias, ssd_A_log,
              ssd_D, ssd_norm_w, w_out0, norm0_ffn, ffn0_w1, ffn0_w3, ffn0_w2, norm1_mix, w_in1,
              swa_q_norm, swa_k_norm, swa_sinks, gla_gate_w2, gla_gate_b, gla_norm_w, w_out1,
              norm1_ffn, ffn1_w1, ffn1_w3, ffn1_w2):
    h = x
    for layer in range(DEPTH):
        if layer % 2 == 0:
            proj = rmsnorm(h, norm0_mix) @ w_in0
            u, z, xbc, dt_raw = split_cols(proj, IN0_SIZES)
            ya = s5_mixer(u, s5_A_re, s5_A_im, s5_log_dt, s5_B_re, s5_B_im, s5_C_re, s5_C_im,
                          s5_D, s5_glu_w, s5_glu_b)
            yb = ssd_mixer(z, xbc, dt_raw, ssd_conv_w, ssd_conv_b, ssd_dt_bias, ssd_A_log,
                           ssd_D, ssd_norm_w)
            h = h + (jnp.concatenate([ya, yb], axis=-1) @ w_out0).astype(h.dtype)
            h = h + swiglu(rmsnorm(h, norm0_ffn), ffn0_w1, ffn0_w3, ffn0_w2).astype(h.dtype)
        else:
            proj = rmsnorm(h, norm1_mix) @ w_in1
            qc, kc, vc, qd, kd, vd, gout, g_lr = split_cols(proj, IN1_SIZES)
            yc = swa_sink_attention(qc, kc, vc, swa_q_norm, swa_k_norm, swa_sinks)
            yd = gla_mixer(qd, kd, vd, gout, g_lr, gla_gate_w2, gla_gate_b, gla_norm_w)
            h = h + (jnp.concatenate([yc.astype(h.dtype), yd.astype(h.dtype)], axis=-1) @ w_out1).astype(h.dtype)
            h = h + swiglu(rmsnorm(h, norm1_ffn), ffn1_w1, ffn1_w3, ffn1_w2).astype(h.dtype)
    return h
```

```cpp
#include <hip/hip_runtime.h>
#include <cstdio>
#include <cstdint>
#include <cmath>
#include <type_traits>
#ifndef WM_IN
#define WM_IN 7
#endif
#ifndef WM_OUT
#define WM_OUT 7
#endif
#ifndef WM_FFN
#define WM_FFN 5
#endif
#ifndef AMANT
#define AMANT 7
#endif
#ifndef HMANT
#define HMANT 7
#endif
#ifndef XMANT
#define XMANT 7
#endif
namespace pg8 {
#define PG8_LAS __attribute__((address_space(3)))
typedef unsigned short bf16_t;
typedef short bf16x8 __attribute__((ext_vector_type(8)));
typedef float f32x4 __attribute__((ext_vector_type(4)));
typedef unsigned u32x4 __attribute__((ext_vector_type(4)));
constexpr int BM = 256, BK = 64, HALF = 128, HTB = HALF * BK * 2  , STAGE_BYTES = 8 * HTB, NXCD = 8, WGM = 8;

__host__ __device__ __forceinline__ int lds_byte(int r, int c) { const int st = (r >> 4) * 2 + (c >> 5), rr = r & 15, cc = c & 31, ob = rr * 64 + cc * 2; return st * 1024 + (ob ^ (((ob >> 9) & 1) << 5)); }
__host__ __device__ __forceinline__ void stage_rc(int b, int& R, int& C) { const int st = b / 1024, sb = b % 1024, swz = sb ^ (((sb >> 9) & 1) << 5); R = (st >> 1) * 16 + swz / 64; C = (st & 1) * 32 + (swz % 64) / 2; }
__host__ __device__ __forceinline__ int perm32(int rho) { const int n = rho >> 4, i = rho & 15; return 8 * (i >> 2) + 4 * n + (i & 3); }

struct Unit { int pm, pn; };
struct Gemm { const bf16_t* A; const bf16_t* Bt; int M, N, K; };

struct StaticOrder {
    int nM, nN, nwg, G, c;
    __host__ __device__ void init(int M, int N, int G_, int c_) { nM = M / BM; nN = N / BM; nwg = nM * nN; G = G_; c = c_; }
    __host__ __device__ bool next(int i, Unit& u) const {
        const long L = (long)i * G + c; if (L >= nwg) return false;
        int wgid = (int)L; { const int q = nwg / NXCD, r = nwg % NXCD, xcd = wgid % NXCD, off = wgid / NXCD; wgid = (xcd < r ? xcd * (q + 1) : r * (q + 1) + (xcd - r) * q) + off; }
        const int nig = WGM * nN, gid = wgid / nig, fm = gid * WGM, gsz = (nM - fm) < WGM ? (nM - fm) : WGM;
        u.pm = fm + ((wgid % nig) % gsz); u.pn = (wgid % nig) / gsz; return true;
    }
    __device__ __forceinline__ void a_ready(const Unit&) const {}
    __device__ __forceinline__ void done(const Unit&) const {}
};
__device__ __forceinline__ unsigned cvt_pk_bf16(float lo, float hi) { unsigned r; asm volatile("v_cvt_pk_bf16_f32 %0, %1, %2" : "=v"(r) : "v"(lo), "v"(hi)); return r; }
typedef unsigned long long ssq_t;
__device__ __forceinline__ float ssq_to_f(ssq_t q) { return ((float)(unsigned)(q >> 32) * 4294967296.0f + (float)(unsigned)q) * (1.0f / 16777216.0f); }
__device__ __forceinline__ ssq_t ssq_from_f(float s) { return (ssq_t)(s * 16777216.0f); }
struct RevOrder : StaticOrder {
    __host__ __device__ bool next(int i, Unit& u) const {
        const long L = (long)nwg - (long)G * (i + 1) + c; if (L < 0) return false;
        int wgid = (int)L; { const int q = nwg / NXCD, r = nwg % NXCD, xcd = wgid % NXCD, off = wgid / NXCD; wgid = (xcd < r ? xcd * (q + 1) : r * (q + 1) + (xcd - r) * q) + off; }
        const int nig = WGM * nN, gid = wgid / nig, fm = gid * WGM, gsz = (nM - fm) < WGM ? (nM - fm) : WGM;
        u.pm = fm + ((wgid % nig) % gsz); u.pn = (wgid % nig) / gsz; return true;
    }
};
template <int NB, class Base = StaticOrder> struct TailOrder : Base {
    const bf16_t* A; const bf16_t* Bt; float* out; int ldo, ncols, tail_pn; const ssq_t* ss; float inv_n, eps;
    __device__ __forceinline__ void done(const Unit& u) const {
        if (u.pn != tail_pn) return;
        const int lane = threadIdx.x & 63, wave = __builtin_amdgcn_readfirstlane(threadIdx.x >> 6), fr = lane & 15, fq = lane >> 4;
        const int row0 = u.pm * BM + wave * 32;
        f32x4 c[2][NB];
#pragma unroll
        for (int rb = 0; rb < 2; ++rb)
#pragma unroll
            for (int nb = 0; nb < NB; ++nb) c[rb][nb] = (f32x4){0.f, 0.f, 0.f, 0.f};
        const bf16_t* ap = A + (size_t)(row0 + fr) * 2048 + 8 * fq; const bf16_t* bp = Bt + (size_t)fr * 2048 + 8 * fq;
#pragma unroll 1
        for (int kc = 0; kc < 64; kc += 8) {
            bf16x8 a0[8], a1[8], bb[NB][8];
#pragma unroll
            for (int j = 0; j < 8; ++j) { a0[j] = *(const bf16x8*)(ap + 32 * (kc + j)); a1[j] = *(const bf16x8*)(ap + 16 * 2048 + 32 * (kc + j));
#pragma unroll
                for (int nb = 0; nb < NB; ++nb) bb[nb][j] = *(const bf16x8*)(bp + (size_t)nb * 16 * 2048 + 32 * (kc + j)); }
#pragma unroll
            for (int j = 0; j < 8; ++j)
#pragma unroll
                for (int nb = 0; nb < NB; ++nb) { c[0][nb] = __builtin_amdgcn_mfma_f32_16x16x32_bf16(a0[j], bb[nb][j], c[0][nb], 0, 0, 0); c[1][nb] = __builtin_amdgcn_mfma_f32_16x16x32_bf16(a1[j], bb[nb][j], c[1][nb], 0, 0, 0); }
        }
        float rsv[2][4];
#pragma unroll
        for (int rb = 0; rb < 2; ++rb)
#pragma unroll
            for (int e = 0; e < 4; ++e) rsv[rb][e] = ss ? __builtin_amdgcn_rsqf(ssq_to_f(ss[row0 + 16 * rb + 4 * fq + e]) * inv_n + eps) : 1.0f;
#pragma unroll
        for (int rb = 0; rb < 2; ++rb)
#pragma unroll
            for (int e = 0; e < 4; ++e) { const int row = row0 + 16 * rb + 4 * fq + e; const float rs = rsv[rb][e];
#pragma unroll
                for (int nb = 0; nb < NB; ++nb) { const int col = 16 * nb + fr; if (col < ncols) out[(size_t)row * ldo + col] = c[rb][nb][e] * rs; } }
    }
};
__device__ __forceinline__ float rnd_am(float f) { if (AMANT >= 7) return f; constexpr int sh = 16 + (7 - AMANT); unsigned u = __builtin_bit_cast(unsigned, f); u = (u + ((1u << (sh - 1)) - 1u) + ((u >> sh) & 1u)) & ~((1u << sh) - 1u); return __builtin_bit_cast(float, u); }
template <int MB> __device__ __forceinline__ float rnd_m(float f) { if (MB >= 7) return f; constexpr int sh = 16 + (7 - (MB >= 7 ? 7 : MB)); unsigned u = __builtin_bit_cast(unsigned, f); u = (u + ((1u << (sh - 1)) - 1u) + ((u >> sh) & 1u)) & ~((1u << sh) - 1u); return __builtin_bit_cast(float, u); }
__device__ __forceinline__ float fast_silu(float x) { return x * __builtin_amdgcn_rcpf(1.0f + __expf(-x)); }
__device__ __forceinline__ float fast_sigmoid(float x) { return __builtin_amdgcn_rcpf(1.0f + __expf(-x)); }

struct Route { unsigned long long off; int ld; int pad; };
struct EpiRoute {
    static constexpr bool PERM = true, AFTER_DRAIN = false;
    unsigned char* ws; const Route* tab;
    float* fbase; int fld, fcols, ftile;
    const ssq_t* ss; float inv_n, eps;
    __device__ __forceinline__ void operator()(const f32x4 (&acc)[2][2][4][2], const Unit& u, int wr, int wc, int fr, int fq) const {
        const int row0 = u.pm * BM + wr * 64 + fr;
        float rs[2][4];
#pragma unroll
        for (int ai = 0; ai < 2; ++ai)
#pragma unroll
            for (int m = 0; m < 4; ++m) rs[ai][m] = ss ? __builtin_amdgcn_rsqf(ssq_to_f(ss[row0 + ai * HALF + m * 16]) * inv_n + eps) : 1.0f;
        if (u.pn == ftile) {
            if (wc == 0) {
#pragma unroll
                for (int ai = 0; ai < 2; ++ai)
#pragma unroll
                    for (int m = 0; m < 4; ++m) { float* rowp = fbase + (size_t)(row0 + ai * HALF + m * 16) * fld;
#pragma unroll
                        for (int n = 0; n < 2; ++n) { const int col = 8 * fq + 4 * n; if (col < fcols) *(f32x4*)(rowp + col) = acc[ai][0][m][n] * rs[ai][m]; } }
            }
            return;
        }
        const Route r = tab[u.pn];
        bf16_t* base = (bf16_t*)(ws + r.off); const int ld = r.ld;
        const int col0 = wc * 32 + 8 * fq;
#pragma unroll
        for (int ai = 0; ai < 2; ++ai)
#pragma unroll
            for (int m = 0; m < 4; ++m) { bf16_t* rowp = base + (size_t)(row0 + ai * HALF + m * 16) * ld + col0;
#pragma unroll
                for (int bj = 0; bj < 2; ++bj) { const f32x4 v0 = acc[ai][bj][m][0] * rs[ai][m], v1 = acc[ai][bj][m][1] * rs[ai][m];
                    u32x4 w; w.x = cvt_pk_bf16(v0[0], v0[1]); w.y = cvt_pk_bf16(v0[2], v0[3]); w.z = cvt_pk_bf16(v1[0], v1[1]); w.w = cvt_pk_bf16(v1[2], v1[3]);
                    *(u32x4*)(rowp + bj * HALF) = w; } }
    }
};

template <bool F32IN, bool COPY = false> struct EpiResidBf {
    static_assert(!F32IN, "the residual stream is read from hb");
    static constexpr bool PERM = true, AFTER_DRAIN = false;
    const float* xin; bf16_t* hb; int ldc; ssq_t* ss; bf16_t* hb5;
    __device__ __forceinline__ void load_half(u32x4 (&w)[4][2], int rbase, int col0) const {
#pragma unroll
        for (int m = 0; m < 4; ++m) { const size_t off = (size_t)(rbase + m * 16) * ldc + col0;
#pragma unroll
            for (int bj = 0; bj < 2; ++bj) w[m][bj] = *(const u32x4*)(hb + off + bj * HALF); }
    }
    __device__ __forceinline__ void store_half(const u32x4 (&w)[4][2], const f32x4 (&acc)[2][4][2], float (&sv)[4], int rbase, int col0) const {
#pragma unroll
        for (int m = 0; m < 4; ++m) { const size_t off = (size_t)(rbase + m * 16) * ldc + col0;
            float s = 0.f;
#pragma unroll
            for (int bj = 0; bj < 2; ++bj) { const u32x4 q = w[m][bj];
                const f32x4 r0 = {__uint_as_float(q.x << 16), __uint_as_float(q.x & 0xffff0000u), __uint_as_float(q.y << 16), __uint_as_float(q.y & 0xffff0000u)};
                const f32x4 r1 = {__uint_as_float(q.z << 16), __uint_as_float(q.z & 0xffff0000u), __uint_as_float(q.w << 16), __uint_as_float(q.w & 0xffff0000u)};
                const f32x4 v0 = r0 + acc[bj][m][0], v1 = r1 + acc[bj][m][1];
                s += (v0[0] * v0[0] + v0[1] * v0[1]) + (v0[2] * v0[2] + v0[3] * v0[3]) + (v1[0] * v1[0] + v1[1] * v1[1]) + (v1[2] * v1[2] + v1[3] * v1[3]);
                u32x4 o; o.x = cvt_pk_bf16(v0[0], v0[1]); o.y = cvt_pk_bf16(v0[2], v0[3]); o.z = cvt_pk_bf16(v1[0], v1[1]); o.w = cvt_pk_bf16(v1[2], v1[3]);
                *(u32x4*)(hb + off + bj * HALF) = o;
                if (COPY) { u32x4 c; c.x = cvt_pk_bf16(rnd_m<XMANT>(v0[0]), rnd_m<XMANT>(v0[1])); c.y = cvt_pk_bf16(rnd_m<XMANT>(v0[2]), rnd_m<XMANT>(v0[3])); c.z = cvt_pk_bf16(rnd_m<XMANT>(v1[0]), rnd_m<XMANT>(v1[1])); c.w = cvt_pk_bf16(rnd_m<XMANT>(v1[2]), rnd_m<XMANT>(v1[3]));
                    *(u32x4*)(hb5 + off + bj * HALF) = c; } }
            s += __shfl_xor(s, 16); s += __shfl_xor(s, 32); sv[m] = s; }
    }
    __device__ __forceinline__ void add_half(const float (&sv)[4], int rbase, int fq) const {
#pragma unroll
        for (int m = 0; m < 4; ++m) if (fq == 0) (void)__hip_atomic_fetch_add(ss + rbase + m * 16, ssq_from_f(sv[m]), __ATOMIC_RELAXED, __HIP_MEMORY_SCOPE_AGENT);
    }
    __device__ __forceinline__ void operator()(const f32x4 (&acc)[2][2][4][2], const Unit& u, int wr, int wc, int fr, int fq) const {
        const int row0 = u.pm * BM + wr * 64 + fr, col0 = u.pn * BM + wc * 32 + 8 * fq;
        u32x4 w0[4][2], w1[4][2]; float s0[4], s1[4];
        load_half(w0, row0, col0);
        store_half(w0, acc[0], s0, row0, col0);
        load_half(w1, row0 + HALF, col0);
        add_half(s0, row0, fq);
        store_half(w1, acc[1], s1, row0 + HALF, col0);
        add_half(s1, row0 + HALF, fq);
    }
};
struct EpiResidOut {
    static constexpr bool PERM = true, AFTER_DRAIN = false;
    const bf16_t* hb; float* out; int ldc;
    __device__ __forceinline__ void operator()(const f32x4 (&acc)[2][2][4][2], const Unit& u, int wr, int wc, int fr, int fq) const {
        const int row0 = u.pm * BM + wr * 64 + fr, col0 = u.pn * BM + wc * 32 + 8 * fq;
#pragma unroll
        for (int ai = 0; ai < 2; ++ai) {
            u32x4 w[4][2];
#pragma unroll
            for (int m = 0; m < 4; ++m) { const size_t off = (size_t)(row0 + ai * HALF + m * 16) * ldc + col0;
#pragma unroll
                for (int bj = 0; bj < 2; ++bj) w[m][bj] = *(const u32x4*)(hb + off + bj * HALF); }
#pragma unroll
            for (int m = 0; m < 4; ++m) { const size_t off = (size_t)(row0 + ai * HALF + m * 16) * ldc + col0;
#pragma unroll
                for (int bj = 0; bj < 2; ++bj) {
                    const f32x4 r0 = {__uint_as_float(w[m][bj].x << 16), __uint_as_float(w[m][bj].x & 0xffff0000u), __uint_as_float(w[m][bj].y << 16), __uint_as_float(w[m][bj].y & 0xffff0000u)};
                    const f32x4 r1 = {__uint_as_float(w[m][bj].z << 16), __uint_as_float(w[m][bj].z & 0xffff0000u), __uint_as_float(w[m][bj].w << 16), __uint_as_float(w[m][bj].w & 0xffff0000u)};
                    *(f32x4*)(out + off + bj * HALF) = r0 + acc[ai][bj][m][0]; *(f32x4*)(out + off + bj * HALF + 4) = r1 + acc[ai][bj][m][1]; } }
        }
    }
};

struct EpiSwiGLU {
    static constexpr bool PERM = true, AFTER_DRAIN = false;
    bf16_t* H; int ldc; const ssq_t* ss; float inv_n, eps;
    __device__ __forceinline__ void operator()(const f32x4 (&acc)[2][2][4][2], const Unit& u, int wr, int wc, int fr, int fq) const {
        const int row0 = u.pm * BM + wr * 64 + fr, col0 = u.pn * HALF + wc * 32 + 8 * fq;
        ssq_t q[2][4];
#pragma unroll
        for (int ai = 0; ai < 2; ++ai)
#pragma unroll
            for (int m = 0; m < 4; ++m) q[ai][m] = ss[row0 + ai * HALF + m * 16];
#pragma unroll
        for (int ai = 0; ai < 2; ++ai)
#pragma unroll
            for (int m = 0; m < 4; ++m) { bf16_t* rowp = H + (size_t)(row0 + ai * HALF + m * 16) * ldc + col0;
                const float rs = __builtin_amdgcn_rsqf(ssq_to_f(q[ai][m]) * inv_n + eps);
                float o[8];
#pragma unroll
                for (int n = 0; n < 2; ++n)
#pragma unroll
                    for (int e = 0; e < 4; ++e) o[4 * n + e] = rnd_m<HMANT>(fast_silu(acc[ai][0][m][n][e] * rs) * (acc[ai][1][m][n][e] * rs));
                u32x4 w; w.x = cvt_pk_bf16(o[0], o[1]); w.y = cvt_pk_bf16(o[2], o[3]); w.z = cvt_pk_bf16(o[4], o[5]); w.w = cvt_pk_bf16(o[6], o[7]);
                *(u32x4*)rowp = w; }
    }
};

struct EpiGLU {
    static constexpr bool PERM = true, AFTER_DRAIN = false;
    const bf16_t* Y; int ldy; bf16_t* O; int ldo; const float* bias;
    __device__ __forceinline__ void operator()(const f32x4 (&acc)[2][2][4][2], const Unit& u, int wr, int wc, int fr, int fq) const {
        const int row0 = u.pm * BM + wr * 64 + fr, col0 = u.pn * BM + wc * 32 + 8 * fq;
        f32x4 bv[2][2];
#pragma unroll
        for (int bj = 0; bj < 2; ++bj)
#pragma unroll
            for (int n = 0; n < 2; ++n) bv[bj][n] = *(const f32x4*)(bias + col0 + bj * HALF + 4 * n);
#pragma unroll
        for (int ai = 0; ai < 2; ++ai) {
          u32x4 yy[4][2];
#pragma unroll
          for (int m = 0; m < 4; ++m)
#pragma unroll
              for (int bj = 0; bj < 2; ++bj) yy[m][bj] = *(const u32x4*)(Y + (size_t)(row0 + ai * HALF + m * 16) * ldy + col0 + bj * HALF);
#pragma unroll
            for (int m = 0; m < 4; ++m) { const size_t r = (size_t)(row0 + ai * HALF + m * 16);
#pragma unroll
                for (int bj = 0; bj < 2; ++bj) { const u32x4 yv = yy[m][bj];
                    const f32x4 g0 = acc[ai][bj][m][0] + bv[bj][0], g1 = acc[ai][bj][m][1] + bv[bj][1];
                    float o[8];
                    o[0] = __uint_as_float(yv.x << 16) * fast_sigmoid(g0[0]); o[1] = __uint_as_float(yv.x & 0xffff0000u) * fast_sigmoid(g0[1]);
                    o[2] = __uint_as_float(yv.y << 16) * fast_sigmoid(g0[2]); o[3] = __uint_as_float(yv.y & 0xffff0000u) * fast_sigmoid(g0[3]);
                    o[4] = __uint_as_float(yv.z << 16) * fast_sigmoid(g1[0]); o[5] = __uint_as_float(yv.z & 0xffff0000u) * fast_sigmoid(g1[1]);
                    o[6] = __uint_as_float(yv.w << 16) * fast_sigmoid(g1[2]); o[7] = __uint_as_float(yv.w & 0xffff0000u) * fast_sigmoid(g1[3]);
                    u32x4 w; w.x = cvt_pk_bf16(o[0], o[1]); w.y = cvt_pk_bf16(o[2], o[3]); w.z = cvt_pk_bf16(o[4], o[5]); w.w = cvt_pk_bf16(o[6], o[7]);
                    *(u32x4*)(O + r * ldo + col0 + bj * HALF) = w; } }
        }
    }
};
template <class Epi, class Sched, bool ALIGN_EPI = false, bool SP2 = false>
__device__ __forceinline__ void gemm_phase(PG8_LAS unsigned char* lds, const Gemm g, const Sched& S, const Epi& E) {
    const int tid = threadIdx.x, wid = __builtin_amdgcn_readfirstlane(tid >> 6), lane = tid & 63, wr = wid >> 2, wc = wid & 3, fr = lane & 15, fq = lane >> 4;
    const int K = g.K, nt = K / BK;
    unsigned voffA[2], voffB[2];
#pragma unroll
    for (int i = 0; i < 2; ++i) { int R, C; stage_rc(tid * 16 + i * 8192, R, C); const int Rb = Epi::PERM ? ((R & ~31) + perm32(R & 31)) : R;
        voffA[i] = (unsigned)(R * K + C) * 2u; voffB[i] = (unsigned)(Rb * K + C) * 2u; }
    const size_t kstep = (size_t)(BK * 2);
    const size_t hstep = (size_t)HALF * K * 2;
    const size_t tstep = 2 * hstep;
    const unsigned ldsw = (unsigned)wid * 1024u;
    const int aoff = lds_byte(wr * 64 + fr, fq * 8), boff = lds_byte(wc * 32 + fr, fq * 8);
#define PG8_SA(b, h) (((b) * 2 + (h)) * HTB)
#define PG8_SB(b, h) ((4 + (b) * 2 + (h)) * HTB)
#define PG8_STAGE(bufoff, gbase, voff) do { _Pragma("unroll") for (int _i = 0; _i < 2; ++_i) \
        __builtin_amdgcn_global_load_lds((const unsigned*)((const char*)(gbase) + (voff)[_i]), (PG8_LAS unsigned*)(lds + (bufoff) + ldsw + _i * 8192), 16, 0, 0); } while (0)
#define PG8_LDA(dst, b, h) do { _Pragma("unroll") for (int m = 0; m < 4; ++m) _Pragma("unroll") for (int k = 0; k < 2; ++k) dst[m][k] = *(const PG8_LAS bf16x8*)(lds + PG8_SA(b, h) + aoff + m * 2048 + k * 1024); } while (0)
#define PG8_LDB(dst, b, h) do { _Pragma("unroll") for (int n = 0; n < 2; ++n) _Pragma("unroll") for (int k = 0; k < 2; ++k) dst[n][k] = *(const PG8_LAS bf16x8*)(lds + PG8_SB(b, h) + boff + n * 2048 + k * 1024); } while (0)
#define PG8_MMA(ai, bj, At, Bt) do { __builtin_amdgcn_s_setprio(1); _Pragma("unroll") for (int m = 0; m < 4; ++m) _Pragma("unroll") for (int n = 0; n < 2; ++n) _Pragma("unroll") for (int k = 0; k < 2; ++k) \
        acc[ai][bj][m][n] = __builtin_amdgcn_mfma_f32_16x16x32_bf16(Bt[n][k], At[m][k], acc[ai][bj][m][n], 0, 0, 0); __builtin_amdgcn_s_setprio(0); } while (0)
#define PG8_WAIT_V(n) asm volatile("s_waitcnt vmcnt(" #n ")" ::: "memory")
#define PG8_WAIT_L(n) asm volatile("s_waitcnt lgkmcnt(" #n ")" ::: "memory")
#define PG8_BAR __builtin_amdgcn_s_barrier()
#define PG8_SCHED __builtin_amdgcn_sched_barrier(0)
    Unit cur, nxt; int ui = 0;
    if (!S.next(0, cur)) return;
    f32x4 acc[2][2][4][2];
#pragma unroll
    for (int a = 0; a < 2; ++a)
#pragma unroll
        for (int b = 0; b < 2; ++b)
#pragma unroll
            for (int m = 0; m < 4; ++m)
#pragma unroll
                for (int n = 0; n < 2; ++n) acc[a][b][m][n] = (f32x4){0.f, 0.f, 0.f, 0.f};
    bf16x8 At[4][2], B0[2][2], B1[2][2];
    const char* cA = (const char*)g.A + (size_t)cur.pm * tstep; const char* cB = (const char*)g.Bt + (size_t)cur.pn * tstep;
    S.a_ready(cur);
    if constexpr (SP2) {
        PG8_STAGE(PG8_SB(0, 0), cB, voffB); PG8_STAGE(PG8_SB(0, 1), cB + hstep, voffB); PG8_STAGE(PG8_SA(0, 0), cA, voffA); PG8_STAGE(PG8_SA(0, 1), cA + hstep, voffA);
        if (wr == 1) PG8_BAR;
        PG8_WAIT_V(2); PG8_BAR;
        PG8_STAGE(PG8_SB(1, 0), cB + kstep, voffB); PG8_STAGE(PG8_SA(1, 0), cA + kstep, voffA); PG8_STAGE(PG8_SB(1, 1), cB + hstep + kstep, voffB);
        PG8_WAIT_V(6); PG8_BAR;
    } else {
        PG8_STAGE(PG8_SB(0, 0), cB, voffB); PG8_STAGE(PG8_SA(0, 0), cA, voffA); PG8_STAGE(PG8_SB(0, 1), cB + hstep, voffB); PG8_STAGE(PG8_SA(0, 1), cA + hstep, voffA);
        if (wr == 1) PG8_BAR;
        PG8_WAIT_V(4); PG8_BAR;
        PG8_STAGE(PG8_SB(1, 0), cB + kstep, voffB); PG8_STAGE(PG8_SA(1, 0), cA + kstep, voffA); PG8_STAGE(PG8_SB(1, 1), cB + hstep + kstep, voffB);
        PG8_WAIT_V(6); PG8_BAR;
    }
    for (;;) {
        const bool has_next = S.next(ui + 1, nxt);
        const char* nA = has_next ? (const char*)g.A + (size_t)nxt.pm * tstep : cA; const char* nB = has_next ? (const char*)g.Bt + (size_t)nxt.pn * tstep : cB;
        for (int t = 0; t < nt; t += 2) {
            const bool last = (t == nt - 2);
            const char* a1 = cA + (size_t)(t + 1) * kstep;
            const char* a2 = last ? nA : cA + (size_t)(t + 2) * kstep; const char* b2 = last ? nB : cB + (size_t)(t + 2) * kstep;
            const char* a3 = a2 + kstep; const char* b3 = b2 + kstep;
            if (last && has_next) S.a_ready(nxt);
            if constexpr (SP2) {
            PG8_LDB(B0, 0, 0); PG8_LDB(B1, 0, 1); PG8_SCHED; PG8_LDA(At, 0, 0); PG8_STAGE(PG8_SA(1, 1), a1 + hstep, voffA);
            PG8_WAIT_V(8); PG8_WAIT_L(0); PG8_BAR; PG8_MMA(0, 0, At, B0); PG8_MMA(0, 1, At, B1); PG8_BAR; PG8_SCHED;
            PG8_LDA(At, 0, 1); PG8_STAGE(PG8_SB(0, 0), b2, voffB); PG8_STAGE(PG8_SB(0, 1), b2 + hstep, voffB); PG8_STAGE(PG8_SA(0, 0), a2, voffA);
            PG8_WAIT_V(8); PG8_WAIT_L(0); PG8_BAR; PG8_MMA(1, 0, At, B0); PG8_MMA(1, 1, At, B1); PG8_BAR; PG8_SCHED;
            PG8_LDB(B0, 1, 0); PG8_LDB(B1, 1, 1); PG8_SCHED; PG8_LDA(At, 1, 0); PG8_STAGE(PG8_SA(0, 1), a2 + hstep, voffA);
            PG8_WAIT_V(8); PG8_WAIT_L(0); PG8_BAR; PG8_MMA(0, 0, At, B0); PG8_MMA(0, 1, At, B1); PG8_BAR; PG8_SCHED;
            PG8_LDA(At, 1, 1); PG8_STAGE(PG8_SB(1, 0), b3, voffB); PG8_STAGE(PG8_SB(1, 1), b3 + hstep, voffB); PG8_STAGE(PG8_SA(1, 0), a3, voffA);
            PG8_WAIT_V(8); PG8_WAIT_L(0); PG8_BAR; PG8_MMA(1, 0, At, B0); PG8_MMA(1, 1, At, B1); PG8_BAR; PG8_SCHED;
            } else {
            PG8_LDB(B0, 0, 0); PG8_SCHED; PG8_LDA(At, 0, 0); PG8_STAGE(PG8_SA(1, 1), a1 + hstep, voffA);
            PG8_WAIT_L(8); PG8_BAR; PG8_WAIT_L(0); PG8_MMA(0, 0, At, B0); PG8_BAR; PG8_SCHED;
            PG8_LDB(B1, 0, 1); PG8_STAGE(PG8_SB(0, 0), b2, voffB);
            PG8_BAR; PG8_WAIT_L(0); PG8_MMA(0, 1, At, B1); PG8_BAR;
            PG8_LDA(At, 0, 1); PG8_STAGE(PG8_SA(0, 0), a2, voffA);
            PG8_BAR; PG8_WAIT_L(0); PG8_MMA(1, 0, At, B0); PG8_BAR; PG8_SCHED;
            PG8_STAGE(PG8_SB(0, 1), b2 + hstep, voffB);
            PG8_WAIT_V(6); PG8_BAR; PG8_MMA(1, 1, At, B1); PG8_BAR;
            PG8_LDB(B0, 1, 0); PG8_SCHED; PG8_LDA(At, 1, 0); PG8_STAGE(PG8_SA(0, 1), a2 + hstep, voffA);
            PG8_WAIT_L(8); PG8_BAR; PG8_WAIT_L(0); PG8_MMA(0, 0, At, B0); PG8_BAR; PG8_SCHED;
            PG8_LDB(B1, 1, 1); PG8_STAGE(PG8_SB(1, 0), b3, voffB);
            PG8_BAR; PG8_WAIT_L(0); PG8_MMA(0, 1, At, B1); PG8_BAR;
            PG8_LDA(At, 1, 1); PG8_STAGE(PG8_SA(1, 0), a3, voffA);
            PG8_BAR; PG8_WAIT_L(0); PG8_MMA(1, 0, At, B0); PG8_BAR; PG8_SCHED;
            PG8_STAGE(PG8_SB(1, 1), b3 + hstep, voffB);
            PG8_WAIT_V(6); PG8_BAR; PG8_MMA(1, 1, At, B1); PG8_BAR;
            }
        }
        if constexpr (ALIGN_EPI) { if (wr == 0) PG8_BAR; }
        if constexpr (!Epi::AFTER_DRAIN) { E(acc, cur, wr, wc, fr, fq); S.done(cur); }
        if (!has_next) break;
#pragma unroll
        for (int a = 0; a < 2; ++a)
#pragma unroll
            for (int b = 0; b < 2; ++b)
#pragma unroll
                for (int m = 0; m < 4; ++m)
#pragma unroll
                    for (int n = 0; n < 2; ++n) acc[a][b][m][n] = (f32x4){0.f, 0.f, 0.f, 0.f};
        cur = nxt; cA = nA; cB = nB; ++ui;
        if constexpr (ALIGN_EPI) { if (wr == 1) PG8_BAR; }
    }
    PG8_WAIT_V(0);
    if constexpr (!ALIGN_EPI) { if (wr == 0) PG8_BAR; }
    PG8_BAR;
    if constexpr (Epi::AFTER_DRAIN) { E.fused(acc, cur, wr, wc, fr, fq, lds, wid, lane); S.done(cur); }
#undef PG8_SA
#undef PG8_SB
#undef PG8_STAGE
#undef PG8_LDA
#undef PG8_LDB
#undef PG8_MMA
#undef PG8_WAIT_V
#undef PG8_WAIT_L
#undef PG8_BAR
#undef PG8_SCHED
}
}

constexpr int NWAVES = 8;
constexpr int D = 2048, BATCH = 8, SEQ = 4096, M = BATCH * SEQ, FF = 5632;
constexpr int N_IN0 = 4632, N_IN1 = 4624, N_INP = 4640, N_MAIN = 4608;
constexpr float RMS_EPS = 1e-6f;
constexpr int NPHASE = 18;

constexpr size_t MiB = 1u << 20;
constexpr size_t WS_CTL = 0, CTL_ZERO_BYTES = 1 * MiB;
constexpr size_t WS_TAB = 1 * MiB;
constexpr size_t WS_WIN0 = 8 * MiB, WS_WOUT0 = 27 * MiB, WS_W13_0 = 35 * MiB, WS_W2_0 = 79 * MiB;
constexpr size_t WS_WIN1 = 101 * MiB, WS_WOUT1 = 120 * MiB, WS_W13_1 = 128 * MiB, WS_W2_1 = 172 * MiB, WS_GLUW = 194 * MiB;
constexpr size_t WS_A = 200 * MiB;
constexpr size_t WS_B = 360 * MiB;
constexpr size_t WS_U = WS_B, WS_Z = WS_B + 32 * MiB, WS_XBC = WS_B + 128 * MiB, WS_DT = WS_B + 288 * MiB, WS_YPRE = WS_B + 292 * MiB, WS_YSSD = WS_XBC;
constexpr size_t WS_Q = WS_B, WS_K = WS_B + 64 * MiB, WS_V = WS_B + 80 * MiB, WS_QD = WS_B + 96 * MiB, WS_KD = WS_B + 128 * MiB, WS_VD = WS_B + 160 * MiB,
                 WS_GOUT = WS_B + 224 * MiB, WS_GLR = WS_B + 288 * MiB, WS_GLAO = WS_B + 292 * MiB;
constexpr size_t WS_QT = 328 * MiB;
constexpr size_t WS_KTT = WS_B + 356 * MiB, WS_ATT = WS_B + 388 * MiB, WS_DEC = WS_B + 404 * MiB;
constexpr size_t WS_H = WS_B;
constexpr size_t WS_HB = 768 * MiB;
constexpr size_t WS_HB5 = 896 * MiB;
constexpr size_t WS_END = (XMANT < 7 ? 1024 : 896) * MiB;
constexpr int CW_BAR = 4096;
constexpr size_t WS_SS = 131072;
constexpr size_t WS_SS0 = 8 * MiB - 262144;
constexpr size_t TAB_TOEP = 0, TAB_QM = 4 * MiB, TAB_ABARD = 6 * MiB, TAB_BTD = 6 * MiB + 65536, TAB_A16 = 6 * MiB + 65536 + 524288;
constexpr size_t WS_PM = 195 * MiB;
constexpr size_t WS_POW = 198 * MiB;

constexpr int RING_OFF = 0, RING_BYTES = 131072;
constexpr int LDS_BYTES = 147456;
constexpr int MISC_OFF = LDS_BYTES - 1024;
constexpr int PT_OFF = MISC_OFF + 512;

#define GAS __attribute__((address_space(1)))
#define LAS __attribute__((address_space(3)))
typedef unsigned short bf16;
typedef unsigned v4u __attribute__((ext_vector_type(4)));
typedef unsigned v2u __attribute__((ext_vector_type(2)));
typedef float f32x4 __attribute__((ext_vector_type(4)));
typedef float f32x2 __attribute__((ext_vector_type(2)));
typedef GAS unsigned gu32;
#define RLX_AGENT __ATOMIC_RELAXED, __HIP_MEMORY_SCOPE_AGENT
#define LDS_WAIT() asm volatile("s_waitcnt lgkmcnt(0)" ::: "memory")
#define VM_WAIT() asm volatile("s_waitcnt vmcnt(0)" ::: "memory")
#define DI __device__ __forceinline__
#define BAR_LDS() do { asm volatile("s_waitcnt lgkmcnt(0)" ::: "memory"); __builtin_amdgcn_s_barrier(); asm volatile("" ::: "memory"); } while (0)
DI unsigned f2bf(float f) { unsigned u = __builtin_bit_cast(unsigned, f); return (u + 0x7fffu + ((u >> 16) & 1u)) >> 16; }
DI unsigned pk2(float lo, float hi) { return f2bf(lo) | (f2bf(hi) << 16); }
typedef __bf16 bf16x2_t __attribute__((ext_vector_type(2)));
DI unsigned cvtpk(float lo, float hi) { const f32x2 v = {lo, hi}; const bf16x2_t b = __builtin_convertvector(v, bf16x2_t); return __builtin_bit_cast(unsigned, b); }
DI float bflo(unsigned w) { return __uint_as_float(w << 16); }
DI float bfhi(unsigned w) { return __uint_as_float(w & 0xffff0000u); }
DI float bf2f(bf16 b) { return __uint_as_float((unsigned)b << 16); }
DI float wave_sum(float v) {
#pragma unroll
    for (int o = 1; o < 64; o <<= 1) v += __shfl_xor(v, o);
    return v;
}
DI float wave_max(float v) {
#pragma unroll
    for (int o = 1; o < 64; o <<= 1) v = fmaxf(v, __shfl_xor(v, o));
    return v;
}
DI float silu_f(float x) { return x * __builtin_amdgcn_rcpf(1.0f + __expf(-x)); }
DI float gelu_tanh_f(float x) { const float z = 0.7978845608028654f * (x + 0.044715f * x * x * x); const float t = 1.0f - 2.0f * __builtin_amdgcn_rcpf(__expf(2.0f * z) + 1.0f); return 0.5f * x * (1.0f + t); }
DI float softplus_f(float x) { const float e = __expf(-fabsf(x)); const float l = e < 0.01f ? e * (1.0f - e * (0.5f - e * 0.33333333f)) : __logf(1.0f + e); return fmaxf(x, 0.f) + l; }

typedef short v4i16_t __attribute__((ext_vector_type(4)));
DI v2u tr16(const LAS bf16* p) { return __builtin_bit_cast(v2u, __builtin_amdgcn_ds_read_tr16_b64_v4i16((LAS v4i16_t*)p)); }
struct InTab { const LAS unsigned long long* t;
    DI const float* operator[](int i) const { const unsigned long long v = t[i];
        const unsigned lo = __builtin_amdgcn_readfirstlane((unsigned)v), hi = __builtin_amdgcn_readfirstlane((unsigned)(v >> 32));
        return (const float*)(const GAS float*)(((unsigned long long)hi << 32) | lo); } };
#define XB_TMO      128
#define XB_XCNT(j)  (256  + 64 * (j))
#define XB_XSUB(j)  (1280 + 64 * (j))
#define XB_XGEN(j)  (2304 + 64 * (j))
#define XB_TOP      3328
#define XB_TOPGEN   3392
#define XCD_BAR_WORDS 3456
#define XB_SPIN_CAP (1u << 18)

__device__ __forceinline__ unsigned xb_ld(unsigned* p)              { return __hip_atomic_load(p, __ATOMIC_RELAXED, __HIP_MEMORY_SCOPE_AGENT); }
__device__ __forceinline__ unsigned xb_add(unsigned* p, unsigned v) { return __hip_atomic_fetch_add(p, v, __ATOMIC_RELAXED, __HIP_MEMORY_SCOPE_AGENT); }
__device__ __forceinline__ unsigned xb_xcc_id() { return (unsigned)__builtin_amdgcn_s_getreg((3 << 11) | 20) & 0xFu; }
#define XB_SPIN(cond, bar) do { unsigned _sp = 0; while (cond) { __builtin_amdgcn_s_sleep(1); \
    if ((++_sp & 255u) == 0u) { if (xb_ld(&(bar)[XB_TMO])) break; if (_sp > XB_SPIN_CAP) { atomicAdd(&(bar)[XB_TMO], 1u); break; } } } } while (0)

struct XcdBarrier {
    unsigned* bar; unsigned x;
    volatile LAS unsigned* st;
};

__device__ __forceinline__ XcdBarrier xcd_barrier_post(unsigned* bar, volatile LAS unsigned* st) {
    XcdBarrier b; b.bar = bar; b.x = xb_xcc_id(); b.st = st;
    if (threadIdx.x == 0) (void)xb_add(&bar[XB_XCNT(b.x)], 1u);
    return b;
}
__device__ __forceinline__ void xcd_barrier_complete(unsigned* bar, unsigned x, unsigned& nloc, unsigned& nx) {
    const unsigned G = gridDim.x * gridDim.y * gridDim.z;
    unsigned sum, cnt, mine, sp = 0u;
    for (;;) {
        sum = 0u; cnt = 0u; mine = 0u;
#pragma unroll
        for (unsigned j = 0; j < 16; ++j) { const unsigned c = xb_ld(&bar[XB_XCNT(j)]); sum += c; cnt += (c > 0u) ? 1u : 0u; mine = (j == x) ? c : mine; }
        if (sum == G) break;
        __builtin_amdgcn_s_sleep(1);
        if ((++sp & 255u) == 0u) { if (xb_ld(&bar[XB_TMO])) break; if (sp > XB_SPIN_CAP) { atomicAdd(&bar[XB_TMO], 1u); break; } }
    }
    nloc = mine > 0u ? mine : 1u; nx = cnt > 0u ? cnt : 1u;
}

__device__ __forceinline__ void xcd_barrier(const XcdBarrier& b) {
    asm volatile("s_waitcnt vmcnt(0)" ::: "memory");
    __syncthreads();
    if (threadIdx.x == 0) {
        unsigned* bar = b.bar;
        __builtin_amdgcn_s_waitcnt(0);
        unsigned nloc = b.st[0], nx = b.st[1];
        if (nloc == 0u) { xcd_barrier_complete(bar, b.x, nloc, nx); b.st[0] = nloc; b.st[1] = nx; }
        const unsigned old = xb_add(&bar[XB_XSUB(b.x)], 1u);
        const unsigned gen = old / nloc;
        if (old + 1u == (gen + 1u) * nloc) {
            __builtin_amdgcn_fence(__ATOMIC_RELEASE, "agent");
            asm volatile("s_waitcnt vmcnt(0)" ::: "memory");
            const unsigned og = xb_add(&bar[XB_TOP], 1u);
            const unsigned tg = og / nx;
            if (og + 1u == (tg + 1u) * nx) xb_add(&bar[XB_TOPGEN], 1u);
            else XB_SPIN(xb_ld(&bar[XB_TOPGEN]) == tg, bar);
            __builtin_amdgcn_fence(__ATOMIC_ACQUIRE, "agent");
            xb_add(&bar[XB_XGEN(b.x)], 1u);
            asm volatile("s_waitcnt vmcnt(0)" ::: "memory");
        } else {
            XB_SPIN(xb_ld(&bar[XB_XGEN(b.x)]) == gen, bar);
            __builtin_amdgcn_fence(__ATOMIC_ACQUIRE, "agent");
            asm volatile("s_waitcnt vmcnt(0)" ::: "memory");
        }
    }
    __syncthreads();
}

template <int MB> DI unsigned f2bfm(float f) { constexpr int sh = 16 + (7 - MB); unsigned u = __builtin_bit_cast(unsigned, f); u = (u + ((1u << (sh - 1)) - 1u) + ((u >> sh) & 1u)) & ~((1u << sh) - 1u); return u >> 16; }
template <int MB> DI unsigned pk2m(float lo, float hi) { return f2bfm<MB>(lo) | (f2bfm<MB>(hi) << 16); }
template <int MB = 7> DI void transpose_item(const float* W, int K, int N, bf16* WT, int mode, LAS float* scr, int item, int nblk, int lane, const float* gain = nullptr) {
    const int kb = item / nblk, nb = item % nblk, k0 = 64 * kb, n0 = 32 * nb;
    const int nn = n0 + (lane & 31); const bool ok = nn < N;
    float wv[32];
#pragma unroll
    for (int i = 0; i < 32; ++i) { const int kk = 2 * i + (lane >> 5); wv[i] = ok ? W[(size_t)(k0 + kk) * N + nn] : 0.f; }
    if (gain) {
#pragma unroll
        for (int i = 0; i < 32; ++i) wv[i] *= gain[k0 + 2 * i + (lane >> 5)]; }
#pragma unroll
    for (int i = 0; i < 32; ++i) scr[(2 * i + (lane >> 5)) * 33 + (lane & 31)] = wv[i];
    LDS_WAIT(); asm volatile("" ::: "memory");
    const int c = lane & 7;
    const int drow0 = (mode == 0) ? n0 : (256 * (n0 >> 7) + (n0 & 127) + (mode == 2 ? 128 : 0));
#pragma unroll
    for (int j = 0; j < 4; ++j) { const int n = (lane >> 3) + 8 * j; const LAS float* s = scr + (8 * c) * 33 + n;
        v4u o; o.x = pk2m<MB>(s[0 * 33], s[1 * 33]); o.y = pk2m<MB>(s[2 * 33], s[3 * 33]); o.z = pk2m<MB>(s[4 * 33], s[5 * 33]); o.w = pk2m<MB>(s[6 * 33], s[7 * 33]);
        *(v4u*)(WT + (size_t)(drow0 + n) * K + k0 + 8 * c) = o; }
    LDS_WAIT(); asm volatile("" ::: "memory");
}
DI void prologue(const InTab in, unsigned char* ws, LAS unsigned char* lds, int gw, int NGW, int lane, int wave) {
    LAS float* scr = (LAS float*)(lds + RING_OFF + wave * 16384);
    constexpr int I_IN = (D / 64) * (N_INP / 32), I_OUT = (D / 64) * (D / 32), I_W1 = (D / 64) * (FF / 32), I_W2 = (FF / 64) * (D / 32), I_GLU = (512 / 64) * (512 / 32);
    constexpr int I_LAYER = I_IN + I_OUT + 2 * I_W1 + I_W2;
    constexpr int NITEMS = 2 * I_LAYER + I_GLU;
    for (int it = gw; it < NITEMS; it += NGW) {
        int r = it;
        if (r >= 2 * I_LAYER) { r -= 2 * I_LAYER; transpose_item(in[11], 512, 512, (bf16*)(ws + WS_GLUW), 0, scr, r, 512 / 32, lane); continue; }
        const int layer = r >= I_LAYER; if (layer) r -= I_LAYER;
        const float* win = layer ? in[25] : in[2]; const float* wout = layer ? in[32] : in[19];
        const float* w1 = layer ? in[34] : in[21]; const float* w3 = layer ? in[35] : in[22]; const float* w2 = layer ? in[36] : in[23];
        const float* gmix = layer ? in[24] : in[1]; const float* gffn = layer ? in[33] : in[20];
        bf16* WIN = (bf16*)(ws + (layer ? WS_WIN1 : WS_WIN0)); bf16* WOUT = (bf16*)(ws + (layer ? WS_WOUT1 : WS_WOUT0));
        bf16* W13 = (bf16*)(ws + (layer ? WS_W13_1 : WS_W13_0)); bf16* W2 = (bf16*)(ws + (layer ? WS_W2_1 : WS_W2_0));
        if (r < I_IN) { transpose_item<WM_IN>(win, D, layer ? N_IN1 : N_IN0, WIN, 0, scr, r, N_INP / 32, lane, gmix); continue; } r -= I_IN;
        if (r < I_OUT) { transpose_item<WM_OUT>(wout, D, D, WOUT, 0, scr, r, D / 32, lane); continue; } r -= I_OUT;
        if (r < I_W1) { transpose_item<WM_FFN>(w1, D, FF, W13, 1, scr, r, FF / 32, lane, gffn); continue; } r -= I_W1;
        if (r < I_W1) { transpose_item<WM_FFN>(w3, D, FF, W13, 2, scr, r, FF / 32, lane, gffn); continue; } r -= I_W1;
        transpose_item<WM_FFN>(w2, FF, D, W2, 0, scr, r, D / 32, lane);
    }
}
DI void s5_tables(const InTab in, unsigned char* ws, int gt) {
    if (gt >= 32 * 64) return;
    const int g = gt >> 6;
    const double are = (double)in[3][gt], aim = (double)in[4][gt], dt = exp((double)in[5][g]);
    const double mag = exp(are * dt), abr = mag * cos(aim * dt), abi = mag * sin(aim * dt);
    const double er = abr - 1.0, ei = abi, den = are * are + aim * aim;
    const double cr = (er * are + ei * aim) / den, ci = (ei * are - er * aim) / den;
    double* ABARD = (double*)(ws + WS_TAB + TAB_ABARD); double* BTD = (double*)(ws + WS_TAB + TAB_BTD); float* A16 = (float*)(ws + WS_TAB + TAB_A16);
    ABARD[gt * 2] = abr; ABARD[gt * 2 + 1] = abi;
    { double* POW = (double*)(ws + WS_POW) + (size_t)gt * 34; double qr = 1.0, qi = 0.0; POW[0] = 1.0; POW[1] = 0.0;
      for (int p = 1; p <= 16; ++p) { const double nr = qr * abr - qi * abi, ni = qr * abi + qi * abr; qr = nr; qi = ni; POW[2 * p] = qr; POW[2 * p + 1] = qi; } }
    double pr = abr, pi = abi;
#pragma unroll
    for (int i = 0; i < 4; ++i) { const double nr = pr * pr - pi * pi, ni = 2.0 * pr * pi; pr = nr; pi = ni; }
    A16[gt * 2] = (float)pr; A16[gt * 2 + 1] = (float)pi;
    for (int c = 0; c < 16; ++c) { const double br = (double)in[6][gt * 16 + c], bi = (double)in[7][gt * 16 + c];
        BTD[(gt * 16 + c) * 2] = cr * br - ci * bi; BTD[(gt * 16 + c) * 2 + 1] = cr * bi + ci * br; }
}
DI void cpow(double ar, double ai, int p, double& pr, double& pi) { pr = 1.0; pi = 0.0; for (int i = 0; i < p; ++i) { const double nr = pr * ar - pi * ai, ni = pr * ai + pi * ar; pr = nr; pi = ni; } }
DI void s5_tables2(const InTab in, unsigned char* ws, LAS unsigned char* lds, int bx, int G, int tid) {
    bf16* TOEP = (bf16*)(ws + WS_TAB + TAB_TOEP); bf16* QM = (bf16*)(ws + WS_TAB + TAB_QM); bf16* PM = (bf16*)(ws + WS_PM);
    LAS double* POW = (LAS double*)(lds + RING_OFF);
    LAS double* BTD = POW + 64 * 34;
    LAS float* Crl = (LAS float*)(BTD + 64 * 32);
    LAS float* Cil = Crl + 16 * 64;
    for (int gi = bx; gi < 32 * 8; gi += G) {
        const int g = gi >> 3, idx = (gi & 7) * 512 + tid;
        __syncthreads();
        { const v4u* s0 = (const v4u*)((const double*)(ws + WS_POW) + (size_t)g * 64 * 34); LAS v4u* d0 = (LAS v4u*)POW;
          for (int k = tid; k < 64 * 34 * 8 / 16; k += 512) d0[k] = s0[k];
          const v4u* s1 = (const v4u*)((const double*)(ws + WS_TAB + TAB_BTD) + (size_t)g * 64 * 32); LAS v4u* d1 = (LAS v4u*)BTD;
          for (int k = tid; k < 64 * 32 * 8 / 16; k += 512) d1[k] = s1[k];
          if (tid < 256) ((LAS v4u*)Crl)[tid] = ((const v4u*)(in[8] + (size_t)g * 16 * 64))[tid];
          else ((LAS v4u*)Cil)[tid - 256] = ((const v4u*)(in[9] + (size_t)g * 16 * 64))[tid - 256]; }
        __syncthreads();
        {   const int d = idx >> 8, cp = (idx >> 4) & 15, c = idx & 15;
            double sum = 0.0;
            for (int n = 0; n < 64; ++n) { const double pr = POW[n * 34 + 2 * d], pi = POW[n * 34 + 2 * d + 1];
                const double br = BTD[(n * 16 + c) * 2], bi = BTD[(n * 16 + c) * 2 + 1], xr = pr * br - pi * bi, xi = pr * bi + pi * br;
                sum += (double)Crl[cp * 64 + n] * xr - (double)Cil[cp * 64 + n] * xi; }
            if (d == 0 && cp == c) sum += (double)in[10][g * 16 + c];
            const bf16 v = (bf16)f2bf((float)sum);
            for (int s = 0; s + d < 16; ++s) { const int j = s + d;
                TOEP[((size_t)(g * 256 + 16 * j + cp)) * 256 + 16 * s + c] = v;
                if (d > 0) TOEP[((size_t)(g * 256 + 16 * s + cp)) * 256 + 16 * j + c] = (bf16)0; } }
        {   const int np = (idx >> 5) & 127, s = (idx >> 1) & 15, half = idx & 1, n = np & 63;
            const double pr = POW[n * 34 + 2 * (15 - s)], pi = POW[n * 34 + 2 * (15 - s) + 1];
            float v[8];
#pragma unroll
            for (int e = 0; e < 8; ++e) { const int c = half * 8 + e; const double br = BTD[(n * 16 + c) * 2], bi = BTD[(n * 16 + c) * 2 + 1];
                v[e] = (float)((np < 64) ? (pr * br - pi * bi) : (pr * bi + pi * br)); }
            v4u o; o.x = pk2(v[0], v[1]); o.y = pk2(v[2], v[3]); o.z = pk2(v[4], v[5]); o.w = pk2(v[6], v[7]);
            *(v4u*)(QM + ((size_t)(g * 128 + np)) * 256 + 16 * s + 8 * half) = o; }
        {   const int j = idx >> 8, cp = (idx >> 4) & 15, o8 = idx & 15;
            float v[8];
#pragma unroll
            for (int e = 0; e < 8; ++e) { const int kp = o8 * 8 + e, n = kp & 63; const double pr = POW[n * 34 + 2 * (j + 1)], pi = POW[n * 34 + 2 * (j + 1) + 1];
                const double cr = (double)Crl[cp * 64 + n], ci = (double)Cil[cp * 64 + n];
                v[e] = (float)((kp < 64) ? (cr * pr - ci * pi) : -(cr * pi + ci * pr)); }
            v4u o; o.x = pk2(v[0], v[1]); o.y = pk2(v[2], v[3]); o.z = pk2(v[4], v[5]); o.w = pk2(v[6], v[7]);
            *(v4u*)(PM + ((size_t)(g * 256 + 16 * j + cp)) * 128 + o8 * 8) = o; }
    }
}
DI void x_to_hb_phase(const float* x, bf16* HB, pg8::ssq_t* ss, int gw, int NGW, int lane) {
    for (int m = gw; m < M; m += NGW) {
        const f32x4* xr = (const f32x4*)(x + (size_t)m * D) + lane;
        f32x4 v[8]; float s = 0.f;
#pragma unroll
        for (int j = 0; j < 8; ++j) { v[j] = xr[64 * j]; s += (v[j].x * v[j].x + v[j].y * v[j].y) + (v[j].z * v[j].z + v[j].w * v[j].w); }
        s = wave_sum(s);
        v2u* o8 = (v2u*)(HB + (size_t)m * D) + lane;
#pragma unroll
        for (int j = 0; j < 8; ++j) { v2u w; w.x = cvtpk(pg8::rnd_am(v[j].x), pg8::rnd_am(v[j].y)); w.y = cvtpk(pg8::rnd_am(v[j].z), pg8::rnd_am(v[j].w)); o8[64 * j] = w; }
        if (lane == 0) ss[m] = pg8::ssq_from_f(s);
    }
}

DI void s5_fast(const InTab in, unsigned char* ws, LAS unsigned char* lds, int u0, int u1, int ustep, int tid, int lane, int wave) {
    typedef short bf16x8 __attribute__((ext_vector_type(8)));
    const bf16* U = (const bf16*)(ws + WS_U); bf16* YPRE = (bf16*)(ws + WS_YPRE);
    const bf16* TOEP = (const bf16*)(ws + WS_TAB + TAB_TOEP); const bf16* QM = (const bf16*)(ws + WS_TAB + TAB_QM); const bf16* PM = (const bf16*)(ws + WS_PM);
    const float* A16 = (const float*)(ws + WS_TAB + TAB_A16);
    LAS float* Sf = (LAS float*)(lds + RING_OFF);
    const int fr = lane & 15, fq = lane >> 4;
    for (int unit = u0; unit < u1; unit += ustep) {
        const int b = unit >> 5, g = unit & 31;
        const bf16* Ub = U + (size_t)b * SEQ * 512 + g * 16;
        bf16x8 af[2][8];
#pragma unroll
        for (int rb = 0; rb < 2; ++rb)
#pragma unroll
            for (int ks = 0; ks < 8; ++ks) { const int token = (32 * wave + 16 * rb + fr) * 16 + 2 * ks + (fq >> 1);
                af[rb][ks] = *(const bf16x8*)(Ub + (size_t)token * 512 + 8 * (fq & 1)); }
        __syncthreads();
        {
            bf16x8 bq[2][8];
#pragma unroll
            for (int ks = 0; ks < 8; ++ks) bq[0][ks] = *(const bf16x8*)(QM + ((size_t)(g * 128 + fr)) * 256 + 32 * ks + 8 * fq);
#pragma unroll
            for (int nb = 0; nb < 8; ++nb) {
                if (nb + 1 < 8) {
#pragma unroll
                    for (int ks = 0; ks < 8; ++ks) bq[(nb + 1) & 1][ks] = *(const bf16x8*)(QM + ((size_t)(g * 128 + 16 * (nb + 1) + fr)) * 256 + 32 * ks + 8 * fq); }
                f32x4 a0 = {0.f, 0.f, 0.f, 0.f}, a1 = {0.f, 0.f, 0.f, 0.f};
#pragma unroll
                for (int ks = 0; ks < 8; ++ks) { a0 = __builtin_amdgcn_mfma_f32_16x16x32_bf16(af[0][ks], bq[nb & 1][ks], a0, 0, 0, 0); a1 = __builtin_amdgcn_mfma_f32_16x16x32_bf16(af[1][ks], bq[nb & 1][ks], a1, 0, 0, 0); }
#pragma unroll
                for (int e = 0; e < 4; ++e) { Sf[(32 * wave + 4 * fq + e) * 132 + 16 * nb + fr] = a0[e]; Sf[(32 * wave + 16 + 4 * fq + e) * 132 + 16 * nb + fr] = a1[e]; }
            }
        }
        __syncthreads();
        if (wave == 0) {
            const float ar = A16[(g * 64 + lane) * 2], ai = A16[(g * 64 + lane) * 2 + 1];
            float hr = 0.f, hi = 0.f;
            for (int c0 = 0; c0 < 256; c0 += 16) {
                float sr[16], si[16];
#pragma unroll
                for (int i = 0; i < 16; ++i) { sr[i] = Sf[(c0 + i) * 132 + lane]; si[i] = Sf[(c0 + i) * 132 + 64 + lane]; }
#pragma unroll
                for (int i = 0; i < 16; ++i) { Sf[(c0 + i) * 132 + lane] = hr; Sf[(c0 + i) * 132 + 64 + lane] = hi;
                    const float nhr = ar * hr - ai * hi + sr[i], nhi = ar * hi + ai * hr + si[i]; hr = nhr; hi = nhi; }
            }
        }
        __syncthreads();
        bf16x8 hf[2][4];
#pragma unroll
        for (int rb = 0; rb < 2; ++rb)
#pragma unroll
            for (int ks = 0; ks < 4; ++ks) { const LAS f32x4* hp = (const LAS f32x4*)(Sf + (32 * wave + 16 * rb + fr) * 132 + 32 * ks + 8 * fq); const f32x4 h0 = hp[0], h1 = hp[1];
                v4u w; w.x = cvtpk(h0[0], h0[1]); w.y = cvtpk(h0[2], h0[3]); w.z = cvtpk(h1[0], h1[1]); w.w = cvtpk(h1[2], h1[3]);
                hf[rb][ks] = __builtin_bit_cast(bf16x8, w); }
        {
            bf16x8 bt[2][8], bp[2][4];
            bt[0][0] = *(const bf16x8*)(TOEP + ((size_t)(g * 256 + fr)) * 256 + 8 * fq);
#pragma unroll
            for (int ks = 0; ks < 4; ++ks) bp[0][ks] = *(const bf16x8*)(PM + ((size_t)(g * 256 + fr)) * 128 + 32 * ks + 8 * fq);
#pragma unroll
            for (int nb = 0; nb < 16; ++nb) {
                if (nb + 1 < 16) {
#pragma unroll
                    for (int ks = 0; ks < 8; ++ks) if (2 * ks <= nb + 1) bt[(nb + 1) & 1][ks] = *(const bf16x8*)(TOEP + ((size_t)(g * 256 + 16 * (nb + 1) + fr)) * 256 + 32 * ks + 8 * fq);
#pragma unroll
                    for (int ks = 0; ks < 4; ++ks) bp[(nb + 1) & 1][ks] = *(const bf16x8*)(PM + ((size_t)(g * 256 + 16 * (nb + 1) + fr)) * 128 + 32 * ks + 8 * fq); }
                f32x4 a0 = {0.f, 0.f, 0.f, 0.f}, a1 = {0.f, 0.f, 0.f, 0.f};
#pragma unroll
                for (int ks = 0; ks < 8; ++ks) if (2 * ks <= nb) { a0 = __builtin_amdgcn_mfma_f32_16x16x32_bf16(af[0][ks], bt[nb & 1][ks], a0, 0, 0, 0); a1 = __builtin_amdgcn_mfma_f32_16x16x32_bf16(af[1][ks], bt[nb & 1][ks], a1, 0, 0, 0); }
#pragma unroll
                for (int ks = 0; ks < 4; ++ks) { a0 = __builtin_amdgcn_mfma_f32_16x16x32_bf16(hf[0][ks], bp[nb & 1][ks], a0, 0, 0, 0); a1 = __builtin_amdgcn_mfma_f32_16x16x32_bf16(hf[1][ks], bp[nb & 1][ks], a1, 0, 0, 0); }
#pragma unroll
                for (int e = 0; e < 4; ++e) {
                    const size_t t0 = (size_t)b * SEQ + (size_t)(32 * wave + 4 * fq + e) * 16 + nb, t1 = t0 + 256;
                    YPRE[t0 * 512 + g * 16 + fr] = (bf16)f2bf(gelu_tanh_f(a0[e]));
                    YPRE[t1 * 512 + g * 16 + fr] = (bf16)f2bf(gelu_tanh_f(a1[e])); }
            }
        }
    }
}
DI void conv_phase(const InTab in, unsigned char* ws, int gt, int NGT) {
    const bf16* XBC = (const bf16*)(ws + WS_XBC); bf16* XC = (bf16*)(ws + WS_A);
    const float* cw = in[13]; const float* cb = in[14];
    for (int i = gt; i < (M / 8) * 320; i += NGT) {
        const int tb = i / 320, c8 = (i % 320) * 8, t0 = tb * 8, ts0 = t0 & (SEQ - 1);
        v4u r[11];
#pragma unroll
        for (int k = 0; k < 11; ++k) { r[k] = (v4u){0u, 0u, 0u, 0u}; if (ts0 - 3 + k >= 0) r[k] = *(const v4u*)(XBC + (size_t)(t0 - 3 + k) * 2560 + c8); }
        float w[4][8], bs[8];
#pragma unroll
        for (int k = 0; k < 4; ++k) { const f32x4 w0 = *(const f32x4*)(cw + k * 2560 + c8), w1 = *(const f32x4*)(cw + k * 2560 + c8 + 4);
            w[k][0] = w0.x; w[k][1] = w0.y; w[k][2] = w0.z; w[k][3] = w0.w; w[k][4] = w1.x; w[k][5] = w1.y; w[k][6] = w1.z; w[k][7] = w1.w; }
        { const f32x4 b0 = *(const f32x4*)(cb + c8), b1 = *(const f32x4*)(cb + c8 + 4); bs[0] = b0.x; bs[1] = b0.y; bs[2] = b0.z; bs[3] = b0.w; bs[4] = b1.x; bs[5] = b1.y; bs[6] = b1.z; bs[7] = b1.w; }
        float x[11][8];
#pragma unroll
        for (int k = 0; k < 11; ++k) { x[k][0] = bflo(r[k].x); x[k][1] = bfhi(r[k].x); x[k][2] = bflo(r[k].y); x[k][3] = bfhi(r[k].y); x[k][4] = bflo(r[k].z); x[k][5] = bfhi(r[k].z); x[k][6] = bflo(r[k].w); x[k][7] = bfhi(r[k].w); }
#pragma unroll
        for (int j = 0; j < 8; ++j) { float acc[8];
#pragma unroll
            for (int e = 0; e < 8; ++e) acc[e] = bs[e] + w[0][e] * x[j][e] + w[1][e] * x[j + 1][e] + w[2][e] * x[j + 2][e] + w[3][e] * x[j + 3][e];
            v4u o; o.x = cvtpk(silu_f(acc[0]), silu_f(acc[1])); o.y = cvtpk(silu_f(acc[2]), silu_f(acc[3])); o.z = cvtpk(silu_f(acc[4]), silu_f(acc[5])); o.w = cvtpk(silu_f(acc[6]), silu_f(acc[7]));
            *(v4u*)(XC + (size_t)(t0 + j) * 2560 + c8) = o; }
    }
}
DI void ssd_fast(const InTab in, unsigned char* ws, LAS unsigned char* lds, int bx, int G, int tid, int lane, int wave) {
    typedef short bf16x8 __attribute__((ext_vector_type(8)));
    const bf16* XC = (const bf16*)(ws + WS_A); const float* DT = (const float*)(ws + WS_DT); const bf16* Z = (const bf16*)(ws + WS_Z); bf16* YS = (bf16*)(ws + WS_YSSD);
    constexpr int SET = 64 * 136 * 2 + 64 * 72 * 2 + 256;
    LAS bf16* T0 = (LAS bf16*)(lds + RING_OFF);
    LAS bf16* Sl = T0 + 2 * SET;
    const int fr = lane & 15, fq = lane >> 4, lb = wave & 3, ph = wave >> 2, tq = fr >> 2, tp = fr & 3;
    const float LOG2E = 1.4426950408889634f;
    for (int unit = bx; unit < BATCH * 24; unit += G) {
        const int b = unit / 24, h = unit % 24, grp = h / 6;
        const float A = -__expf(in[16][h]), Dh = in[17][h], dtb = in[15][h];
        f32x4 st[4];
#pragma unroll
        for (int i = 0; i < 4; ++i) st[i] = (f32x4){0.f, 0.f, 0.f, 0.f};
        __syncthreads();
        for (int i = tid; i < 64 * 136 / 2; i += 512) ((LAS unsigned*)Sl)[i] = 0u;
        v4u rB[2], rC[2], rX; float rdt;
#define SSD_FETCH(chunk) do { const size_t r0_ = (size_t)b * SEQ + (size_t)(chunk) * 64; \
            _Pragma("unroll") for (int i = 0; i < 2; ++i) { const int pc = tid + 512 * i, s = pc >> 4, n0 = (pc & 15) * 8; \
                rB[i] = *(const v4u*)(XC + (r0_ + s) * 2560 + 1536 + grp * 128 + n0); rC[i] = *(const v4u*)(XC + (r0_ + s) * 2560 + 2048 + grp * 128 + n0); } \
            rX = *(const v4u*)(XC + (r0_ + (tid >> 3)) * 2560 + h * 64 + (tid & 7) * 8); \
            rdt = DT[(r0_ + lane) * 32 + h]; } while (0)
#define SSD_STAGE(set) do { LAS bf16* Bl_ = T0 + (set) * SET; LAS bf16* Cl_ = Bl_ + 64 * 136; LAS bf16* Xl_ = Cl_ + 64 * 136; LAS bf16* Xw_ = Xl_ + 64 * 72; LAS float* cs_ = (LAS float*)(Xw_ + 64 * 72); \
            const float dt = softplus_f(rdt + dtb); float cs = dt * A; \
            _Pragma("unroll") for (int off = 1; off < 64; off <<= 1) { const float t = __shfl_up(cs, off); if (lane >= off) cs += t; } \
            const float cs_last = __shfl(cs, 63); const float wgt = __expf(cs_last - cs) * dt; \
            if (wave == 0) { cs_[lane] = cs; cs_[64 + lane] = dt; } \
            _Pragma("unroll") for (int i = 0; i < 2; ++i) { const int pc = tid + 512 * i, s = pc >> 4, n0 = (pc & 15) * 8; \
                *(LAS v4u*)(Bl_ + s * 136 + n0) = rB[i]; *(LAS v4u*)(Cl_ + s * 136 + n0) = rC[i]; } \
            { const int l = tid >> 3, p0 = (tid & 7) * 8; const float wl = __shfl(wgt, l); \
              *(LAS v4u*)(Xl_ + l * 72 + p0) = rX; \
              v4u xs; xs.x = cvtpk(bflo(rX.x) * wl, bfhi(rX.x) * wl); xs.y = cvtpk(bflo(rX.y) * wl, bfhi(rX.y) * wl); xs.z = cvtpk(bflo(rX.z) * wl, bfhi(rX.z) * wl); xs.w = cvtpk(bflo(rX.w) * wl, bfhi(rX.w) * wl); \
              *(LAS v4u*)(Xw_ + l * 72 + p0) = xs; } } while (0)
        SSD_FETCH(0); SSD_STAGE(0); SSD_FETCH(1);
        __syncthreads();
        for (int ch = 0; ch < SEQ / 64; ++ch) {
            const size_t row0 = (size_t)b * SEQ + ch * 64;
            const LAS bf16* Bl = T0 + (ch & 1) * SET; const LAS bf16* Cl = Bl + 64 * 136; const LAS bf16* Xl = Cl + 64 * 136; const LAS bf16* Xw = Xl + 64 * 72; const LAS float* csl = (const LAS float*)(Xw + 64 * 72);
            const LAS bf16* Scur = Sl + (ch & 1) * (64 * 136); LAS bf16* Snxt = Sl + ((ch + 1) & 1) * (64 * 136);
            const size_t row = row0 + 16 * lb + fr;
            v2u zw[2];
#pragma unroll
            for (int pi = 0; pi < 2; ++pi) zw[pi] = *(const v2u*)(Z + row * 1536 + h * 64 + 16 * (2 * ph + pi) + 4 * fq);
            bf16x8 cf[4];
#pragma unroll
            for (int ks = 0; ks < 4; ++ks) cf[ks] = *(const LAS bf16x8*)(Cl + (16 * lb + fr) * 136 + 32 * ks + 8 * fq);
            const float cs_l = csl[16 * lb + fr];
            f32x4 gt[4];
#pragma unroll
            for (int sb = 0; sb < 4; ++sb) { gt[sb] = (f32x4){0.f, 0.f, 0.f, 0.f};
                if (sb <= lb) {
#pragma unroll
                    for (int ks = 0; ks < 4; ++ks) { const bf16x8 a = *(const LAS bf16x8*)(Bl + (16 * sb + fr) * 136 + 32 * ks + 8 * fq);
                        gt[sb] = __builtin_amdgcn_mfma_f32_16x16x32_bf16(a, cf[ks], gt[sb], 0, 0, 0); }
                    const f32x4 css = *(const LAS f32x4*)(csl + 16 * sb + 4 * fq), dts = *(const LAS f32x4*)(csl + 64 + 16 * sb + 4 * fq);
#pragma unroll
                    for (int e = 0; e < 4; ++e) { const int s = 16 * sb + 4 * fq + e, l = 16 * lb + fr;
                        gt[sb][e] = (s <= l) ? gt[sb][e] * __builtin_amdgcn_exp2f((cs_l - css[e]) * LOG2E) * dts[e] : 0.f; }
                } }
            bf16x8 mt[2];
#pragma unroll
            for (int kk = 0; kk < 2; ++kk) { v4u w; w.x = cvtpk(gt[2 * kk][0], gt[2 * kk][1]); w.y = cvtpk(gt[2 * kk][2], gt[2 * kk][3]);
                w.z = cvtpk(gt[2 * kk + 1][0], gt[2 * kk + 1][1]); w.w = cvtpk(gt[2 * kk + 1][2], gt[2 * kk + 1][3]); mt[kk] = __builtin_bit_cast(bf16x8, w); }
            const float el = __builtin_amdgcn_exp2f(cs_l * LOG2E);
#pragma unroll
            for (int pi = 0; pi < 2; ++pi) { const int pb = 2 * ph + pi;
                f32x4 y = {0.f, 0.f, 0.f, 0.f};
#pragma unroll
                for (int ks = 0; ks < 4; ++ks) { const bf16x8 a = *(const LAS bf16x8*)(Scur + (16 * pb + fr) * 136 + 32 * ks + 8 * fq);
                    y = __builtin_amdgcn_mfma_f32_16x16x32_bf16(a, cf[ks], y, 0, 0, 0); }
                y = y * el;
#pragma unroll
                for (int kk = 0; kk < 2; ++kk) if (2 * kk <= lb) {
                    const v2u lo = tr16(Xl + (32 * kk + 4 * fq + tq) * 72 + 16 * pb + 4 * tp), hi = tr16(Xl + (32 * kk + 16 + 4 * fq + tq) * 72 + 16 * pb + 4 * tp);
                    v4u aw; aw.x = lo.x; aw.y = lo.y; aw.z = hi.x; aw.w = hi.y;
                    y = __builtin_amdgcn_mfma_f32_16x16x32_bf16(__builtin_bit_cast(bf16x8, aw), mt[kk], y, 0, 0, 0); }
                const v2u xw = *(const LAS v2u*)(Xl + (16 * lb + fr) * 72 + 16 * pb + 4 * fq);
                const float o0 = (y[0] + Dh * bflo(xw.x)) * pg8::fast_silu(bflo(zw[pi].x)), o1 = (y[1] + Dh * bfhi(xw.x)) * pg8::fast_silu(bfhi(zw[pi].x));
                const float o2 = (y[2] + Dh * bflo(xw.y)) * pg8::fast_silu(bflo(zw[pi].y)), o3 = (y[3] + Dh * bfhi(xw.y)) * pg8::fast_silu(bfhi(zw[pi].y));
                v2u ow; ow.x = cvtpk(o0, o1); ow.y = cvtpk(o2, o3);
                *(v2u*)(YS + row * 1536 + h * 64 + 16 * pb + 4 * fq) = ow;
            }
            const float dec = __builtin_amdgcn_exp2f(csl[63] * LOG2E);
            bf16x8 ba[2];
#pragma unroll
            for (int ks = 0; ks < 2; ++ks) { const v2u lo = tr16(Bl + (32 * ks + 8 * fq + tq) * 136 + 16 * wave + 4 * tp), hi = tr16(Bl + (32 * ks + 8 * fq + 4 + tq) * 136 + 16 * wave + 4 * tp);
                v4u aw; aw.x = lo.x; aw.y = lo.y; aw.z = hi.x; aw.w = hi.y; ba[ks] = __builtin_bit_cast(bf16x8, aw); }
#pragma unroll
            for (int pb = 0; pb < 4; ++pb) { st[pb] = st[pb] * dec;
#pragma unroll
                for (int ks = 0; ks < 2; ++ks) { const v2u lo = tr16(Xw + (32 * ks + 8 * fq + tq) * 72 + 16 * pb + 4 * tp), hi = tr16(Xw + (32 * ks + 8 * fq + 4 + tq) * 72 + 16 * pb + 4 * tp);
                    v4u xv; xv.x = lo.x; xv.y = lo.y; xv.z = hi.x; xv.w = hi.y;
                    st[pb] = __builtin_amdgcn_mfma_f32_16x16x32_bf16(ba[ks], __builtin_bit_cast(bf16x8, xv), st[pb], 0, 0, 0); }
                v2u sw; sw.x = cvtpk(st[pb][0], st[pb][1]); sw.y = cvtpk(st[pb][2], st[pb][3]);
                *(LAS v2u*)(Snxt + (16 * pb + fr) * 136 + 16 * wave + 4 * fq) = sw; }
            if (ch + 1 < SEQ / 64) { SSD_STAGE((ch + 1) & 1); if (ch + 2 < SEQ / 64) SSD_FETCH(ch + 2); }
            BAR_LDS();
        }
#undef SSD_FETCH
#undef SSD_STAGE
    }
}
DI void ssd_finalize(const InTab in, unsigned char* ws, int gw, int NGW, int lane) {
    const bf16* YS = (const bf16*)(ws + WS_YSSD); bf16* Y = (bf16*)(ws + WS_A); const float* nw = in[18];
    for (int m = 2 * gw; m < M; m += 2 * NGW) {
        unsigned w[2][4][3];
#pragma unroll
        for (int r = 0; r < 2; ++r)
#pragma unroll
            for (int grp = 0; grp < 4; ++grp) { const unsigned* src = (const unsigned*)(YS + (size_t)(m + r) * 1536 + grp * 384) + lane * 3; w[r][grp][0] = src[0]; w[r][grp][1] = src[1]; w[r][grp][2] = src[2]; }
#pragma unroll
        for (int r = 0; r < 2; ++r)
#pragma unroll
            for (int grp = 0; grp < 4; ++grp) {
                const float v[6] = {bflo(w[r][grp][0]), bfhi(w[r][grp][0]), bflo(w[r][grp][1]), bfhi(w[r][grp][1]), bflo(w[r][grp][2]), bfhi(w[r][grp][2])};
                float s = 0.f;
#pragma unroll
                for (int j = 0; j < 6; ++j) s += v[j] * v[j];
                const float rstd = __builtin_amdgcn_rsqf(wave_sum(s) * (1.f / 384.f) + RMS_EPS);
                const float* g = nw + grp * 384 + lane * 6;
                unsigned* dst = (unsigned*)(Y + (size_t)(m + r) * D + 512 + grp * 384) + lane * 3;
                dst[0] = cvtpk(v[0] * rstd * g[0], v[1] * rstd * g[1]); dst[1] = cvtpk(v[2] * rstd * g[2], v[3] * rstd * g[3]); dst[2] = cvtpk(v[4] * rstd * g[4], v[5] * rstd * g[5]);
            }
    }
}
DI void swa_fast(const InTab in, unsigned char* ws, LAS unsigned char* lds, int bx, int G, int tid, int lane, int wave) {
    typedef short bf16x8 __attribute__((ext_vector_type(8)));
    const bf16* Q = (const bf16*)(ws + WS_Q); const bf16* Kb = (const bf16*)(ws + WS_K); const bf16* Vb = (const bf16*)(ws + WS_V); bf16* Y = (bf16*)(ws + WS_A);
    LAS bf16* Kl = (LAS bf16*)(lds + RING_OFF);
    LAS bf16* Vl = (LAS bf16*)(lds + RING_OFF + 192 * 144);
    const int fr = lane & 15, fq = lane >> 4, piece = tid & 7, tq = fr >> 2, tp = fr & 3;
    const int hql = wave >> 1, qo = (wave & 1) * 32, kb0 = qo >> 4;
    const float LOG2E = 1.4426950408889634f;
    float wk8[8], wq0[8], wq1[8];
#pragma unroll
    for (int j = 0; j < 8; ++j) { wk8[j] = in[27][piece * 8 + j]; wq0[j] = in[26][fq * 8 + j]; wq1[j] = in[26][32 + fq * 8 + j]; }
    v4u kw[3], vw[3], qw[2][2];
#define SWA_FETCH(u_) do { const int b_ = (u_) >> 8, kvh_ = ((u_) >> 6) & 3, t0_ = ((u_) & 63) * 64; \
        _Pragma("unroll") for (int i = 0; i < 3; ++i) { const int idx_ = (tid + 512 * i) >> 3, pos_ = t0_ - 128 + idx_; kw[i] = (v4u){0u, 0u, 0u, 0u}; vw[i] = (v4u){0u, 0u, 0u, 0u}; \
            if (pos_ >= 0) { const size_t r_ = (size_t)b_ * SEQ + pos_; kw[i] = *(const v4u*)(Kb + r_ * 256 + kvh_ * 64 + piece * 8); vw[i] = *(const v4u*)(Vb + r_ * 256 + kvh_ * 64 + piece * 8); } } \
        _Pragma("unroll") for (int qb = 0; qb < 2; ++qb) { const size_t r_ = (size_t)b_ * SEQ + t0_ + qo + qb * 16 + fr; \
            qw[qb][0] = *(const v4u*)(Q + r_ * 1024 + (kvh_ * 4 + hql) * 64 + fq * 8); qw[qb][1] = *(const v4u*)(Q + r_ * 1024 + (kvh_ * 4 + hql) * 64 + 32 + fq * 8); } } while (0)
    if (bx < BATCH * 4 * 64) SWA_FETCH(bx);
    for (int unit = bx; unit < BATCH * 4 * 64; unit += G) {
        const int b = unit >> 8, kvh = (unit >> 6) & 3, t0 = (unit & 63) * 64;
        const size_t row0 = (size_t)b * SEQ + t0;
        __syncthreads();
#pragma unroll
        for (int i = 0; i < 3; ++i) {
            const int pc = tid + 512 * i, idx = pc >> 3;
            const float k0 = bflo(kw[i].x), k1 = bfhi(kw[i].x), k2 = bflo(kw[i].y), k3 = bfhi(kw[i].y), k4 = bflo(kw[i].z), k5 = bfhi(kw[i].z), k6 = bflo(kw[i].w), k7 = bfhi(kw[i].w);
            float ss = (k0 * k0 + k1 * k1) + (k2 * k2 + k3 * k3) + (k4 * k4 + k5 * k5) + (k6 * k6 + k7 * k7);
            ss += __shfl_xor(ss, 1); ss += __shfl_xor(ss, 2); ss += __shfl_xor(ss, 4);
            const float rs = __builtin_amdgcn_rsqf(ss * (1.f / 64.f) + RMS_EPS);
            v4u o; o.x = cvtpk(k0 * rs * wk8[0], k1 * rs * wk8[1]); o.y = cvtpk(k2 * rs * wk8[2], k3 * rs * wk8[3]);
            o.z = cvtpk(k4 * rs * wk8[4], k5 * rs * wk8[5]); o.w = cvtpk(k6 * rs * wk8[6], k7 * rs * wk8[7]);
            *(LAS v4u*)(Kl + idx * 72 + piece * 8) = o;
            *(LAS v4u*)(Vl + idx * 72 + piece * 8) = vw[i];
        }
        const int hq = kvh * 4 + hql;
        bf16x8 qf[2][2];
#pragma unroll
        for (int qb = 0; qb < 2; ++qb) {
            const v4u w0 = qw[qb][0], w1 = qw[qb][1];
            const float a0 = bflo(w0.x), a1 = bfhi(w0.x), a2 = bflo(w0.y), a3 = bfhi(w0.y), a4 = bflo(w0.z), a5 = bfhi(w0.z), a6 = bflo(w0.w), a7 = bfhi(w0.w);
            const float c0 = bflo(w1.x), c1 = bfhi(w1.x), c2 = bflo(w1.y), c3 = bfhi(w1.y), c4 = bflo(w1.z), c5 = bfhi(w1.z), c6 = bflo(w1.w), c7 = bfhi(w1.w);
            float ss = (a0 * a0 + a1 * a1) + (a2 * a2 + a3 * a3) + (a4 * a4 + a5 * a5) + (a6 * a6 + a7 * a7) + (c0 * c0 + c1 * c1) + (c2 * c2 + c3 * c3) + (c4 * c4 + c5 * c5) + (c6 * c6 + c7 * c7);
            ss += __shfl_xor(ss, 16); ss += __shfl_xor(ss, 32);
            const float sc = __builtin_amdgcn_rsqf(ss * (1.f / 64.f) + RMS_EPS) * 0.125f * LOG2E;
            v4u p0, p1;
            p0.x = cvtpk(a0 * sc * wq0[0], a1 * sc * wq0[1]); p0.y = cvtpk(a2 * sc * wq0[2], a3 * sc * wq0[3]);
            p0.z = cvtpk(a4 * sc * wq0[4], a5 * sc * wq0[5]); p0.w = cvtpk(a6 * sc * wq0[6], a7 * sc * wq0[7]);
            p1.x = cvtpk(c0 * sc * wq1[0], c1 * sc * wq1[1]); p1.y = cvtpk(c2 * sc * wq1[2], c3 * sc * wq1[3]);
            p1.z = cvtpk(c4 * sc * wq1[4], c5 * sc * wq1[5]); p1.w = cvtpk(c6 * sc * wq1[6], c7 * sc * wq1[7]);
            qf[qb][0] = __builtin_bit_cast(bf16x8, p0); qf[qb][1] = __builtin_bit_cast(bf16x8, p1);
        }
        __syncthreads();
        if (unit + G < BATCH * 4 * 64) SWA_FETCH(unit + G);
        f32x4 s[10][2];
#pragma unroll
        for (int i = 0; i < 10; ++i) { s[i][0] = (f32x4){0.f, 0.f, 0.f, 0.f}; s[i][1] = (f32x4){0.f, 0.f, 0.f, 0.f}; }
#pragma unroll
        for (int i = 0; i < 10; ++i)
#pragma unroll
            for (int ks = 0; ks < 2; ++ks) { const bf16x8 a = *(const LAS bf16x8*)(Kl + ((kb0 + i) * 16 + fr) * 72 + ks * 32 + fq * 8);
                if (i < 9) s[i][0] = __builtin_amdgcn_mfma_f32_16x16x32_bf16(a, qf[0][ks], s[i][0], 0, 0, 0);
                if (i > 0) s[i][1] = __builtin_amdgcn_mfma_f32_16x16x32_bf16(a, qf[1][ks], s[i][1], 0, 0, 0); }
        const float sinkl = in[28][hq] * LOG2E;
        float linv[2];
#pragma unroll
        for (int qb = 0; qb < 2; ++qb) {
#pragma unroll
            for (int e = 0; e < 4; ++e) { if (!(4 * fq + e > fr)) s[qb][qb][e] = -INFINITY; if (!(4 * fq + e <= fr)) s[qb + 8][qb][e] = -INFINITY; }
            if (t0 < 128) {
#pragma unroll
                for (int d = 0; d < 9; ++d)
#pragma unroll
                    for (int e = 0; e < 4; ++e) if (t0 - 128 + (kb0 + qb + d) * 16 + 4 * fq + e < 0) s[qb + d][qb][e] = -INFINITY;
            }
            float mx = sinkl;
#pragma unroll
            for (int d = 0; d < 9; ++d) mx = fmaxf(mx, fmaxf(fmaxf(s[qb + d][qb][0], s[qb + d][qb][1]), fmaxf(s[qb + d][qb][2], s[qb + d][qb][3])));
            mx = fmaxf(mx, __shfl_xor(mx, 16)); mx = fmaxf(mx, __shfl_xor(mx, 32));
            float l = 0.f;
#pragma unroll
            for (int d = 0; d < 9; ++d)
#pragma unroll
                for (int e = 0; e < 4; ++e) { const float pv = __builtin_amdgcn_exp2f(s[qb + d][qb][e] - mx); s[qb + d][qb][e] = pv; l += pv; }
            l += __shfl_xor(l, 16); l += __shfl_xor(l, 32);
            l += __builtin_amdgcn_exp2f(sinkl - mx);
            linv[qb] = 1.0f / l;
        }
        s[9][0] = (f32x4){0.f, 0.f, 0.f, 0.f}; s[0][1] = (f32x4){0.f, 0.f, 0.f, 0.f};
        f32x4 o[4][2];
#pragma unroll
        for (int hb = 0; hb < 4; ++hb) { o[hb][0] = (f32x4){0.f, 0.f, 0.f, 0.f}; o[hb][1] = (f32x4){0.f, 0.f, 0.f, 0.f}; }
#pragma unroll
        for (int st = 0; st < 5; ++st) {
            bf16x8 pf[2];
#pragma unroll
            for (int qb = 0; qb < 2; ++qb) { v4u w; w.x = cvtpk(s[2 * st][qb][0], s[2 * st][qb][1]); w.y = cvtpk(s[2 * st][qb][2], s[2 * st][qb][3]);
                w.z = cvtpk(s[2 * st + 1][qb][0], s[2 * st + 1][qb][1]); w.w = cvtpk(s[2 * st + 1][qb][2], s[2 * st + 1][qb][3]); pf[qb] = __builtin_bit_cast(bf16x8, w); }
#pragma unroll
            for (int hb = 0; hb < 4; ++hb) {
                const v2u lo = tr16(Vl + ((kb0 + 2 * st) * 16 + 4 * fq + tq) * 72 + 16 * hb + 4 * tp), hi = tr16(Vl + ((kb0 + 2 * st + 1) * 16 + 4 * fq + tq) * 72 + 16 * hb + 4 * tp);
                v4u aw; aw.x = lo.x; aw.y = lo.y; aw.z = hi.x; aw.w = hi.y;
                const bf16x8 a = __builtin_bit_cast(bf16x8, aw);
                o[hb][0] = __builtin_amdgcn_mfma_f32_16x16x32_bf16(a, pf[0], o[hb][0], 0, 0, 0);
                o[hb][1] = __builtin_amdgcn_mfma_f32_16x16x32_bf16(a, pf[1], o[hb][1], 0, 0, 0); }
        }
#pragma unroll
        for (int qb = 0; qb < 2; ++qb) { const size_t r = row0 + qo + qb * 16 + fr;
#pragma unroll
            for (int hb = 0; hb < 4; ++hb) { const f32x4 v = o[hb][qb] * linv[qb]; v2u w; w.x = cvtpk(v[0], v[1]); w.y = cvtpk(v[2], v[3]);
                *(v2u*)(Y + r * D + hq * 64 + hb * 16 + 4 * fq) = w; } }
    }
#undef SWA_FETCH
}
DI void gla_pre(const InTab in, unsigned char* ws, LAS unsigned char* lds, int bx, int G, int tid, int lane, int wave) {
    typedef short bf16x8 __attribute__((ext_vector_type(8)));
    const bf16* QD = (const bf16*)(ws + WS_QD); const bf16* KD = (const bf16*)(ws + WS_KD); const float* GLR = (const float*)(ws + WS_GLR);
    bf16* QT = (bf16*)(ws + WS_QT); bf16* KTT = (bf16*)(ws + WS_KTT); bf16* ATT = (bf16*)(ws + WS_ATT); float* DEC = (float*)(ws + WS_DEC);
    LAS bf16* Ql = (LAS bf16*)(lds + RING_OFF);
    LAS bf16* Kl = Ql + 64 * 136;
    LAS float* gl = (LAS float*)(Kl + 64 * 136);
    LAS float* tot = gl + 64 * 16;
    const int fr = lane & 15, fq = lane >> 4, kc = tid & 127, sg = tid >> 7;
    constexpr int NU = BATCH * 64 * 4;
    if (bx >= NU) return;
    float w2n[16], gbn; f32x4 rgn; bf16 rqn[16], rkn[16];
#define GP_FETCH(u_) do { const int h_ = (u_) & 3, bc2_ = (u_) >> 2; const size_t r0_ = (size_t)(bc2_ >> 6) * SEQ + (size_t)(bc2_ & 63) * 64; \
        _Pragma("unroll") for (int r = 0; r < 16; ++r) w2n[r] = in[29][r * 512 + h_ * 128 + kc]; \
        gbn = in[30][h_ * 128 + kc]; \
        rgn = *(const f32x4*)(GLR + r0_ * 16 + (tid & 255) * 4); \
        _Pragma("unroll") for (int i = 0; i < 16; ++i) { rqn[i] = QD[(r0_ + 16 * sg + i) * 512 + h_ * 128 + kc]; rkn[i] = KD[(r0_ + 16 * sg + i) * 512 + h_ * 128 + kc]; } } while (0)
    GP_FETCH(bx);
    for (int unit = bx;; unit += G) {
        const int h = unit & 3, bc_ = unit >> 2, b = bc_ >> 6, c = bc_ & 63;
        const size_t row0 = (size_t)b * SEQ + c * 64;
        float w2[16]; bf16 rq[16], rk[16];
#pragma unroll
        for (int r = 0; r < 16; ++r) { w2[r] = w2n[r]; rq[r] = rqn[r]; rk[r] = rkn[r]; }
        const float gb = gbn; const f32x4 rg = rgn;
        GP_FETCH(unit + G < NU ? unit + G : unit);
        __syncthreads();
        if (tid < 256) *(LAS f32x4*)(gl + tid * 4) = rg;
        __syncthreads();
        float pre[16]; float run = 0.f;
#pragma unroll
        for (int i = 0; i < 16; ++i) { const LAS f32x4* gp = (const LAS f32x4*)(gl + (16 * sg + i) * 16); const f32x4 g0 = gp[0], g1 = gp[1], g2 = gp[2], g3 = gp[3];
            float x = gb;
#pragma unroll
            for (int e = 0; e < 4; ++e) x += g0[e] * w2[e] + g1[e] * w2[4 + e] + g2[e] * w2[8 + e] + g3[e] * w2[12 + e];
            const float ls = fminf(x, 0.f) - __logf(1.0f + __expf(-fabsf(x)));
            run += ls * (1.0f / 16.0f); pre[i] = run; }
        tot[sg * 128 + kc] = run;
        __syncthreads();
        const float t0 = tot[kc], t1 = tot[128 + kc], t2 = tot[256 + kc], t3 = tot[384 + kc];
        const float offs = (sg > 0 ? t0 : 0.f) + (sg > 1 ? t1 : 0.f) + (sg > 2 ? t2 : 0.f), blast = (t0 + t1) + (t2 + t3);
        if (sg == 0) DEC[(size_t)unit * 128 + kc] = __expf(blast);
        float k2[16];
#pragma unroll
        for (int i = 0; i < 16; ++i) { const int t = 16 * sg + i; const float bcv = pre[i] + offs;
            const float q = bf2f(rq[i]), k = bf2f(rk[i]);
            const float qt = q * __expf(bcv) * 0.08838834764831845f, kt = k * __expf(-bcv);
            k2[i] = k * __expf(blast - bcv);
            const bf16 qb = (bf16)f2bf(qt);
            QT[(row0 + t) * 512 + h * 128 + kc] = qb; Ql[t * 136 + kc] = qb; Kl[t * 136 + kc] = (bf16)f2bf(kt); }
        { v4u o0, o1; o0.x = cvtpk(k2[0], k2[1]); o0.y = cvtpk(k2[2], k2[3]); o0.z = cvtpk(k2[4], k2[5]); o0.w = cvtpk(k2[6], k2[7]);
          o1.x = cvtpk(k2[8], k2[9]); o1.y = cvtpk(k2[10], k2[11]); o1.z = cvtpk(k2[12], k2[13]); o1.w = cvtpk(k2[14], k2[15]);
          v4u* dst = (v4u*)(KTT + ((size_t)unit * 128 + kc) * 64 + 16 * sg); dst[0] = o0; dst[1] = o1; }
        __syncthreads();
#pragma unroll
        for (int ti = 0; ti < 2; ++ti) { const int tile = wave * 2 + ti, sb = tile >> 2, lb = tile & 3;
            f32x4 acc = {0.f, 0.f, 0.f, 0.f};
            if (sb <= lb) {
#pragma unroll
                for (int ks = 0; ks < 4; ++ks) { const bf16x8 a = *(const LAS bf16x8*)(Kl + (16 * sb + fr) * 136 + 32 * ks + 8 * fq), bq = *(const LAS bf16x8*)(Ql + (16 * lb + fr) * 136 + 32 * ks + 8 * fq);
                    acc = __builtin_amdgcn_mfma_f32_16x16x32_bf16(a, bq, acc, 0, 0, 0); }
            }
            const int l = 16 * lb + fr, s0 = 16 * sb + 4 * fq;
            v2u w; w.x = cvtpk(s0 <= l ? acc[0] : 0.f, s0 + 1 <= l ? acc[1] : 0.f); w.y = cvtpk(s0 + 2 <= l ? acc[2] : 0.f, s0 + 3 <= l ? acc[3] : 0.f);
            *(v2u*)(ATT + ((size_t)unit * 64 + l) * 64 + s0) = w; }
        if (unit + G >= NU) break;
    }
#undef GP_FETCH
}
DI void gla_seq(const InTab in, unsigned char* ws, LAS unsigned char* lds, int bx, int G, int tid, int lane, int wave) {
    typedef short bf16x8 __attribute__((ext_vector_type(8)));
    const bf16* VD = (const bf16*)(ws + WS_VD); const bf16* QT = (const bf16*)(ws + WS_QT); const bf16* KTT = (const bf16*)(ws + WS_KTT); const bf16* ATT = (const bf16*)(ws + WS_ATT);
    const float* DEC = (const float*)(ws + WS_DEC); bf16* GO = (bf16*)(ws + WS_GLAO);
    LAS bf16* vl0 = (LAS bf16*)(lds + RING_OFF);
    LAS bf16* ST = vl0 + 2 * 64 * 40;
    const int fr = lane & 15, fq = lane >> 4, lb = wave & 3, tq = fr >> 2, tp = fr & 3; const bool owave = wave < 4;
    for (int unit = bx; unit < BATCH * 32; unit += G) {
        const int b = unit >> 5, h = (unit >> 3) & 3, sl = unit & 7;
        f32x4 st[2]; st[0] = (f32x4){0.f, 0.f, 0.f, 0.f}; st[1] = (f32x4){0.f, 0.f, 0.f, 0.f};
        __syncthreads();
        for (int i = tid; i < 32 * 136 / 2; i += 512) ((LAS unsigned*)ST)[i] = 0u;
        v4u rV[2]; bf16x8 rA[2][2], rQ[2][4], rK[2][2]; f32x4 rD[2];
        rV[0] = rV[1] = (v4u){0u, 0u, 0u, 0u};
#pragma unroll
        for (int s_ = 0; s_ < 2; ++s_) {
#pragma unroll
            for (int ks = 0; ks < 2; ++ks) rA[s_][ks] = (bf16x8){0, 0, 0, 0, 0, 0, 0, 0};
#pragma unroll
            for (int ks = 0; ks < 4; ++ks) rQ[s_][ks] = (bf16x8){0, 0, 0, 0, 0, 0, 0, 0}; }
#define GLA_FETCH(set, chunk) do { const size_t r0_ = (size_t)b * SEQ + (size_t)(chunk) * 64; const size_t cu_ = (size_t)(b * 64 + (chunk)) * 4 + h; \
            if (tid < 256) rV[set] = *(const v4u*)(VD + (r0_ + (tid >> 2)) * 1024 + h * 256 + sl * 32 + (tid & 3) * 8); \
            _Pragma("unroll") for (int ks = 0; ks < 2; ++ks) rK[set][ks] = *(const bf16x8*)(KTT + (cu_ * 128 + 16 * wave + fr) * 64 + 32 * ks + 8 * fq); \
            if (owave) { _Pragma("unroll") for (int ks = 0; ks < 2; ++ks) rA[set][ks] = *(const bf16x8*)(ATT + (cu_ * 64 + 16 * lb + fr) * 64 + 32 * ks + 8 * fq); \
                _Pragma("unroll") for (int ks = 0; ks < 4; ++ks) rQ[set][ks] = *(const bf16x8*)(QT + (r0_ + 16 * lb + fr) * 512 + h * 128 + 32 * ks + 8 * fq); } \
            rD[set] = *(const f32x4*)(DEC + cu_ * 128 + 16 * wave + 4 * fq); } while (0)
#define GLA_STEP(set, chunk) do { const int ch_ = (chunk); const size_t row0 = (size_t)b * SEQ + (size_t)ch_ * 64; \
            const LAS bf16* vl = vl0 + (ch_ & 1) * (64 * 40); \
            bf16x8 wA[2], wQ[4], wK[2]; const f32x4 wD = rD[set]; \
            _Pragma("unroll") for (int ks = 0; ks < 2; ++ks) { wA[ks] = rA[set][ks]; wK[ks] = rK[set][ks]; } \
            _Pragma("unroll") for (int ks = 0; ks < 4; ++ks) wQ[ks] = rQ[set][ks]; \
            if (ch_ + 2 < SEQ / 64) GLA_FETCH(set, ch_ + 2); \
            const LAS bf16* Scur = ST + (ch_ & 1) * (32 * 136); LAS bf16* Snxt = ST + ((ch_ + 1) & 1) * (32 * 136); \
            bf16x8 vf[2][2]; \
            _Pragma("unroll") for (int d2 = 0; d2 < 2; ++d2) _Pragma("unroll") for (int ks = 0; ks < 2; ++ks) { \
                const v2u lo = tr16(vl + (32 * ks + 8 * fq + tq) * 40 + 16 * d2 + 4 * tp), hi = tr16(vl + (32 * ks + 8 * fq + 4 + tq) * 40 + 16 * d2 + 4 * tp); \
                v4u aw; aw.x = lo.x; aw.y = lo.y; aw.z = hi.x; aw.w = hi.y; vf[d2][ks] = __builtin_bit_cast(bf16x8, aw); } \
            if (owave) { _Pragma("unroll") for (int d2 = 0; d2 < 2; ++d2) { f32x4 o = {0.f, 0.f, 0.f, 0.f}, o2 = {0.f, 0.f, 0.f, 0.f}; \
                _Pragma("unroll") for (int ks = 0; ks < 2; ++ks) if (2 * ks <= lb) o = __builtin_amdgcn_mfma_f32_16x16x32_bf16(vf[d2][ks], wA[ks], o, 0, 0, 0); \
                _Pragma("unroll") for (int ks = 0; ks < 4; ++ks) { const bf16x8 a = *(const LAS bf16x8*)(Scur + (16 * d2 + fr) * 136 + 32 * ks + 8 * fq); \
                    if (ks & 1) o2 = __builtin_amdgcn_mfma_f32_16x16x32_bf16(a, wQ[ks], o2, 0, 0, 0); else o = __builtin_amdgcn_mfma_f32_16x16x32_bf16(a, wQ[ks], o, 0, 0, 0); } \
                o = o + o2; \
                v2u w; w.x = cvtpk(o[0], o[1]); w.y = cvtpk(o[2], o[3]); \
                *(v2u*)(GO + (row0 + 16 * lb + fr) * 1024 + h * 256 + sl * 32 + 16 * d2 + 4 * fq) = w; } } \
            _Pragma("unroll") for (int d2 = 0; d2 < 2; ++d2) { st[d2] = st[d2] * wD; \
                _Pragma("unroll") for (int ks = 0; ks < 2; ++ks) st[d2] = __builtin_amdgcn_mfma_f32_16x16x32_bf16(wK[ks], vf[d2][ks], st[d2], 0, 0, 0); \
                v2u sw; sw.x = cvtpk(st[d2][0], st[d2][1]); sw.y = cvtpk(st[d2][2], st[d2][3]); \
                *(LAS v2u*)(Snxt + (16 * d2 + fr) * 136 + 16 * wave + 4 * fq) = sw; } \
            if (tid < 256) *(LAS v4u*)(vl0 + ((ch_ + 1) & 1) * (64 * 40) + (tid >> 2) * 40 + (tid & 3) * 8) = rV[(set) ^ 1];     \
            BAR_LDS(); } while (0)
        GLA_FETCH(0, 0); GLA_FETCH(1, 1);
        if (tid < 256) *(LAS v4u*)(vl0 + (tid >> 2) * 40 + (tid & 3) * 8) = rV[0];
        __syncthreads();
        for (int ch = 0; ch < SEQ / 64; ch += 2) { GLA_STEP(0, ch); GLA_STEP(1, ch + 1); }
#undef GLA_FETCH
#undef GLA_STEP
    }
}
DI void gla_finalize(const InTab in, unsigned char* ws, int gw, int NGW, int lane) {
    const bf16* GO = (const bf16*)(ws + WS_GLAO); const bf16* GOUT = (const bf16*)(ws + WS_GOUT); bf16* Y = (bf16*)(ws + WS_A);
    const f32x4 g = *(const f32x4*)(in[31] + lane * 4);
    for (int m = 2 * gw; m < M; m += 2 * NGW) {
        v2u wo[2][4], wg[2][4];
#pragma unroll
        for (int r = 0; r < 2; ++r)
#pragma unroll
            for (int h = 0; h < 4; ++h) { wo[r][h] = *(const v2u*)(GO + (size_t)(m + r) * 1024 + h * 256 + lane * 4); wg[r][h] = *(const v2u*)(GOUT + (size_t)(m + r) * 1024 + h * 256 + lane * 4); }
#pragma unroll
        for (int r = 0; r < 2; ++r)
#pragma unroll
            for (int h = 0; h < 4; ++h) {
                const float v0 = bflo(wo[r][h].x), v1 = bfhi(wo[r][h].x), v2 = bflo(wo[r][h].y), v3 = bfhi(wo[r][h].y);
                const float rstd = __builtin_amdgcn_rsqf(wave_sum(v0 * v0 + v1 * v1 + v2 * v2 + v3 * v3) * (1.f / 256.f) + RMS_EPS);
                v2u o; o.x = cvtpk(v0 * rstd * g.x * silu_f(bflo(wg[r][h].x)), v1 * rstd * g.y * silu_f(bfhi(wg[r][h].x)));
                o.y = cvtpk(v2 * rstd * g.z * silu_f(bflo(wg[r][h].y)), v3 * rstd * g.w * silu_f(bfhi(wg[r][h].y)));
                *(v2u*)(Y + (size_t)(m + r) * D + 1024 + h * 256 + lane * 4) = o;
            }
    }
}
#define RT(base, first, ld) {(unsigned long long)(base) + 512ull * (unsigned long long)(first), (ld), 0}
__device__ const pg8::Route ROUTES[2][19] = {
  { RT(WS_U, 0, 512), RT(WS_U, 1, 512),
    RT(WS_Z, 0, 1536), RT(WS_Z, 1, 1536), RT(WS_Z, 2, 1536), RT(WS_Z, 3, 1536), RT(WS_Z, 4, 1536), RT(WS_Z, 5, 1536),
    RT(WS_XBC, 0, 2560), RT(WS_XBC, 1, 2560), RT(WS_XBC, 2, 2560), RT(WS_XBC, 3, 2560), RT(WS_XBC, 4, 2560), RT(WS_XBC, 5, 2560), RT(WS_XBC, 6, 2560), RT(WS_XBC, 7, 2560), RT(WS_XBC, 8, 2560), RT(WS_XBC, 9, 2560),
    RT(WS_DT, 0, 32) },
  { RT(WS_Q, 0, 1024), RT(WS_Q, 1, 1024), RT(WS_Q, 2, 1024), RT(WS_Q, 3, 1024),
    RT(WS_K, 0, 256), RT(WS_V, 0, 256),
    RT(WS_QD, 0, 512), RT(WS_QD, 1, 512), RT(WS_KD, 0, 512), RT(WS_KD, 1, 512),
    RT(WS_VD, 0, 1024), RT(WS_VD, 1, 1024), RT(WS_VD, 2, 1024), RT(WS_VD, 3, 1024),
    RT(WS_GOUT, 0, 1024), RT(WS_GOUT, 1, 1024), RT(WS_GOUT, 2, 1024), RT(WS_GOUT, 3, 1024),
    RT(WS_GLR, 0, 16) } };
#undef RT
constexpr bool USE_HB5 = XMANT < 7;
DI pg8::ssq_t* ssq(unsigned char* ws, int k) { return k == 0 ? (pg8::ssq_t*)(ws + WS_SS0) : (pg8::ssq_t*)(ws + WS_SS) + (size_t)(k - 1) * M; }
struct Args { const float* in[37]; float* out; unsigned char* ws; int ph_lo, ph_hi; };
#define IN(k) (lo <= (k) && (k) < hi)
#define SEAM(k) do { if (IN(k) && IN((k) + 1)) xcd_barrier(bar); } while (0)
template <int LAYER, int HF>
DI void ffn_half(const InTab in, float* out, unsigned char* ws, LAS unsigned char* lds, const XcdBarrier& bar, int G, int bx) {
    constexpr int MH = M / 2; constexpr size_t R0 = (size_t)HF * MH;
    bf16* HB = (bf16*)(ws + WS_HB) + R0 * D; bf16* Hh = (bf16*)(ws + WS_H) + R0 * FF;
    const bf16* W13 = (const bf16*)(ws + (LAYER ? WS_W13_1 : WS_W13_0)); const bf16* W2 = (const bf16*)(ws + (LAYER ? WS_W2_1 : WS_W2_0));
    { pg8::Gemm g{USE_HB5 ? (const bf16*)(ws + WS_HB5) + R0 * D : HB, W13, MH, 2 * FF, D}; pg8::RevOrder S; S.init(MH, 2 * FF, G, bx);
      pg8::EpiSwiGLU E{Hh, FF, ssq(ws, LAYER ? 3 : 1) + R0, 1.0f / D, RMS_EPS};
      pg8::gemm_phase<pg8::EpiSwiGLU, pg8::RevOrder, true, true>(lds + RING_OFF, g, S, E); }
    xcd_barrier(bar);
    { pg8::Gemm g{Hh, W2, MH, D, FF}; pg8::StaticOrder S; S.init(MH, D, G, bx);
      if (LAYER == 0) { pg8::EpiResidBf<false> E{nullptr, HB, D, ssq(ws, 2) + R0, nullptr};
          pg8::gemm_phase<pg8::EpiResidBf<false>, pg8::StaticOrder, true, true>(lds + RING_OFF, g, S, E); }
      else { pg8::EpiResidOut E{HB, out + R0 * D, D};
          pg8::gemm_phase<pg8::EpiResidOut, pg8::StaticOrder, true, true>(lds + RING_OFF, g, S, E); } }
}
template <int LAYER>
DI void layer_body(const InTab in, float* out, unsigned char* ws, LAS unsigned char* lds, const XcdBarrier& bar, int lo, int hi, int tid, int lane, int wave, int G, int bx) {
    constexpr int pb = LAYER * 9;
    const int gw = bx * NWAVES + wave, NGW = G * NWAVES, gt = bx * NWAVES * 64 + tid, NGT = G * NWAVES * 64;
    bf16* HB = (bf16*)(ws + WS_HB); bf16* YM = (bf16*)(ws + WS_A);
    const bf16* WIN = (const bf16*)(ws + (LAYER ? WS_WIN1 : WS_WIN0)); const bf16* WOUT = (const bf16*)(ws + (LAYER ? WS_WOUT1 : WS_WOUT0));
    const bf16* W13 = (const bf16*)(ws + (LAYER ? WS_W13_1 : WS_W13_0)); const bf16* W2 = (const bf16*)(ws + (LAYER ? WS_W2_1 : WS_W2_0));
    if (LAYER == 0) {
        if (IN(pb + 0)) { prologue(in, ws, lds, gw, NGW, lane, wave); s5_tables(in, ws, gt); x_to_hb_phase(in[0], HB, ssq(ws, 0), gw, NGW, lane); }
        SEAM(pb + 0);
    }
    if (IN(pb + 1)) {
        if (LAYER == 0) { s5_tables2(in, ws, lds, bx, G, tid); __syncthreads(); }
        pg8::Gemm g{HB, WIN, M, N_MAIN, D};
        pg8::EpiRoute E; E.ws = ws; E.tab = ROUTES[LAYER]; E.ftile = -1; E.fbase = nullptr; E.fld = 0; E.fcols = 0; E.ss = ssq(ws, LAYER ? 2 : 0); E.inv_n = 1.0f / D; E.eps = RMS_EPS;
        typedef typename std::conditional<LAYER == 0, pg8::TailOrder<2, pg8::StaticOrder>, pg8::TailOrder<1, pg8::RevOrder>>::type InOrder;
        InOrder S; S.init(M, N_MAIN, G, bx); S.A = HB; S.Bt = WIN + (size_t)N_MAIN * D; S.tail_pn = N_MAIN / 256 - 1; S.ss = ssq(ws, LAYER ? 2 : 0); S.inv_n = 1.0f / D; S.eps = RMS_EPS;
        if (LAYER == 0) { S.out = (float*)(ws + WS_DT); S.ldo = 32; S.ncols = 24; }
        else { S.out = (float*)(ws + WS_GLR); S.ldo = 16; S.ncols = 16; }
        pg8::gemm_phase<pg8::EpiRoute, InOrder, true, true>(lds + RING_OFF, g, S, E);
    }
    SEAM(pb + 1);
    if (IN(pb + 2)) {
        if (LAYER == 0) {
            const int ha = G / 4;
            if (bx < ha) s5_fast(in, ws, lds, bx, 64, ha, tid, lane, wave);
            else conv_phase(in, ws, (bx - ha) * NWAVES * 64 + tid, (G - ha) * NWAVES * 64);
        }
        else { gla_pre(in, ws, lds, bx, G, tid, lane, wave); __syncthreads(); swa_fast(in, ws, lds, bx, G, tid, lane, wave); }
    }
    SEAM(pb + 2);
    if (IN(pb + 3)) {
        if (LAYER == 0) { ssd_fast(in, ws, lds, bx, G, tid, lane, wave);
            const bool spare = G > 192;
            if (!spare || bx >= 192) s5_fast(in, ws, lds, 64 + (spare ? bx - 192 : bx), 256, spare ? G - 192 : G, tid, lane, wave); }
        else gla_seq(in, ws, lds, bx, G, tid, lane, wave);
    }
    SEAM(pb + 3);
    if (IN(pb + 4)) {
        if (LAYER == 0) {
            ssd_finalize(in, ws, gw, NGW, lane);
            __syncthreads();
            pg8::Gemm g{(const bf16*)(ws + WS_YPRE), (const bf16*)(ws + WS_GLUW), M, 512, 512}; pg8::StaticOrder S; S.init(M, 512, G, bx);
            pg8::EpiGLU E{(const bf16*)(ws + WS_YPRE), 512, YM, D, in[12]};
            pg8::gemm_phase<pg8::EpiGLU, pg8::StaticOrder, true, true>(lds + RING_OFF, g, S, E);
        } else gla_finalize(in, ws, gw, NGW, lane);
    }
    SEAM(pb + 4);
    if (IN(pb + 5)) {
        pg8::Gemm g{YM, WOUT, M, D, D}; pg8::StaticOrder S; S.init(M, D, G, bx);
        pg8::EpiResidBf<false, USE_HB5> E{nullptr, HB, D, ssq(ws, LAYER ? 3 : 1), (bf16*)(ws + WS_HB5)};
        pg8::gemm_phase<pg8::EpiResidBf<false, USE_HB5>, pg8::StaticOrder, true, true>(lds + RING_OFF, g, S, E);
    }
    if (IN(pb + 5) && IN(pb + 7)) xcd_barrier(bar);
    if (IN(pb + 7)) {
        ffn_half<LAYER, 0>(in, out, ws, lds, bar, G, bx);
        ffn_half<LAYER, 1>(in, out, ws, lds, bar, G, bx);
    }
    if (LAYER == 0) { if (IN(pb + 7) && IN(pb + 10)) xcd_barrier(bar); }
}
__global__ void __launch_bounds__(NWAVES * 64, 2) fwd(Args args) {
    extern __shared__ __attribute__((aligned(16))) unsigned char lds_raw[];
    LAS unsigned char* lds = (LAS unsigned char*)lds_raw;
    volatile LAS unsigned* MISC = (volatile LAS unsigned*)(lds + MISC_OFF);
    const int tid = threadIdx.x, lane = tid & 63, wave = __builtin_amdgcn_readfirstlane(tid >> 6);
    const int G = gridDim.x, bx = blockIdx.x;
    unsigned char* ws = args.ws;
    if (tid < 32) MISC[tid] = 0u;
    if (tid < 37) ((LAS unsigned long long*)(lds + PT_OFF))[tid] = (unsigned long long)args.in[tid];
    __syncthreads();
    InTab in; in.t = (const LAS unsigned long long*)(lds + PT_OFF);
    const int lo = args.ph_lo, hi = args.ph_hi;
    XcdBarrier bar; bar.bar = (unsigned*)(ws + WS_CTL) + CW_BAR; bar.x = 0; bar.st = nullptr;
    if (hi - lo > 1) bar = xcd_barrier_post((unsigned*)(ws + WS_CTL) + CW_BAR, MISC + 8);
    layer_body<0>(in, args.out, ws, lds, bar, lo, hi, tid, lane, wave, G, bx);
    layer_body<1>(in, args.out, ws, lds, bar, lo, hi, tid, lane, wave, G, bx);
}
#undef IN
#undef SEAM

extern "C" void kernel_launch(void* const* d_in, const int* in_sizes, int n_in, void* d_out, int out_size, void* d_ws, size_t ws_size, hipStream_t stream) {
    static int grid = 0;
    if (grid == 0) {
        if (n_in != 37 || in_sizes[0] != M * D || out_size != M * D || ws_size < WS_END) { fprintf(stderr, "kernel_launch: unexpected shapes (n_in %d, in0 %d, out %d, ws %zu)\n", n_in, n_in > 0 ? in_sizes[0] : -1, out_size, ws_size); grid = -1; return; }
        int dev = 0, cus = 0;
        if (hipGetDevice(&dev) != hipSuccess || hipDeviceGetAttribute(&cus, hipDeviceAttributeMultiprocessorCount, dev) != hipSuccess) { grid = -1; return; }
        if (hipFuncSetAttribute((const void*)fwd, hipFuncAttributeMaxDynamicSharedMemorySize, LDS_BYTES) != hipSuccess) { fprintf(stderr, "kernel_launch: hipFuncSetAttribute failed\n"); grid = -1; return; }
        int per_cu = 0;
        if (hipOccupancyMaxActiveBlocksPerMultiprocessor(&per_cu, (const void*)fwd, NWAVES * 64, LDS_BYTES) != hipSuccess || per_cu < 1) fprintf(stderr, "kernel_launch: occupancy query reports %d\n", per_cu);
        (void)hipGetLastError();
        grid = cus;
    }
    if (grid < 0) return;
    if (hipMemsetAsync((char*)d_ws + WS_CTL, 0, CTL_ZERO_BYTES, stream) != hipSuccess) return;
    Args a{};
    for (int i = 0; i < 37; ++i) a.in[i] = (const float*)d_in[i];
    a.out = (float*)d_out; a.ws = (unsigned char*)d_ws;
    a.ph_lo = 0; a.ph_hi = NPHASE;
    hipLaunchKernelGGL(fwd, dim3(grid), dim3(NWAVES * 64), LDS_BYTES, stream, a);
}
```

```cpp
#include <hip/hip_runtime.h>
#include <cstdio>
#include <cstdint>
#include <cmath>
#ifndef WM_IN
#define WM_IN 7
#endif
#ifndef WM_OUT
#define WM_OUT 7
#endif
#ifndef WM_FFN
#define WM_FFN 5
#endif
#ifndef AMANT
#define AMANT 7
#endif
#ifndef HMANT
#define HMANT 7
#endif
#ifndef XMANT
#define XMANT 7
#endif
namespace pg8 {
#define PG8_LAS __attribute__((address_space(3)))
typedef unsigned short bf16_t;
typedef short bf16x8 __attribute__((ext_vector_type(8)));
typedef float f32x4 __attribute__((ext_vector_type(4)));
typedef unsigned u32x4 __attribute__((ext_vector_type(4)));
constexpr int BM = 256, BK = 64, HALF = 128, HTB = HALF * BK * 2  , STAGE_BYTES = 8 * HTB, NXCD = 8, WGM = 8;

__host__ __device__ __forceinline__ int lds_byte(int r, int c) { const int st = (r >> 4) * 2 + (c >> 5), rr = r & 15, cc = c & 31, ob = rr * 64 + cc * 2; return st * 1024 + (ob ^ (((ob >> 9) & 1) << 5)); }
__host__ __device__ __forceinline__ void stage_rc(int b, int& R, int& C) { const int st = b / 1024, sb = b % 1024, swz = sb ^ (((sb >> 9) & 1) << 5); R = (st >> 1) * 16 + swz / 64; C = (st & 1) * 32 + (swz % 64) / 2; }
__host__ __device__ __forceinline__ int perm32(int rho) { const int n = rho >> 4, i = rho & 15; return 8 * (i >> 2) + 4 * n + (i & 3); }

struct Unit { int pm, pn; };
struct Gemm { const bf16_t* A; const bf16_t* Bt; int M, N, K; };

struct StaticOrder {
    int nM, nN, nwg, G, c;
    __host__ __device__ void init(int M, int N, int G_, int c_) { nM = M / BM; nN = N / BM; nwg = nM * nN; G = G_; c = c_; }
    __host__ __device__ bool next(int i, Unit& u) const {
        const long L = (long)i * G + c; if (L >= nwg) return false;
        int wgid = (int)L; { const int q = nwg / NXCD, r = nwg % NXCD, xcd = wgid % NXCD, off = wgid / NXCD; wgid = (xcd < r ? xcd * (q + 1) : r * (q + 1) + (xcd - r) * q) + off; }
        const int nig = WGM * nN, gid = wgid / nig, fm = gid * WGM, gsz = (nM - fm) < WGM ? (nM - fm) : WGM;
        u.pm = fm + ((wgid % nig) % gsz); u.pn = (wgid % nig) / gsz; return true;
    }
    __device__ __forceinline__ void a_ready(const Unit&) const {}
    __device__ __forceinline__ void done(const Unit&) const {}
};
__device__ __forceinline__ unsigned cvt_pk_bf16(float lo, float hi) { unsigned r; asm volatile("v_cvt_pk_bf16_f32 %0, %1, %2" : "=v"(r) : "v"(lo), "v"(hi)); return r; }
typedef unsigned long long ssq_t;
__device__ __forceinline__ float ssq_to_f(ssq_t q) { return ((float)(unsigned)(q >> 32) * 4294967296.0f + (float)(unsigned)q) * (1.0f / 16777216.0f); }
__device__ __forceinline__ ssq_t ssq_from_f(float s) { return (ssq_t)(s * 16777216.0f); }
struct RevOrder : StaticOrder {
    __host__ __device__ bool next(int i, Unit& u) const {
        const long L = (long)nwg - (long)G * (i + 1) + c; if (L < 0) return false;
        int wgid = (int)L; { const int q = nwg / NXCD, r = nwg % NXCD, xcd = wgid % NXCD, off = wgid / NXCD; wgid = (xcd < r ? xcd * (q + 1) : r * (q + 1) + (xcd - r) * q) + off; }
        const int nig = WGM * nN, gid = wgid / nig, fm = gid * WGM, gsz = (nM - fm) < WGM ? (nM - fm) : WGM;
        u.pm = fm + ((wgid % nig) % gsz); u.pn = (wgid % nig) / gsz; return true;
    }
};
template <int NB> struct TailOrder : StaticOrder {
    const bf16_t* A; const bf16_t* Bt; float* out; int ldo, ncols, tail_pn; const ssq_t* ss; float inv_n, eps;
    __device__ __forceinline__ void done(const Unit& u) const {
        if (u.pn != tail_pn) return;
        const int lane = threadIdx.x & 63, wave = __builtin_amdgcn_readfirstlane(threadIdx.x >> 6), fr = lane & 15, fq = lane >> 4;
        const int row0 = u.pm * BM + wave * 32;
        f32x4 c[2][NB];
#pragma unroll
        for (int rb = 0; rb < 2; ++rb)
#pragma unroll
            for (int nb = 0; nb < NB; ++nb) c[rb][nb] = (f32x4){0.f, 0.f, 0.f, 0.f};
        const bf16_t* ap = A + (size_t)(row0 + fr) * 2048 + 8 * fq; const bf16_t* bp = Bt + (size_t)fr * 2048 + 8 * fq;
#pragma unroll 1
        for (int kc = 0; kc < 64; kc += 8) {
            bf16x8 a0[8], a1[8], bb[NB][8];
#pragma unroll
            for (int j = 0; j < 8; ++j) { a0[j] = *(const bf16x8*)(ap + 32 * (kc + j)); a1[j] = *(const bf16x8*)(ap + 16 * 2048 + 32 * (kc + j));
#pragma unroll
                for (int nb = 0; nb < NB; ++nb) bb[nb][j] = *(const bf16x8*)(bp + (size_t)nb * 16 * 2048 + 32 * (kc + j)); }
#pragma unroll
            for (int j = 0; j < 8; ++j)
#pragma unroll
                for (int nb = 0; nb < NB; ++nb) { c[0][nb] = __builtin_amdgcn_mfma_f32_16x16x32_bf16(a0[j], bb[nb][j], c[0][nb], 0, 0, 0); c[1][nb] = __builtin_amdgcn_mfma_f32_16x16x32_bf16(a1[j], bb[nb][j], c[1][nb], 0, 0, 0); }
        }
        float rsv[2][4];
#pragma unroll
        for (int rb = 0; rb < 2; ++rb)
#pragma unroll
            for (int e = 0; e < 4; ++e) rsv[rb][e] = ss ? __builtin_amdgcn_rsqf(ssq_to_f(ss[row0 + 16 * rb + 4 * fq + e]) * inv_n + eps) : 1.0f;
#pragma unroll
        for (int rb = 0; rb < 2; ++rb)
#pragma unroll
            for (int e = 0; e < 4; ++e) { const int row = row0 + 16 * rb + 4 * fq + e; const float rs = rsv[rb][e];
#pragma unroll
                for (int nb = 0; nb < NB; ++nb) { const int col = 16 * nb + fr; if (col < ncols) out[(size_t)row * ldo + col] = c[rb][nb][e] * rs; } }
    }
};
__device__ __forceinline__ float rnd_am(float f) { if (AMANT >= 7) return f; constexpr int sh = 16 + (7 - AMANT); unsigned u = __builtin_bit_cast(unsigned, f); u = (u + ((1u << (sh - 1)) - 1u) + ((u >> sh) & 1u)) & ~((1u << sh) - 1u); return __builtin_bit_cast(float, u); }
template <int MB> __device__ __forceinline__ float rnd_m(float f) { if (MB >= 7) return f; constexpr int sh = 16 + (7 - (MB >= 7 ? 7 : MB)); unsigned u = __builtin_bit_cast(unsigned, f); u = (u + ((1u << (sh - 1)) - 1u) + ((u >> sh) & 1u)) & ~((1u << sh) - 1u); return __builtin_bit_cast(float, u); }
__device__ __forceinline__ float fast_silu(float x) { return x * __builtin_amdgcn_rcpf(1.0f + __expf(-x)); }
__device__ __forceinline__ float fast_sigmoid(float x) { return __builtin_amdgcn_rcpf(1.0f + __expf(-x)); }

struct Route { unsigned long long off; int ld; int pad; };
struct EpiRoute {
    static constexpr bool PERM = true, AFTER_DRAIN = false;
    unsigned char* ws; const Route* tab;
    float* fbase; int fld, fcols, ftile;
    const ssq_t* ss; float inv_n, eps;
    __device__ __forceinline__ void operator()(const f32x4 (&acc)[2][2][4][2], const Unit& u, int wr, int wc, int fr, int fq) const {
        const int row0 = u.pm * BM + wr * 64 + fr;
        float rs[2][4];
#pragma unroll
        for (int ai = 0; ai < 2; ++ai)
#pragma unroll
            for (int m = 0; m < 4; ++m) rs[ai][m] = ss ? __builtin_amdgcn_rsqf(ssq_to_f(ss[row0 + ai * HALF + m * 16]) * inv_n + eps) : 1.0f;
        if (u.pn == ftile) {
            if (wc == 0) {
#pragma unroll
                for (int ai = 0; ai < 2; ++ai)
#pragma unroll
                    for (int m = 0; m < 4; ++m) { float* rowp = fbase + (size_t)(row0 + ai * HALF + m * 16) * fld;
#pragma unroll
                        for (int n = 0; n < 2; ++n) { const int col = 8 * fq + 4 * n; if (col < fcols) *(f32x4*)(rowp + col) = acc[ai][0][m][n] * rs[ai][m]; } }
            }
            return;
        }
        const Route r = tab[u.pn];
        bf16_t* base = (bf16_t*)(ws + r.off); const int ld = r.ld;
        const int col0 = wc * 32 + 8 * fq;
#pragma unroll
        for (int ai = 0; ai < 2; ++ai)
#pragma unroll
            for (int m = 0; m < 4; ++m) { bf16_t* rowp = base + (size_t)(row0 + ai * HALF + m * 16) * ld + col0;
#pragma unroll
                for (int bj = 0; bj < 2; ++bj) { const f32x4 v0 = acc[ai][bj][m][0] * rs[ai][m], v1 = acc[ai][bj][m][1] * rs[ai][m];
                    u32x4 w; w.x = cvt_pk_bf16(v0[0], v0[1]); w.y = cvt_pk_bf16(v0[2], v0[3]); w.z = cvt_pk_bf16(v1[0], v1[1]); w.w = cvt_pk_bf16(v1[2], v1[3]);
                    *(u32x4*)(rowp + bj * HALF) = w; } }
    }
};

template <bool F32IN, bool COPY = false> struct EpiResidBf {
    static_assert(!F32IN, "the residual stream is read from hb");
    static constexpr bool PERM = true, AFTER_DRAIN = false;
    const float* xin; bf16_t* hb; int ldc; ssq_t* ss; bf16_t* hb5;
    __device__ __forceinline__ void load_half(u32x4 (&w)[4][2], int rbase, int col0) const {
#pragma unroll
        for (int m = 0; m < 4; ++m) { const size_t off = (size_t)(rbase + m * 16) * ldc + col0;
#pragma unroll
            for (int bj = 0; bj < 2; ++bj) w[m][bj] = *(const u32x4*)(hb + off + bj * HALF); }
    }
    __device__ __forceinline__ void store_half(const u32x4 (&w)[4][2], const f32x4 (&acc)[2][4][2], float (&sv)[4], int rbase, int col0) const {
#pragma unroll
        for (int m = 0; m < 4; ++m) { const size_t off = (size_t)(rbase + m * 16) * ldc + col0;
            float s = 0.f;
#pragma unroll
            for (int bj = 0; bj < 2; ++bj) { const u32x4 q = w[m][bj];
                const f32x4 r0 = {__uint_as_float(q.x << 16), __uint_as_float(q.x & 0xffff0000u), __uint_as_float(q.y << 16), __uint_as_float(q.y & 0xffff0000u)};
                const f32x4 r1 = {__uint_as_float(q.z << 16), __uint_as_float(q.z & 0xffff0000u), __uint_as_float(q.w << 16), __uint_as_float(q.w & 0xffff0000u)};
                const f32x4 v0 = r0 + acc[bj][m][0], v1 = r1 + acc[bj][m][1];
                s += (v0[0] * v0[0] + v0[1] * v0[1]) + (v0[2] * v0[2] + v0[3] * v0[3]) + (v1[0] * v1[0] + v1[1] * v1[1]) + (v1[2] * v1[2] + v1[3] * v1[3]);
                u32x4 o; o.x = cvt_pk_bf16(v0[0], v0[1]); o.y = cvt_pk_bf16(v0[2], v0[3]); o.z = cvt_pk_bf16(v1[0], v1[1]); o.w = cvt_pk_bf16(v1[2], v1[3]);
                *(u32x4*)(hb + off + bj * HALF) = o;
                if (COPY) { u32x4 c; c.x = cvt_pk_bf16(rnd_m<XMANT>(v0[0]), rnd_m<XMANT>(v0[1])); c.y = cvt_pk_bf16(rnd_m<XMANT>(v0[2]), rnd_m<XMANT>(v0[3])); c.z = cvt_pk_bf16(rnd_m<XMANT>(v1[0]), rnd_m<XMANT>(v1[1])); c.w = cvt_pk_bf16(rnd_m<XMANT>(v1[2]), rnd_m<XMANT>(v1[3]));
                    *(u32x4*)(hb5 + off + bj * HALF) = c; } }
            s += __shfl_xor(s, 16); s += __shfl_xor(s, 32); sv[m] = s; }
    }
    __device__ __forceinline__ void add_half(const float (&sv)[4], int rbase, int fq) const {
#pragma unroll
        for (int m = 0; m < 4; ++m) if (fq == 0) (void)__hip_atomic_fetch_add(ss + rbase + m * 16, ssq_from_f(sv[m]), __ATOMIC_RELAXED, __HIP_MEMORY_SCOPE_AGENT);
    }
    __device__ __forceinline__ void operator()(const f32x4 (&acc)[2][2][4][2], const Unit& u, int wr, int wc, int fr, int fq) const {
        const int row0 = u.pm * BM + wr * 64 + fr, col0 = u.pn * BM + wc * 32 + 8 * fq;
        u32x4 w0[4][2], w1[4][2]; float s0[4], s1[4];
        load_half(w0, row0, col0);
        store_half(w0, acc[0], s0, row0, col0);
        load_half(w1, row0 + HALF, col0);
        add_half(s0, row0, fq);
        store_half(w1, acc[1], s1, row0 + HALF, col0);
        add_half(s1, row0 + HALF, fq);
    }
};
struct EpiResidOut {
    static constexpr bool PERM = true, AFTER_DRAIN = false;
    const bf16_t* hb; float* out; int ldc;
    __device__ __forceinline__ void operator()(const f32x4 (&acc)[2][2][4][2], const Unit& u, int wr, int wc, int fr, int fq) const {
        const int row0 = u.pm * BM + wr * 64 + fr, col0 = u.pn * BM + wc * 32 + 8 * fq;
#pragma unroll
        for (int ai = 0; ai < 2; ++ai) {
            u32x4 w[4][2];
#pragma unroll
            for (int m = 0; m < 4; ++m) { const size_t off = (size_t)(row0 + ai * HALF + m * 16) * ldc + col0;
#pragma unroll
                for (int bj = 0; bj < 2; ++bj) w[m][bj] = *(const u32x4*)(hb + off + bj * HALF); }
#pragma unroll
            for (int m = 0; m < 4; ++m) { const size_t off = (size_t)(row0 + ai * HALF + m * 16) * ldc + col0;
#pragma unroll
                for (int bj = 0; bj < 2; ++bj) {
                    const f32x4 r0 = {__uint_as_float(w[m][bj].x << 16), __uint_as_float(w[m][bj].x & 0xffff0000u), __uint_as_float(w[m][bj].y << 16), __uint_as_float(w[m][bj].y & 0xffff0000u)};
                    const f32x4 r1 = {__uint_as_float(w[m][bj].z << 16), __uint_as_float(w[m][bj].z & 0xffff0000u), __uint_as_float(w[m][bj].w << 16), __uint_as_float(w[m][bj].w & 0xffff0000u)};
                    *(f32x4*)(out + off + bj * HALF) = r0 + acc[ai][bj][m][0]; *(f32x4*)(out + off + bj * HALF + 4) = r1 + acc[ai][bj][m][1]; } }
        }
    }
};

struct EpiSwiGLU {
    static constexpr bool PERM = true, AFTER_DRAIN = false;
    bf16_t* H; int ldc; const ssq_t* ss; float inv_n, eps;
    __device__ __forceinline__ void operator()(const f32x4 (&acc)[2][2][4][2], const Unit& u, int wr, int wc, int fr, int fq) const {
        const int row0 = u.pm * BM + wr * 64 + fr, col0 = u.pn * HALF + wc * 32 + 8 * fq;
        ssq_t q[2][4];
#pragma unroll
        for (int ai = 0; ai < 2; ++ai)
#pragma unroll
            for (int m = 0; m < 4; ++m) q[ai][m] = ss[row0 + ai * HALF + m * 16];
#pragma unroll
        for (int ai = 0; ai < 2; ++ai)
#pragma unroll
            for (int m = 0; m < 4; ++m) { bf16_t* rowp = H + (size_t)(row0 + ai * HALF + m * 16) * ldc + col0;
                const float rs = __builtin_amdgcn_rsqf(ssq_to_f(q[ai][m]) * inv_n + eps);
                float o[8];
#pragma unroll
                for (int n = 0; n < 2; ++n)
#pragma unroll
                    for (int e = 0; e < 4; ++e) o[4 * n + e] = rnd_m<HMANT>(fast_silu(acc[ai][0][m][n][e] * rs) * (acc[ai][1][m][n][e] * rs));
                u32x4 w; w.x = cvt_pk_bf16(o[0], o[1]); w.y = cvt_pk_bf16(o[2], o[3]); w.z = cvt_pk_bf16(o[4], o[5]); w.w = cvt_pk_bf16(o[6], o[7]);
                *(u32x4*)rowp = w; }
    }
};

struct EpiGLU {
    static constexpr bool PERM = true, AFTER_DRAIN = false;
    const bf16_t* Y; int ldy; bf16_t* O; int ldo; const float* bias;
    __device__ __forceinline__ void operator()(const f32x4 (&acc)[2][2][4][2], const Unit& u, int wr, int wc, int fr, int fq) const {
        const int row0 = u.pm * BM + wr * 64 + fr, col0 = u.pn * BM + wc * 32 + 8 * fq;
        f32x4 bv[2][2];
#pragma unroll
        for (int bj = 0; bj < 2; ++bj)
#pragma unroll
            for (int n = 0; n < 2; ++n) bv[bj][n] = *(const f32x4*)(bias + col0 + bj * HALF + 4 * n);
#pragma unroll
        for (int ai = 0; ai < 2; ++ai) {
          u32x4 yy[4][2];
#pragma unroll
          for (int m = 0; m < 4; ++m)
#pragma unroll
              for (int bj = 0; bj < 2; ++bj) yy[m][bj] = *(const u32x4*)(Y + (size_t)(row0 + ai * HALF + m * 16) * ldy + col0 + bj * HALF);
#pragma unroll
            for (int m = 0; m < 4; ++m) { const size_t r = (size_t)(row0 + ai * HALF + m * 16);
#pragma unroll
                for (int bj = 0; bj < 2; ++bj) { const u32x4 yv = yy[m][bj];
                    const f32x4 g0 = acc[ai][bj][m][0] + bv[bj][0], g1 = acc[ai][bj][m][1] + bv[bj][1];
                    float o[8];
                    o[0] = __uint_as_float(yv.x << 16) * fast_sigmoid(g0[0]); o[1] = __uint_as_float(yv.x & 0xffff0000u) * fast_sigmoid(g0[1]);
                    o[2] = __uint_as_float(yv.y << 16) * fast_sigmoid(g0[2]); o[3] = __uint_as_float(yv.y & 0xffff0000u) * fast_sigmoid(g0[3]);
                    o[4] = __uint_as_float(yv.z << 16) * fast_sigmoid(g1[0]); o[5] = __uint_as_float(yv.z & 0xffff0000u) * fast_sigmoid(g1[1]);
                    o[6] = __uint_as_float(yv.w << 16) * fast_sigmoid(g1[2]); o[7] = __uint_as_float(yv.w & 0xffff0000u) * fast_sigmoid(g1[3]);
                    u32x4 w; w.x = cvt_pk_bf16(o[0], o[1]); w.y = cvt_pk_bf16(o[2], o[3]); w.z = cvt_pk_bf16(o[4], o[5]); w.w = cvt_pk_bf16(o[6], o[7]);
                    *(u32x4*)(O + r * ldo + col0 + bj * HALF) = w; } }
        }
    }
};
template <class Epi, class Sched, bool ALIGN_EPI = false, bool SP2 = false>
__device__ __forceinline__ void gemm_phase(PG8_LAS unsigned char* lds, const Gemm g, const Sched& S, const Epi& E) {
    const int tid = threadIdx.x, wid = __builtin_amdgcn_readfirstlane(tid >> 6), lane = tid & 63, wr = wid >> 2, wc = wid & 3, fr = lane & 15, fq = lane >> 4;
    const int K = g.K, nt = K / BK;
    unsigned voffA[2], voffB[2];
#pragma unroll
    for (int i = 0; i < 2; ++i) { int R, C; stage_rc(tid * 16 + i * 8192, R, C); const int Rb = Epi::PERM ? ((R & ~31) + perm32(R & 31)) : R;
        voffA[i] = (unsigned)(R * K + C) * 2u; voffB[i] = (unsigned)(Rb * K + C) * 2u; }
    const size_t kstep = (size_t)(BK * 2);
    const size_t hstep = (size_t)HALF * K * 2;
    const size_t tstep = 2 * hstep;
    const unsigned ldsw = (unsigned)wid * 1024u;
    const int aoff = lds_byte(wr * 64 + fr, fq * 8), boff = lds_byte(wc * 32 + fr, fq * 8);
#define PG8_SA(b, h) (((b) * 2 + (h)) * HTB)
#define PG8_SB(b, h) ((4 + (b) * 2 + (h)) * HTB)
#define PG8_STAGE(bufoff, gbase, voff) do { _Pragma("unroll") for (int _i = 0; _i < 2; ++_i) \
        __builtin_amdgcn_global_load_lds((const unsigned*)((const char*)(gbase) + (voff)[_i]), (PG8_LAS unsigned*)(lds + (bufoff) + ldsw + _i * 8192), 16, 0, 0); } while (0)
#define PG8_LDA(dst, b, h) do { _Pragma("unroll") for (int m = 0; m < 4; ++m) _Pragma("unroll") for (int k = 0; k < 2; ++k) dst[m][k] = *(const PG8_LAS bf16x8*)(lds + PG8_SA(b, h) + aoff + m * 2048 + k * 1024); } while (0)
#define PG8_LDB(dst, b, h) do { _Pragma("unroll") for (int n = 0; n < 2; ++n) _Pragma("unroll") for (int k = 0; k < 2; ++k) dst[n][k] = *(const PG8_LAS bf16x8*)(lds + PG8_SB(b, h) + boff + n * 2048 + k * 1024); } while (0)
#define PG8_MMA(ai, bj, At, Bt) do { __builtin_amdgcn_s_setprio(1); _Pragma("unroll") for (int m = 0; m < 4; ++m) _Pragma("unroll") for (int n = 0; n < 2; ++n) _Pragma("unroll") for (int k = 0; k < 2; ++k) \
        acc[ai][bj][m][n] = __builtin_amdgcn_mfma_f32_16x16x32_bf16(Bt[n][k], At[m][k], acc[ai][bj][m][n], 0, 0, 0); __builtin_amdgcn_s_setprio(0); } while (0)
#define PG8_WAIT_V(n) asm volatile("s_waitcnt vmcnt(" #n ")" ::: "memory")
#define PG8_WAIT_L(n) asm volatile("s_waitcnt lgkmcnt(" #n ")" ::: "memory")
#define PG8_BAR __builtin_amdgcn_s_barrier()
#define PG8_SCHED __builtin_amdgcn_sched_barrier(0)
    Unit cur, nxt; int ui = 0;
    if (!S.next(0, cur)) return;
    f32x4 acc[2][2][4][2];
#pragma unroll
    for (int a = 0; a < 2; ++a)
#pragma unroll
        for (int b = 0; b < 2; ++b)
#pragma unroll
            for (int m = 0; m < 4; ++m)
#pragma unroll
                for (int n = 0; n < 2; ++n) acc[a][b][m][n] = (f32x4){0.f, 0.f, 0.f, 0.f};
    bf16x8 At[4][2], B0[2][2], B1[2][2];
    const char* cA = (const char*)g.A + (size_t)cur.pm * tstep; const char* cB = (const char*)g.Bt + (size_t)cur.pn * tstep;
    S.a_ready(cur);
    if constexpr (SP2) {
        PG8_STAGE(PG8_SB(0, 0), cB, voffB); PG8_STAGE(PG8_SB(0, 1), cB + hstep, voffB); PG8_STAGE(PG8_SA(0, 0), cA, voffA); PG8_STAGE(PG8_SA(0, 1), cA + hstep, voffA);
        if (wr == 1) PG8_BAR;
        PG8_WAIT_V(2); PG8_BAR;
        PG8_STAGE(PG8_SB(1, 0), cB + kstep, voffB); PG8_STAGE(PG8_SA(1, 0), cA + kstep, voffA); PG8_STAGE(PG8_SB(1, 1), cB + hstep + kstep, voffB);
        PG8_WAIT_V(6); PG8_BAR;
    } else {
        PG8_STAGE(PG8_SB(0, 0), cB, voffB); PG8_STAGE(PG8_SA(0, 0), cA, voffA); PG8_STAGE(PG8_SB(0, 1), cB + hstep, voffB); PG8_STAGE(PG8_SA(0, 1), cA + hstep, voffA);
        if (wr == 1) PG8_BAR;
        PG8_WAIT_V(4); PG8_BAR;
        PG8_STAGE(PG8_SB(1, 0), cB + kstep, voffB); PG8_STAGE(PG8_SA(1, 0), cA + kstep, voffA); PG8_STAGE(PG8_SB(1, 1), cB + hstep + kstep, voffB);
        PG8_WAIT_V(6); PG8_BAR;
    }
    for (;;) {
        const bool has_next = S.next(ui + 1, nxt);
        const char* nA = has_next ? (const char*)g.A + (size_t)nxt.pm * tstep : cA; const char* nB = has_next ? (const char*)g.Bt + (size_t)nxt.pn * tstep : cB;
        for (int t = 0; t < nt; t += 2) {
            const bool last = (t == nt - 2);
            const char* a1 = cA + (size_t)(t + 1) * kstep;
            const char* a2 = last ? nA : cA + (size_t)(t + 2) * kstep; const char* b2 = last ? nB : cB + (size_t)(t + 2) * kstep;
            const char* a3 = a2 + kstep; const char* b3 = b2 + kstep;
            if (last && has_next) S.a_ready(nxt);
            if constexpr (SP2) {
            PG8_LDB(B0, 0, 0); PG8_LDB(B1, 0, 1); PG8_SCHED; PG8_LDA(At, 0, 0); PG8_STAGE(PG8_SA(1, 1), a1 + hstep, voffA);
            PG8_WAIT_V(8); PG8_WAIT_L(0); PG8_BAR; PG8_MMA(0, 0, At, B0); PG8_MMA(0, 1, At, B1); PG8_BAR; PG8_SCHED;
            PG8_LDA(At, 0, 1); PG8_STAGE(PG8_SB(0, 0), b2, voffB); PG8_STAGE(PG8_SB(0, 1), b2 + hstep, voffB); PG8_STAGE(PG8_SA(0, 0), a2, voffA);
            PG8_WAIT_V(8); PG8_WAIT_L(0); PG8_BAR; PG8_MMA(1, 0, At, B0); PG8_MMA(1, 1, At, B1); PG8_BAR; PG8_SCHED;
            PG8_LDB(B0, 1, 0); PG8_LDB(B1, 1, 1); PG8_SCHED; PG8_LDA(At, 1, 0); PG8_STAGE(PG8_SA(0, 1), a2 + hstep, voffA);
            PG8_WAIT_V(8); PG8_WAIT_L(0); PG8_BAR; PG8_MMA(0, 0, At, B0); PG8_MMA(0, 1, At, B1); PG8_BAR; PG8_SCHED;
            PG8_LDA(At, 1, 1); PG8_STAGE(PG8_SB(1, 0), b3, voffB); PG8_STAGE(PG8_SB(1, 1), b3 + hstep, voffB); PG8_STAGE(PG8_SA(1, 0), a3, voffA);
            PG8_WAIT_V(8); PG8_WAIT_L(0); PG8_BAR; PG8_MMA(1, 0, At, B0); PG8_MMA(1, 1, At, B1); PG8_BAR; PG8_SCHED;
            } else {
            PG8_LDB(B0, 0, 0); PG8_SCHED; PG8_LDA(At, 0, 0); PG8_STAGE(PG8_SA(1, 1), a1 + hstep, voffA);
            PG8_WAIT_L(8); PG8_BAR; PG8_WAIT_L(0); PG8_MMA(0, 0, At, B0); PG8_BAR; PG8_SCHED;
            PG8_LDB(B1, 0, 1); PG8_STAGE(PG8_SB(0, 0), b2, voffB);
            PG8_BAR; PG8_WAIT_L(0); PG8_MMA(0, 1, At, B1); PG8_BAR;
            PG8_LDA(At, 0, 1); PG8_STAGE(PG8_SA(0, 0), a2, voffA);
            PG8_BAR; PG8_WAIT_L(0); PG8_MMA(1, 0, At, B0); PG8_BAR; PG8_SCHED;
            PG8_STAGE(PG8_SB(0, 1), b2 + hstep, voffB);
            PG8_WAIT_V(6); PG8_BAR; PG8_MMA(1, 1, At, B1); PG8_BAR;
            PG8_LDB(B0, 1, 0); PG8_SCHED; PG8_LDA(At, 1, 0); PG8_STAGE(PG8_SA(0, 1), a2 + hstep, voffA);
            PG8_WAIT_L(8); PG8_BAR; PG8_WAIT_L(0); PG8_MMA(0, 0, At, B0); PG8_BAR; PG8_SCHED;
            PG8_LDB(B1, 1, 1); PG8_STAGE(PG8_SB(1, 0), b3, voffB);
            PG8_BAR; PG8_WAIT_L(0); PG8_MMA(0, 1, At, B1); PG8_BAR;
            PG8_LDA(At, 1, 1); PG8_STAGE(PG8_SA(1, 0), a3, voffA);
            PG8_BAR; PG8_WAIT_L(0); PG8_MMA(1, 0, At, B0); PG8_BAR; PG8_SCHED;
            PG8_STAGE(PG8_SB(1, 1), b3 + hstep, voffB);
            PG8_WAIT_V(6); PG8_BAR; PG8_MMA(1, 1, At, B1); PG8_BAR;
            }
        }
        if constexpr (ALIGN_EPI) { if (wr == 0) PG8_BAR; }
        if constexpr (!Epi::AFTER_DRAIN) { E(acc, cur, wr, wc, fr, fq); S.done(cur); }
        if (!has_next) break;
#pragma unroll
        for (int a = 0; a < 2; ++a)
#pragma unroll
            for (int b = 0; b < 2; ++b)
#pragma unroll
                for (int m = 0; m < 4; ++m)
#pragma unroll
                    for (int n = 0; n < 2; ++n) acc[a][b][m][n] = (f32x4){0.f, 0.f, 0.f, 0.f};
        cur = nxt; cA = nA; cB = nB; ++ui;
        if constexpr (ALIGN_EPI) { if (wr == 1) PG8_BAR; }
    }
    PG8_WAIT_V(0);
    if constexpr (!ALIGN_EPI) { if (wr == 0) PG8_BAR; }
    PG8_BAR;
    if constexpr (Epi::AFTER_DRAIN) { E.fused(acc, cur, wr, wc, fr, fq, lds, wid, lane); S.done(cur); }
#undef PG8_SA
#undef PG8_SB
#undef PG8_STAGE
#undef PG8_LDA
#undef PG8_LDB
#undef PG8_MMA
#undef PG8_WAIT_V
#undef PG8_WAIT_L
#undef PG8_BAR
#undef PG8_SCHED
}
}

constexpr int NWAVES = 8;
constexpr int D = 2048, BATCH = 8, SEQ = 4096, M = BATCH * SEQ, FF = 5632;
constexpr int N_IN0 = 4632, N_IN1 = 4624, N_INP = 4640, N_MAIN = 4608;
constexpr float RMS_EPS = 1e-6f;
constexpr int NPHASE = 18;

constexpr size_t MiB = 1u << 20;
constexpr size_t WS_CTL = 0, CTL_ZERO_BYTES = 1 * MiB;
constexpr size_t WS_TAB = 1 * MiB;
constexpr size_t WS_WIN0 = 8 * MiB, WS_WOUT0 = 27 * MiB, WS_W13_0 = 35 * MiB, WS_W2_0 = 79 * MiB;
constexpr size_t WS_WIN1 = 101 * MiB, WS_WOUT1 = 120 * MiB, WS_W13_1 = 128 * MiB, WS_W2_1 = 172 * MiB, WS_GLUW = 194 * MiB;
constexpr size_t WS_A = 200 * MiB;
constexpr size_t WS_B = 360 * MiB;
constexpr size_t WS_U = WS_B, WS_Z = WS_B + 32 * MiB, WS_XBC = WS_B + 128 * MiB, WS_DT = WS_B + 288 * MiB, WS_YPRE = WS_B + 292 * MiB, WS_YSSD = WS_XBC;
constexpr size_t WS_Q = WS_B, WS_K = WS_B + 64 * MiB, WS_V = WS_B + 80 * MiB, WS_QD = WS_B + 96 * MiB, WS_KD = WS_B + 128 * MiB, WS_VD = WS_B + 160 * MiB,
                 WS_GOUT = WS_B + 224 * MiB, WS_GLR = WS_B + 288 * MiB, WS_GLAO = WS_B + 292 * MiB;
constexpr size_t WS_QT = 328 * MiB;
constexpr size_t WS_KTT = WS_B + 356 * MiB, WS_ATT = WS_B + 388 * MiB, WS_DEC = WS_B + 404 * MiB;
constexpr size_t WS_H = WS_B;
constexpr size_t WS_HB = 768 * MiB;
constexpr size_t WS_HB5 = 896 * MiB;
constexpr size_t WS_END = (XMANT < 7 ? 1024 : 896) * MiB;
constexpr int CW_BAR = 4096;
constexpr size_t WS_SS = 131072;
constexpr size_t WS_SS0 = 8 * MiB - 262144;
constexpr size_t TAB_TOEP = 0, TAB_QM = 4 * MiB, TAB_ABARD = 6 * MiB, TAB_BTD = 6 * MiB + 65536, TAB_A16 = 6 * MiB + 65536 + 524288;
constexpr size_t WS_PM = 195 * MiB;
constexpr size_t WS_POW = 198 * MiB;

constexpr int RING_OFF = 0, RING_BYTES = 131072;
constexpr int LDS_BYTES = 147456;
constexpr int MISC_OFF = LDS_BYTES - 1024;
constexpr int PT_OFF = MISC_OFF + 512;

#define GAS __attribute__((address_space(1)))
#define LAS __attribute__((address_space(3)))
typedef unsigned short bf16;
typedef unsigned v4u __attribute__((ext_vector_type(4)));
typedef unsigned v2u __attribute__((ext_vector_type(2)));
typedef float f32x4 __attribute__((ext_vector_type(4)));
typedef float f32x2 __attribute__((ext_vector_type(2)));
typedef GAS unsigned gu32;
#define RLX_AGENT __ATOMIC_RELAXED, __HIP_MEMORY_SCOPE_AGENT
#define LDS_WAIT() asm volatile("s_waitcnt lgkmcnt(0)" ::: "memory")
#define VM_WAIT() asm volatile("s_waitcnt vmcnt(0)" ::: "memory")
#define DI __device__ __forceinline__
#define BAR_LDS() do { asm volatile("s_waitcnt lgkmcnt(0)" ::: "memory"); __builtin_amdgcn_s_barrier(); asm volatile("" ::: "memory"); } while (0)
DI unsigned f2bf(float f) { unsigned u = __builtin_bit_cast(unsigned, f); return (u + 0x7fffu + ((u >> 16) & 1u)) >> 16; }
DI unsigned pk2(float lo, float hi) { return f2bf(lo) | (f2bf(hi) << 16); }
typedef __bf16 bf16x2_t __attribute__((ext_vector_type(2)));
DI unsigned cvtpk(float lo, float hi) { const f32x2 v = {lo, hi}; const bf16x2_t b = __builtin_convertvector(v, bf16x2_t); return __builtin_bit_cast(unsigned, b); }
DI float bflo(unsigned w) { return __uint_as_float(w << 16); }
DI float bfhi(unsigned w) { return __uint_as_float(w & 0xffff0000u); }
DI float bf2f(bf16 b) { return __uint_as_float((unsigned)b << 16); }
DI float wave_sum(float v) {
#pragma unroll
    for (int o = 1; o < 64; o <<= 1) v += __shfl_xor(v, o);
    return v;
}
DI float wave_max(float v) {
#pragma unroll
    for (int o = 1; o < 64; o <<= 1) v = fmaxf(v, __shfl_xor(v, o));
    return v;
}
DI float silu_f(float x) { return x * __builtin_amdgcn_rcpf(1.0f + __expf(-x)); }
DI float gelu_tanh_f(float x) { const float z = 0.7978845608028654f * (x + 0.044715f * x * x * x); const float t = 1.0f - 2.0f * __builtin_amdgcn_rcpf(__expf(2.0f * z) + 1.0f); return 0.5f * x * (1.0f + t); }
DI float softplus_f(float x) { const float e = __expf(-fabsf(x)); const float l = e < 0.01f ? e * (1.0f - e * (0.5f - e * 0.33333333f)) : __logf(1.0f + e); return fmaxf(x, 0.f) + l; }

typedef short v4i16_t __attribute__((ext_vector_type(4)));
DI v2u tr16(const LAS bf16* p) { return __builtin_bit_cast(v2u, __builtin_amdgcn_ds_read_tr16_b64_v4i16((LAS v4i16_t*)p)); }
struct InTab { const LAS unsigned long long* t;
    DI const float* operator[](int i) const { const unsigned long long v = t[i];
        const unsigned lo = __builtin_amdgcn_readfirstlane((unsigned)v), hi = __builtin_amdgcn_readfirstlane((unsigned)(v >> 32));
        return (const float*)(const GAS float*)(((unsigned long long)hi << 32) | lo); } };
#define XB_TMO      128
#define XB_XCNT(j)  (256  + 64 * (j))
#define XB_XSUB(j)  (1280 + 64 * (j))
#define XB_XGEN(j)  (2304 + 64 * (j))
#define XB_TOP      3328
#define XB_TOPGEN   3392
#define XCD_BAR_WORDS 3456
#define XB_SPIN_CAP (1u << 18)

__device__ __forceinline__ unsigned xb_ld(unsigned* p)              { return __hip_atomic_load(p, __ATOMIC_RELAXED, __HIP_MEMORY_SCOPE_AGENT); }
__device__ __forceinline__ unsigned xb_add(unsigned* p, unsigned v) { return __hip_atomic_fetch_add(p, v, __ATOMIC_RELAXED, __HIP_MEMORY_SCOPE_AGENT); }
__device__ __forceinline__ unsigned xb_xcc_id() { return (unsigned)__builtin_amdgcn_s_getreg((3 << 11) | 20) & 0xFu; }
#define XB_SPIN(cond, bar) do { unsigned _sp = 0; while (cond) { __builtin_amdgcn_s_sleep(1); \
    if ((++_sp & 255u) == 0u) { if (xb_ld(&(bar)[XB_TMO])) break; if (_sp > XB_SPIN_CAP) { atomicAdd(&(bar)[XB_TMO], 1u); break; } } } } while (0)

struct XcdBarrier {
    unsigned* bar; unsigned x;
    volatile LAS unsigned* st;
};

__device__ __forceinline__ XcdBarrier xcd_barrier_post(unsigned* bar, volatile LAS unsigned* st) {
    XcdBarrier b; b.bar = bar; b.x = xb_xcc_id(); b.st = st;
    if (threadIdx.x == 0) (void)xb_add(&bar[XB_XCNT(b.x)], 1u);
    return b;
}
__device__ __forceinline__ void xcd_barrier_complete(unsigned* bar, unsigned x, unsigned& nloc, unsigned& nx) {
    const unsigned G = gridDim.x * gridDim.y * gridDim.z;
    unsigned sum, cnt, mine, sp = 0u;
    for (;;) {
        sum = 0u; cnt = 0u; mine = 0u;
#pragma unroll
        for (unsigned j = 0; j < 16; ++j) { const unsigned c = xb_ld(&bar[XB_XCNT(j)]); sum += c; cnt += (c > 0u) ? 1u : 0u; mine = (j == x) ? c : mine; }
        if (sum == G) break;
        __builtin_amdgcn_s_sleep(1);
        if ((++sp & 255u) == 0u) { if (xb_ld(&bar[XB_TMO])) break; if (sp > XB_SPIN_CAP) { atomicAdd(&bar[XB_TMO], 1u); break; } }
    }
    nloc = mine > 0u ? mine : 1u; nx = cnt > 0u ? cnt : 1u;
}

__device__ __forceinline__ void xcd_barrier(const XcdBarrier& b) {
    asm volatile("s_waitcnt vmcnt(0)" ::: "memory");
    __syncthreads();
    if (threadIdx.x == 0) {
        unsigned* bar = b.bar;
        __builtin_amdgcn_s_waitcnt(0);
        unsigned nloc = b.st[0], nx = b.st[1];
        if (nloc == 0u) { xcd_barrier_complete(bar, b.x, nloc, nx); b.st[0] = nloc; b.st[1] = nx; }
        const unsigned old = xb_add(&bar[XB_XSUB(b.x)], 1u);
        const unsigned gen = old / nloc;
        if (old + 1u == (gen + 1u) * nloc) {
            __builtin_amdgcn_fence(__ATOMIC_RELEASE, "agent");
            asm volatile("s_waitcnt vmcnt(0)" ::: "memory");
            const unsigned og = xb_add(&bar[XB_TOP], 1u);
            const unsigned tg = og / nx;
            if (og + 1u == (tg + 1u) * nx) xb_add(&bar[XB_TOPGEN], 1u);
            else XB_SPIN(xb_ld(&bar[XB_TOPGEN]) == tg, bar);
            __builtin_amdgcn_fence(__ATOMIC_ACQUIRE, "agent");
            xb_add(&bar[XB_XGEN(b.x)], 1u);
            asm volatile("s_waitcnt vmcnt(0)" ::: "memory");
        } else {
            XB_SPIN(xb_ld(&bar[XB_XGEN(b.x)]) == gen, bar);
            __builtin_amdgcn_fence(__ATOMIC_ACQUIRE, "agent");
            asm volatile("s_waitcnt vmcnt(0)" ::: "memory");
        }
    }
    __syncthreads();
}

template <int MB> DI unsigned f2bfm(float f) { constexpr int sh = 16 + (7 - MB); unsigned u = __builtin_bit_cast(unsigned, f); u = (u + ((1u << (sh - 1)) - 1u) + ((u >> sh) & 1u)) & ~((1u << sh) - 1u); return u >> 16; }
template <int MB> DI unsigned pk2m(float lo, float hi) { return f2bfm<MB>(lo) | (f2bfm<MB>(hi) << 16); }
template <int MB = 7> DI void transpose_item(const float* W, int K, int N, bf16* WT, int mode, LAS float* scr, int item, int nblk, int lane, const float* gain = nullptr) {
    const int kb = item / nblk, nb = item % nblk, k0 = 64 * kb, n0 = 32 * nb;
    const int nn = n0 + (lane & 31); const bool ok = nn < N;
    float wv[32];
#pragma unroll
    for (int i = 0; i < 32; ++i) { const int kk = 2 * i + (lane >> 5); wv[i] = ok ? W[(size_t)(k0 + kk) * N + nn] : 0.f; }
    if (gain) {
#pragma unroll
        for (int i = 0; i < 32; ++i) wv[i] *= gain[k0 + 2 * i + (lane >> 5)]; }
#pragma unroll
    for (int i = 0; i < 32; ++i) scr[(2 * i + (lane >> 5)) * 33 + (lane & 31)] = wv[i];
    LDS_WAIT(); asm volatile("" ::: "memory");
    const int c = lane & 7;
    const int drow0 = (mode == 0) ? n0 : (256 * (n0 >> 7) + (n0 & 127) + (mode == 2 ? 128 : 0));
#pragma unroll
    for (int j = 0; j < 4; ++j) { const int n = (lane >> 3) + 8 * j; const LAS float* s = scr + (8 * c) * 33 + n;
        v4u o; o.x = pk2m<MB>(s[0 * 33], s[1 * 33]); o.y = pk2m<MB>(s[2 * 33], s[3 * 33]); o.z = pk2m<MB>(s[4 * 33], s[5 * 33]); o.w = pk2m<MB>(s[6 * 33], s[7 * 33]);
        *(v4u*)(WT + (size_t)(drow0 + n) * K + k0 + 8 * c) = o; }
    LDS_WAIT(); asm volatile("" ::: "memory");
}
DI void prologue(const InTab in, unsigned char* ws, LAS unsigned char* lds, int gw, int NGW, int lane, int wave) {
    LAS float* scr = (LAS float*)(lds + RING_OFF + wave * 16384);
    constexpr int I_IN = (D / 64) * (N_INP / 32), I_OUT = (D / 64) * (D / 32), I_W1 = (D / 64) * (FF / 32), I_W2 = (FF / 64) * (D / 32), I_GLU = (512 / 64) * (512 / 32);
    constexpr int I_LAYER = I_IN + I_OUT + 2 * I_W1 + I_W2;
    constexpr int NITEMS = 2 * I_LAYER + I_GLU;
    for (int it = gw; it < NITEMS; it += NGW) {
        int r = it;
        if (r >= 2 * I_LAYER) { r -= 2 * I_LAYER; transpose_item(in[11], 512, 512, (bf16*)(ws + WS_GLUW), 0, scr, r, 512 / 32, lane); continue; }
        const int layer = r >= I_LAYER; if (layer) r -= I_LAYER;
        const float* win = layer ? in[25] : in[2]; const float* wout = layer ? in[32] : in[19];
        const float* w1 = layer ? in[34] : in[21]; const float* w3 = layer ? in[35] : in[22]; const float* w2 = layer ? in[36] : in[23];
        const float* gmix = layer ? in[24] : in[1]; const float* gffn = layer ? in[33] : in[20];
        bf16* WIN = (bf16*)(ws + (layer ? WS_WIN1 : WS_WIN0)); bf16* WOUT = (bf16*)(ws + (layer ? WS_WOUT1 : WS_WOUT0));
        bf16* W13 = (bf16*)(ws + (layer ? WS_W13_1 : WS_W13_0)); bf16* W2 = (bf16*)(ws + (layer ? WS_W2_1 : WS_W2_0));
        if (r < I_IN) { transpose_item<WM_IN>(win, D, layer ? N_IN1 : N_IN0, WIN, 0, scr, r, N_INP / 32, lane, gmix); continue; } r -= I_IN;
        if (r < I_OUT) { transpose_item<WM_OUT>(wout, D, D, WOUT, 0, scr, r, D / 32, lane); continue; } r -= I_OUT;
        if (r < I_W1) { transpose_item<WM_FFN>(w1, D, FF, W13, 1, scr, r, FF / 32, lane, gffn); continue; } r -= I_W1;
        if (r < I_W1) { transpose_item<WM_FFN>(w3, D, FF, W13, 2, scr, r, FF / 32, lane, gffn); continue; } r -= I_W1;
        transpose_item<WM_FFN>(w2, FF, D, W2, 0, scr, r, D / 32, lane);
    }
}
DI void s5_tables(const InTab in, unsigned char* ws, int gt) {
    if (gt >= 32 * 64) return;
    const int g = gt >> 6;
    const double are = (double)in[3][gt], aim = (double)in[4][gt], dt = exp((double)in[5][g]);
    const double mag = exp(are * dt), abr = mag * cos(aim * dt), abi = mag * sin(aim * dt);
    const double er = abr - 1.0, ei = abi, den = are * are + aim * aim;
    const double cr = (er * are + ei * aim) / den, ci = (ei * are - er * aim) / den;
    double* ABARD = (double*)(ws + WS_TAB + TAB_ABARD); double* BTD = (double*)(ws + WS_TAB + TAB_BTD); float* A16 = (float*)(ws + WS_TAB + TAB_A16);
    ABARD[gt * 2] = abr; ABARD[gt * 2 + 1] = abi;
    { double* POW = (double*)(ws + WS_POW) + (size_t)gt * 34; double qr = 1.0, qi = 0.0; POW[0] = 1.0; POW[1] = 0.0;
      for (int p = 1; p <= 16; ++p) { const double nr = qr * abr - qi * abi, ni = qr * abi + qi * abr; qr = nr; qi = ni; POW[2 * p] = qr; POW[2 * p + 1] = qi; } }
    double pr = abr, pi = abi;
#pragma unroll
    for (int i = 0; i < 4; ++i) { const double nr = pr * pr - pi * pi, ni = 2.0 * pr * pi; pr = nr; pi = ni; }
    A16[gt * 2] = (float)pr; A16[gt * 2 + 1] = (float)pi;
    for (int c = 0; c < 16; ++c) { const double br = (double)in[6][gt * 16 + c], bi = (double)in[7][gt * 16 + c];
        BTD[(gt * 16 + c) * 2] = cr * br - ci * bi; BTD[(gt * 16 + c) * 2 + 1] = cr * bi + ci * br; }
}
DI void cpow(double ar, double ai, int p, double& pr, double& pi) { pr = 1.0; pi = 0.0; for (int i = 0; i < p; ++i) { const double nr = pr * ar - pi * ai, ni = pr * ai + pi * ar; pr = nr; pi = ni; } }
DI void s5_tables2(const InTab in, unsigned char* ws, LAS unsigned char* lds, int bx, int G, int tid) {
    bf16* TOEP = (bf16*)(ws + WS_TAB + TAB_TOEP); bf16* QM = (bf16*)(ws + WS_TAB + TAB_QM); bf16* PM = (bf16*)(ws + WS_PM);
    LAS double* POW = (LAS double*)(lds + RING_OFF);
    LAS double* BTD = POW + 64 * 34;
    LAS float* Crl = (LAS float*)(BTD + 64 * 32);
    LAS float* Cil = Crl + 16 * 64;
    for (int gi = bx; gi < 32 * 8; gi += G) {
        const int g = gi >> 3, idx = (gi & 7) * 512 + tid;
        __syncthreads();
        { const v4u* s0 = (const v4u*)((const double*)(ws + WS_POW) + (size_t)g * 64 * 34); LAS v4u* d0 = (LAS v4u*)POW;
          for (int k = tid; k < 64 * 34 * 8 / 16; k += 512) d0[k] = s0[k];
          const v4u* s1 = (const v4u*)((const double*)(ws + WS_TAB + TAB_BTD) + (size_t)g * 64 * 32); LAS v4u* d1 = (LAS v4u*)BTD;
          for (int k = tid; k < 64 * 32 * 8 / 16; k += 512) d1[k] = s1[k];
          if (tid < 256) ((LAS v4u*)Crl)[tid] = ((const v4u*)(in[8] + (size_t)g * 16 * 64))[tid];
          else ((LAS v4u*)Cil)[tid - 256] = ((const v4u*)(in[9] + (size_t)g * 16 * 64))[tid - 256]; }
        __syncthreads();
        {   const int d = idx >> 8, cp = (idx >> 4) & 15, c = idx & 15;
            double sum = 0.0;
            for (int n = 0; n < 64; ++n) { const double pr = POW[n * 34 + 2 * d], pi = POW[n * 34 + 2 * d + 1];
                const double br = BTD[(n * 16 + c) * 2], bi = BTD[(n * 16 + c) * 2 + 1], xr = pr * br - pi * bi, xi = pr * bi + pi * br;
                sum += (double)Crl[cp * 64 + n] * xr - (double)Cil[cp * 64 + n] * xi; }
            if (d == 0 && cp == c) sum += (double)in[10][g * 16 + c];
            const bf16 v = (bf16)f2bf((float)sum);
            for (int s = 0; s + d < 16; ++s) { const int j = s + d;
                TOEP[((size_t)(g * 256 + 16 * j + cp)) * 256 + 16 * s + c] = v;
                if (d > 0) TOEP[((size_t)(g * 256 + 16 * s + cp)) * 256 + 16 * j + c] = (bf16)0; } }
        {   const int np = (idx >> 5) & 127, s = (idx >> 1) & 15, half = idx & 1, n = np & 63;
            const double pr = POW[n * 34 + 2 * (15 - s)], pi = POW[n * 34 + 2 * (15 - s) + 1];
            float v[8];
#pragma unroll
            for (int e = 0; e < 8; ++e) { const int c = half * 8 + e; const double br = BTD[(n * 16 + c) * 2], bi = BTD[(n * 16 + c) * 2 + 1];
                v[e] = (float)((np < 64) ? (pr * br - pi * bi) : (pr * bi + pi * br)); }
            v4u o; o.x = pk2(v[0], v[1]); o.y = pk2(v[2], v[3]); o.z = pk2(v[4], v[5]); o.w = pk2(v[6], v[7]);
            *(v4u*)(QM + ((size_t)(g * 128 + np)) * 256 + 16 * s + 8 * half) = o; }
        {   const int j = idx >> 8, cp = (idx >> 4) & 15, o8 = idx & 15;
            float v[8];
#pragma unroll
            for (int e = 0; e < 8; ++e) { const int kp = o8 * 8 + e, n = kp & 63; const double pr = POW[n * 34 + 2 * (j + 1)], pi = POW[n * 34 + 2 * (j + 1) + 1];
                const double cr = (double)Crl[cp * 64 + n], ci = (double)Cil[cp * 64 + n];
                v[e] = (float)((kp < 64) ? (cr * pr - ci * pi) : -(cr * pi + ci * pr)); }
            v4u o; o.x = pk2(v[0], v[1]); o.y = pk2(v[2], v[3]); o.z = pk2(v[4], v[5]); o.w = pk2(v[6], v[7]);
            *(v4u*)(PM + ((size_t)(g * 256 + 16 * j + cp)) * 128 + o8 * 8) = o; }
    }
}
DI void x_to_hb_phase(const float* x, bf16* HB, pg8::ssq_t* ss, int gw, int NGW, int lane) {
    const int per = (M + NGW - 1) / NGW, m0 = gw * per, m1 = m0 + per < M ? m0 + per : M;
    for (int m = m0; m < m1; ++m) {
        const f32x4* xr = (const f32x4*)(x + (size_t)m * D) + lane;
        f32x4 v[8]; float s = 0.f;
#pragma unroll
        for (int j = 0; j < 8; ++j) { v[j] = xr[64 * j]; s += (v[j].x * v[j].x + v[j].y * v[j].y) + (v[j].z * v[j].z + v[j].w * v[j].w); }
        s = wave_sum(s);
        v2u* o8 = (v2u*)(HB + (size_t)m * D) + lane;
#pragma unroll
        for (int j = 0; j < 8; ++j) { v2u w; w.x = cvtpk(pg8::rnd_am(v[j].x), pg8::rnd_am(v[j].y)); w.y = cvtpk(pg8::rnd_am(v[j].z), pg8::rnd_am(v[j].w)); o8[64 * j] = w; }
        if (lane == 0) ss[m] = pg8::ssq_from_f(s);
    }
}

DI void s5_fast(const InTab in, unsigned char* ws, LAS unsigned char* lds, int u0, int u1, int ustep, int tid, int lane, int wave) {
    typedef short bf16x8 __attribute__((ext_vector_type(8)));
    const bf16* U = (const bf16*)(ws + WS_U); bf16* YPRE = (bf16*)(ws + WS_YPRE);
    const bf16* TOEP = (const bf16*)(ws + WS_TAB + TAB_TOEP); const bf16* QM = (const bf16*)(ws + WS_TAB + TAB_QM); const bf16* PM = (const bf16*)(ws + WS_PM);
    const float* A16 = (const float*)(ws + WS_TAB + TAB_A16);
    LAS float* Sf = (LAS float*)(lds + RING_OFF);
    const int fr = lane & 15, fq = lane >> 4;
    for (int unit = u0; unit < u1; unit += ustep) {
        const int b = unit >> 5, g = unit & 31;
        const bf16* Ub = U + (size_t)b * SEQ * 512 + g * 16;
        bf16x8 af[2][8];
#pragma unroll
        for (int rb = 0; rb < 2; ++rb)
#pragma unroll
            for (int ks = 0; ks < 8; ++ks) { const int token = (32 * wave + 16 * rb + fr) * 16 + 2 * ks + (fq >> 1);
                af[rb][ks] = *(const bf16x8*)(Ub + (size_t)token * 512 + 8 * (fq & 1)); }
        __syncthreads();
        {
            bf16x8 bq[2][8];
#pragma unroll
            for (int ks = 0; ks < 8; ++ks) bq[0][ks] = *(const bf16x8*)(QM + ((size_t)(g * 128 + fr)) * 256 + 32 * ks + 8 * fq);
#pragma unroll
            for (int nb = 0; nb < 8; ++nb) {
                if (nb + 1 < 8) {
#pragma unroll
                    for (int ks = 0; ks < 8; ++ks) bq[(nb + 1) & 1][ks] = *(const bf16x8*)(QM + ((size_t)(g * 128 + 16 * (nb + 1) + fr)) * 256 + 32 * ks + 8 * fq); }
                f32x4 a0 = {0.f, 0.f, 0.f, 0.f}, a1 = {0.f, 0.f, 0.f, 0.f};
#pragma unroll
                for (int ks = 0; ks < 8; ++ks) { a0 = __builtin_amdgcn_mfma_f32_16x16x32_bf16(af[0][ks], bq[nb & 1][ks], a0, 0, 0, 0); a1 = __builtin_amdgcn_mfma_f32_16x16x32_bf16(af[1][ks], bq[nb & 1][ks], a1, 0, 0, 0); }
#pragma unroll
                for (int e = 0; e < 4; ++e) { Sf[(32 * wave + 4 * fq + e) * 132 + 16 * nb + fr] = a0[e]; Sf[(32 * wave + 16 + 4 * fq + e) * 132 + 16 * nb + fr] = a1[e]; }
            }
        }
        __syncthreads();
        if (wave == 0) {
            const float ar = A16[(g * 64 + lane) * 2], ai = A16[(g * 64 + lane) * 2 + 1];
            float hr = 0.f, hi = 0.f;
            for (int c0 = 0; c0 < 256; c0 += 16) {
                float sr[16], si[16];
#pragma unroll
                for (int i = 0; i < 16; ++i) { sr[i] = Sf[(c0 + i) * 132 + lane]; si[i] = Sf[(c0 + i) * 132 + 64 + lane]; }
#pragma unroll
                for (int i = 0; i < 16; ++i) { Sf[(c0 + i) * 132 + lane] = hr; Sf[(c0 + i) * 132 + 64 + lane] = hi;
                    const float nhr = ar * hr - ai * hi + sr[i], nhi = ar * hi + ai * hr + si[i]; hr = nhr; hi = nhi; }
            }
        }
        __syncthreads();
        bf16x8 hf[2][4];
#pragma unroll
        for (int rb = 0; rb < 2; ++rb)
#pragma unroll
            for (int ks = 0; ks < 4; ++ks) { const LAS f32x4* hp = (const LAS f32x4*)(Sf + (32 * wave + 16 * rb + fr) * 132 + 32 * ks + 8 * fq); const f32x4 h0 = hp[0], h1 = hp[1];
                v4u w; w.x = cvtpk(h0[0], h0[1]); w.y = cvtpk(h0[2], h0[3]); w.z = cvtpk(h1[0], h1[1]); w.w = cvtpk(h1[2], h1[3]);
                hf[rb][ks] = __builtin_bit_cast(bf16x8, w); }
        {
            bf16x8 bt[2][8], bp[2][4];
            bt[0][0] = *(const bf16x8*)(TOEP + ((size_t)(g * 256 + fr)) * 256 + 8 * fq);
#pragma unroll
            for (int ks = 0; ks < 4; ++ks) bp[0][ks] = *(const bf16x8*)(PM + ((size_t)(g * 256 + fr)) * 128 + 32 * ks + 8 * fq);
#pragma unroll
            for (int nb = 0; nb < 16; ++nb) {
                if (nb + 1 < 16) {
#pragma unroll
                    for (int ks = 0; ks < 8; ++ks) if (2 * ks <= nb + 1) bt[(nb + 1) & 1][ks] = *(const bf16x8*)(TOEP + ((size_t)(g * 256 + 16 * (nb + 1) + fr)) * 256 + 32 * ks + 8 * fq);
#pragma unroll
                    for (int ks = 0; ks < 4; ++ks) bp[(nb + 1) & 1][ks] = *(const bf16x8*)(PM + ((size_t)(g * 256 + 16 * (nb + 1) + fr)) * 128 + 32 * ks + 8 * fq); }
                f32x4 a0 = {0.f, 0.f, 0.f, 0.f}, a1 = {0.f, 0.f, 0.f, 0.f};
#pragma unroll
                for (int ks = 0; ks < 8; ++ks) if (2 * ks <= nb) { a0 = __builtin_amdgcn_mfma_f32_16x16x32_bf16(af[0][ks], bt[nb & 1][ks], a0, 0, 0, 0); a1 = __builtin_amdgcn_mfma_f32_16x16x32_bf16(af[1][ks], bt[nb & 1][ks], a1, 0, 0, 0); }
#pragma unroll
                for (int ks = 0; ks < 4; ++ks) { a0 = __builtin_amdgcn_mfma_f32_16x16x32_bf16(hf[0][ks], bp[nb & 1][ks], a0, 0, 0, 0); a1 = __builtin_amdgcn_mfma_f32_16x16x32_bf16(hf[1][ks], bp[nb & 1][ks], a1, 0, 0, 0); }
#pragma unroll
                for (int e = 0; e < 4; ++e) {
                    const size_t t0 = (size_t)b * SEQ + (size_t)(32 * wave + 4 * fq + e) * 16 + nb, t1 = t0 + 256;
                    YPRE[t0 * 512 + g * 16 + fr] = (bf16)f2bf(gelu_tanh_f(a0[e]));
                    YPRE[t1 * 512 + g * 16 + fr] = (bf16)f2bf(gelu_tanh_f(a1[e])); }
            }
        }
    }
}
DI void conv_phase(const InTab in, unsigned char* ws, int gt, int NGT) {
    const bf16* XBC = (const bf16*)(ws + WS_XBC); bf16* XC = (bf16*)(ws + WS_A);
    const float* cw = in[13]; const float* cb = in[14];
    for (int i = gt; i < (M / 8) * 320; i += NGT) {
        const int tb = i / 320, c8 = (i % 320) * 8, t0 = tb * 8, ts0 = t0 & (SEQ - 1);
        v4u r[11];
#pragma unroll
        for (int k = 0; k < 11; ++k) { r[k] = (v4u){0u, 0u, 0u, 0u}; if (ts0 - 3 + k >= 0) r[k] = *(const v4u*)(XBC + (size_t)(t0 - 3 + k) * 2560 + c8); }
        float w[4][8], bs[8];
#pragma unroll
        for (int k = 0; k < 4; ++k) { const f32x4 w0 = *(const f32x4*)(cw + k * 2560 + c8), w1 = *(const f32x4*)(cw + k * 2560 + c8 + 4);
            w[k][0] = w0.x; w[k][1] = w0.y; w[k][2] = w0.z; w[k][3] = w0.w; w[k][4] = w1.x; w[k][5] = w1.y; w[k][6] = w1.z; w[k][7] = w1.w; }
        { const f32x4 b0 = *(const f32x4*)(cb + c8), b1 = *(const f32x4*)(cb + c8 + 4); bs[0] = b0.x; bs[1] = b0.y; bs[2] = b0.z; bs[3] = b0.w; bs[4] = b1.x; bs[5] = b1.y; bs[6] = b1.z; bs[7] = b1.w; }
        float x[11][8];
#pragma unroll
        for (int k = 0; k < 11; ++k) { x[k][0] = bflo(r[k].x); x[k][1] = bfhi(r[k].x); x[k][2] = bflo(r[k].y); x[k][3] = bfhi(r[k].y); x[k][4] = bflo(r[k].z); x[k][5] = bfhi(r[k].z); x[k][6] = bflo(r[k].w); x[k][7] = bfhi(r[k].w); }
#pragma unroll
        for (int j = 0; j < 8; ++j) { float acc[8];
#pragma unroll
            for (int e = 0; e < 8; ++e) acc[e] = bs[e] + w[0][e] * x[j][e] + w[1][e] * x[j + 1][e] + w[2][e] * x[j + 2][e] + w[3][e] * x[j + 3][e];
            v4u o; o.x = cvtpk(silu_f(acc[0]), silu_f(acc[1])); o.y = cvtpk(silu_f(acc[2]), silu_f(acc[3])); o.z = cvtpk(silu_f(acc[4]), silu_f(acc[5])); o.w = cvtpk(silu_f(acc[6]), silu_f(acc[7]));
            *(v4u*)(XC + (size_t)(t0 + j) * 2560 + c8) = o; }
    }
}
DI void ssd_fast(const InTab in, unsigned char* ws, LAS unsigned char* lds, int bx, int G, int tid, int lane, int wave) {
    typedef short bf16x8 __attribute__((ext_vector_type(8)));
    const bf16* XC = (const bf16*)(ws + WS_A); const float* DT = (const float*)(ws + WS_DT); const bf16* Z = (const bf16*)(ws + WS_Z); bf16* YS = (bf16*)(ws + WS_YSSD);
    constexpr int SET = 64 * 136 * 2 + 64 * 72 * 2 + 256;
    LAS bf16* T0 = (LAS bf16*)(lds + RING_OFF);
    LAS bf16* Sl = T0 + 2 * SET;
    const int fr = lane & 15, fq = lane >> 4, lb = wave & 3, ph = wave >> 2, tq = fr >> 2, tp = fr & 3;
    const float LOG2E = 1.4426950408889634f;
    for (int unit = bx; unit < BATCH * 24; unit += G) {
        const int b = unit / 24, h = unit % 24, grp = h / 6;
        const float A = -__expf(in[16][h]), Dh = in[17][h], dtb = in[15][h];
        f32x4 st[4];
#pragma unroll
        for (int i = 0; i < 4; ++i) st[i] = (f32x4){0.f, 0.f, 0.f, 0.f};
        __syncthreads();
        for (int i = tid; i < 64 * 136 / 2; i += 512) ((LAS unsigned*)Sl)[i] = 0u;
        v4u rB[2], rC[2], rX; float rdt;
#define SSD_FETCH(chunk) do { const size_t r0_ = (size_t)b * SEQ + (size_t)(chunk) * 64; \
            _Pragma("unroll") for (int i = 0; i < 2; ++i) { const int pc = tid + 512 * i, s = pc >> 4, n0 = (pc & 15) * 8; \
                rB[i] = *(const v4u*)(XC + (r0_ + s) * 2560 + 1536 + grp * 128 + n0); rC[i] = *(const v4u*)(XC + (r0_ + s) * 2560 + 2048 + grp * 128 + n0); } \
            rX = *(const v4u*)(XC + (r0_ + (tid >> 3)) * 2560 + h * 64 + (tid & 7) * 8); \
            rdt = DT[(r0_ + lane) * 32 + h]; } while (0)
#define SSD_STAGE(set) do { LAS bf16* Bl_ = T0 + (set) * SET; LAS bf16* Cl_ = Bl_ + 64 * 136; LAS bf16* Xl_ = Cl_ + 64 * 136; LAS bf16* Xw_ = Xl_ + 64 * 72; LAS float* cs_ = (LAS float*)(Xw_ + 64 * 72); \
            const float dt = softplus_f(rdt + dtb); float cs = dt * A; \
            _Pragma("unroll") for (int off = 1; off < 64; off <<= 1) { const float t = __shfl_up(cs, off); if (lane >= off) cs += t; } \
            const float cs_last = __shfl(cs, 63); const float wgt = __expf(cs_last - cs) * dt; \
            if (wave == 0) { cs_[lane] = cs; cs_[64 + lane] = dt; } \
            _Pragma("unroll") for (int i = 0; i < 2; ++i) { const int pc = tid + 512 * i, s = pc >> 4, n0 = (pc & 15) * 8; \
                *(LAS v4u*)(Bl_ + s * 136 + n0) = rB[i]; *(LAS v4u*)(Cl_ + s * 136 + n0) = rC[i]; } \
            { const int l = tid >> 3, p0 = (tid & 7) * 8; const float wl = __shfl(wgt, l); \
              *(LAS v4u*)(Xl_ + l * 72 + p0) = rX; \
              v4u xs; xs.x = cvtpk(bflo(rX.x) * wl, bfhi(rX.x) * wl); xs.y = cvtpk(bflo(rX.y) * wl, bfhi(rX.y) * wl); xs.z = cvtpk(bflo(rX.z) * wl, bfhi(rX.z) * wl); xs.w = cvtpk(bflo(rX.w) * wl, bfhi(rX.w) * wl); \
              *(LAS v4u*)(Xw_ + l * 72 + p0) = xs; } } while (0)
        SSD_FETCH(0); SSD_STAGE(0); SSD_FETCH(1);
        __syncthreads();
        for (int ch = 0; ch < SEQ / 64; ++ch) {
            const size_t row0 = (size_t)b * SEQ + ch * 64;
            const LAS bf16* Bl = T0 + (ch & 1) * SET; const LAS bf16* Cl = Bl + 64 * 136; const LAS bf16* Xl = Cl + 64 * 136; const LAS bf16* Xw = Xl + 64 * 72; const LAS float* csl = (const LAS float*)(Xw + 64 * 72);
            const LAS bf16* Scur = Sl + (ch & 1) * (64 * 136); LAS bf16* Snxt = Sl + ((ch + 1) & 1) * (64 * 136);
            const size_t row = row0 + 16 * lb + fr;
            v2u zw[2];
#pragma unroll
            for (int pi = 0; pi < 2; ++pi) zw[pi] = *(const v2u*)(Z + row * 1536 + h * 64 + 16 * (2 * ph + pi) + 4 * fq);
            bf16x8 cf[4];
#pragma unroll
            for (int ks = 0; ks < 4; ++ks) cf[ks] = *(const LAS bf16x8*)(Cl + (16 * lb + fr) * 136 + 32 * ks + 8 * fq);
            const float cs_l = csl[16 * lb + fr];
            f32x4 gt[4];
#pragma unroll
            for (int sb = 0; sb < 4; ++sb) { gt[sb] = (f32x4){0.f, 0.f, 0.f, 0.f};
                if (sb <= lb) {
#pragma unroll
                    for (int ks = 0; ks < 4; ++ks) { const bf16x8 a = *(const LAS bf16x8*)(Bl + (16 * sb + fr) * 136 + 32 * ks + 8 * fq);
                        gt[sb] = __builtin_amdgcn_mfma_f32_16x16x32_bf16(a, cf[ks], gt[sb], 0, 0, 0); }
                    const f32x4 css = *(const LAS f32x4*)(csl + 16 * sb + 4 * fq), dts = *(const LAS f32x4*)(csl + 64 + 16 * sb + 4 * fq);
#pragma unroll
                    for (int e = 0; e < 4; ++e) { const int s = 16 * sb + 4 * fq + e, l = 16 * lb + fr;
                        gt[sb][e] = (s <= l) ? gt[sb][e] * __builtin_amdgcn_exp2f((cs_l - css[e]) * LOG2E) * dts[e] : 0.f; }
                } }
            bf16x8 mt[2];
#pragma unroll
            for (int kk = 0; kk < 2; ++kk) { v4u w; w.x = cvtpk(gt[2 * kk][0], gt[2 * kk][1]); w.y = cvtpk(gt[2 * kk][2], gt[2 * kk][3]);
                w.z = cvtpk(gt[2 * kk + 1][0], gt[2 * kk + 1][1]); w.w = cvtpk(gt[2 * kk + 1][2], gt[2 * kk + 1][3]); mt[kk] = __builtin_bit_cast(bf16x8, w); }
            const float el = __builtin_amdgcn_exp2f(cs_l * LOG2E);
#pragma unroll
            for (int pi = 0; pi < 2; ++pi) { const int pb = 2 * ph + pi;
                f32x4 y = {0.f, 0.f, 0.f, 0.f};
#pragma unroll
                for (int ks = 0; ks < 4; ++ks) { const bf16x8 a = *(const LAS bf16x8*)(Scur + (16 * pb + fr) * 136 + 32 * ks + 8 * fq);
                    y = __builtin_amdgcn_mfma_f32_16x16x32_bf16(a, cf[ks], y, 0, 0, 0); }
                y = y * el;
#pragma unroll
                for (int kk = 0; kk < 2; ++kk) if (2 * kk <= lb) {
                    const v2u lo = tr16(Xl + (32 * kk + 4 * fq + tq) * 72 + 16 * pb + 4 * tp), hi = tr16(Xl + (32 * kk + 16 + 4 * fq + tq) * 72 + 16 * pb + 4 * tp);
                    v4u aw; aw.x = lo.x; aw.y = lo.y; aw.z = hi.x; aw.w = hi.y;
                    y = __builtin_amdgcn_mfma_f32_16x16x32_bf16(__builtin_bit_cast(bf16x8, aw), mt[kk], y, 0, 0, 0); }
                const v2u xw = *(const LAS v2u*)(Xl + (16 * lb + fr) * 72 + 16 * pb + 4 * fq);
                const float o0 = (y[0] + Dh * bflo(xw.x)) * pg8::fast_silu(bflo(zw[pi].x)), o1 = (y[1] + Dh * bfhi(xw.x)) * pg8::fast_silu(bfhi(zw[pi].x));
                const float o2 = (y[2] + Dh * bflo(xw.y)) * pg8::fast_silu(bflo(zw[pi].y)), o3 = (y[3] + Dh * bfhi(xw.y)) * pg8::fast_silu(bfhi(zw[pi].y));
                v2u ow; ow.x = cvtpk(o0, o1); ow.y = cvtpk(o2, o3);
                *(v2u*)(YS + row * 1536 + h * 64 + 16 * pb + 4 * fq) = ow;
            }
            const float dec = __builtin_amdgcn_exp2f(csl[63] * LOG2E);
            bf16x8 ba[2];
#pragma unroll
            for (int ks = 0; ks < 2; ++ks) { const v2u lo = tr16(Bl + (32 * ks + 8 * fq + tq) * 136 + 16 * wave + 4 * tp), hi = tr16(Bl + (32 * ks + 8 * fq + 4 + tq) * 136 + 16 * wave + 4 * tp);
                v4u aw; aw.x = lo.x; aw.y = lo.y; aw.z = hi.x; aw.w = hi.y; ba[ks] = __builtin_bit_cast(bf16x8, aw); }
#pragma unroll
            for (int pb = 0; pb < 4; ++pb) { st[pb] = st[pb] * dec;
#pragma unroll
                for (int ks = 0; ks < 2; ++ks) { const v2u lo = tr16(Xw + (32 * ks + 8 * fq + tq) * 72 + 16 * pb + 4 * tp), hi = tr16(Xw + (32 * ks + 8 * fq + 4 + tq) * 72 + 16 * pb + 4 * tp);
                    v4u xv; xv.x = lo.x; xv.y = lo.y; xv.z = hi.x; xv.w = hi.y;
                    st[pb] = __builtin_amdgcn_mfma_f32_16x16x32_bf16(ba[ks], __builtin_bit_cast(bf16x8, xv), st[pb], 0, 0, 0); }
                v2u sw; sw.x = cvtpk(st[pb][0], st[pb][1]); sw.y = cvtpk(st[pb][2], st[pb][3]);
                *(LAS v2u*)(Snxt + (16 * pb + fr) * 136 + 16 * wave + 4 * fq) = sw; }
            if (ch + 1 < SEQ / 64) { SSD_STAGE((ch + 1) & 1); if (ch + 2 < SEQ / 64) SSD_FETCH(ch + 2); }
            BAR_LDS();
        }
#undef SSD_FETCH
#undef SSD_STAGE
    }
}
DI void ssd_finalize(const InTab in, unsigned char* ws, int gw, int NGW, int lane) {
    const bf16* YS = (const bf16*)(ws + WS_YSSD); bf16* Y = (bf16*)(ws + WS_A); const float* nw = in[18];
    for (int m = 2 * gw; m < M; m += 2 * NGW) {
        unsigned w[2][4][3];
#pragma unroll
        for (int r = 0; r < 2; ++r)
#pragma unroll
            for (int grp = 0; grp < 4; ++grp) { const unsigned* src = (const unsigned*)(YS + (size_t)(m + r) * 1536 + grp * 384) + lane * 3; w[r][grp][0] = src[0]; w[r][grp][1] = src[1]; w[r][grp][2] = src[2]; }
#pragma unroll
        for (int r = 0; r < 2; ++r)
#pragma unroll
            for (int grp = 0; grp < 4; ++grp) {
                const float v[6] = {bflo(w[r][grp][0]), bfhi(w[r][grp][0]), bflo(w[r][grp][1]), bfhi(w[r][grp][1]), bflo(w[r][grp][2]), bfhi(w[r][grp][2])};
                float s = 0.f;
#pragma unroll
                for (int j = 0; j < 6; ++j) s += v[j] * v[j];
                const float rstd = __builtin_amdgcn_rsqf(wave_sum(s) * (1.f / 384.f) + RMS_EPS);
                const float* g = nw + grp * 384 + lane * 6;
                unsigned* dst = (unsigned*)(Y + (size_t)(m + r) * D + 512 + grp * 384) + lane * 3;
                dst[0] = cvtpk(v[0] * rstd * g[0], v[1] * rstd * g[1]); dst[1] = cvtpk(v[2] * rstd * g[2], v[3] * rstd * g[3]); dst[2] = cvtpk(v[4] * rstd * g[4], v[5] * rstd * g[5]);
            }
    }
}
DI void swa_fast(const InTab in, unsigned char* ws, LAS unsigned char* lds, int bx, int G, int tid, int lane, int wave) {
    typedef short bf16x8 __attribute__((ext_vector_type(8)));
    const bf16* Q = (const bf16*)(ws + WS_Q); const bf16* Kb = (const bf16*)(ws + WS_K); const bf16* Vb = (const bf16*)(ws + WS_V); bf16* Y = (bf16*)(ws + WS_A);
    LAS bf16* Kl = (LAS bf16*)(lds + RING_OFF);
    LAS bf16* Vl = (LAS bf16*)(lds + RING_OFF + 192 * 144);
    const int fr = lane & 15, fq = lane >> 4, piece = tid & 7, tq = fr >> 2, tp = fr & 3;
    const int hql = wave >> 1, qo = (wave & 1) * 32, kb0 = qo >> 4;
    const float LOG2E = 1.4426950408889634f;
    float wk8[8], wq0[8], wq1[8];
#pragma unroll
    for (int j = 0; j < 8; ++j) { wk8[j] = in[27][piece * 8 + j]; wq0[j] = in[26][fq * 8 + j]; wq1[j] = in[26][32 + fq * 8 + j]; }
    v4u kw[3], vw[3], qw[2][2];
#define SWA_FETCH(u_) do { const int b_ = (u_) >> 8, kvh_ = ((u_) >> 6) & 3, t0_ = ((u_) & 63) * 64; \
        _Pragma("unroll") for (int i = 0; i < 3; ++i) { const int idx_ = (tid + 512 * i) >> 3, pos_ = t0_ - 128 + idx_; kw[i] = (v4u){0u, 0u, 0u, 0u}; vw[i] = (v4u){0u, 0u, 0u, 0u}; \
            if (pos_ >= 0) { const size_t r_ = (size_t)b_ * SEQ + pos_; kw[i] = *(const v4u*)(Kb + r_ * 256 + kvh_ * 64 + piece * 8); vw[i] = *(const v4u*)(Vb + r_ * 256 + kvh_ * 64 + piece * 8); } } \
        _Pragma("unroll") for (int qb = 0; qb < 2; ++qb) { const size_t r_ = (size_t)b_ * SEQ + t0_ + qo + qb * 16 + fr; \
            qw[qb][0] = *(const v4u*)(Q + r_ * 1024 + (kvh_ * 4 + hql) * 64 + fq * 8); qw[qb][1] = *(const v4u*)(Q + r_ * 1024 + (kvh_ * 4 + hql) * 64 + 32 + fq * 8); } } while (0)
    if (bx < BATCH * 4 * 64) SWA_FETCH(bx);
    for (int unit = bx; unit < BATCH * 4 * 64; unit += G) {
        const int b = unit >> 8, kvh = (unit >> 6) & 3, t0 = (unit & 63) * 64;
        const size_t row0 = (size_t)b * SEQ + t0;
        __syncthreads();
#pragma unroll
        for (int i = 0; i < 3; ++i) {
            const int pc = tid + 512 * i, idx = pc >> 3;
            const float k0 = bflo(kw[i].x), k1 = bfhi(kw[i].x), k2 = bflo(kw[i].y), k3 = bfhi(kw[i].y), k4 = bflo(kw[i].z), k5 = bfhi(kw[i].z), k6 = bflo(kw[i].w), k7 = bfhi(kw[i].w);
            float ss = (k0 * k0 + k1 * k1) + (k2 * k2 + k3 * k3) + (k4 * k4 + k5 * k5) + (k6 * k6 + k7 * k7);
            ss += __shfl_xor(ss, 1); ss += __shfl_xor(ss, 2); ss += __shfl_xor(ss, 4);
            const float rs = __builtin_amdgcn_rsqf(ss * (1.f / 64.f) + RMS_EPS);
            v4u o; o.x = cvtpk(k0 * rs * wk8[0], k1 * rs * wk8[1]); o.y = cvtpk(k2 * rs * wk8[2], k3 * rs * wk8[3]);
            o.z = cvtpk(k4 * rs * wk8[4], k5 * rs * wk8[5]); o.w = cvtpk(k6 * rs * wk8[6], k7 * rs * wk8[7]);
            *(LAS v4u*)(Kl + idx * 72 + piece * 8) = o;
            *(LAS v4u*)(Vl + idx * 72 + piece * 8) = vw[i];
        }
        const int hq = kvh * 4 + hql;
        bf16x8 qf[2][2];
#pragma unroll
        for (int qb = 0; qb < 2; ++qb) {
            const v4u w0 = qw[qb][0], w1 = qw[qb][1];
            const float a0 = bflo(w0.x), a1 = bfhi(w0.x), a2 = bflo(w0.y), a3 = bfhi(w0.y), a4 = bflo(w0.z), a5 = bfhi(w0.z), a6 = bflo(w0.w), a7 = bfhi(w0.w);
            const float c0 = bflo(w1.x), c1 = bfhi(w1.x), c2 = bflo(w1.y), c3 = bfhi(w1.y), c4 = bflo(w1.z), c5 = bfhi(w1.z), c6 = bflo(w1.w), c7 = bfhi(w1.w);
            float ss = (a0 * a0 + a1 * a1) + (a2 * a2 + a3 * a3) + (a4 * a4 + a5 * a5) + (a6 * a6 + a7 * a7) + (c0 * c0 + c1 * c1) + (c2 * c2 + c3 * c3) + (c4 * c4 + c5 * c5) + (c6 * c6 + c7 * c7);
            ss += __shfl_xor(ss, 16); ss += __shfl_xor(ss, 32);
            const float sc = __builtin_amdgcn_rsqf(ss * (1.f / 64.f) + RMS_EPS) * 0.125f * LOG2E;
            v4u p0, p1;
            p0.x = cvtpk(a0 * sc * wq0[0], a1 * sc * wq0[1]); p0.y = cvtpk(a2 * sc * wq0[2], a3 * sc * wq0[3]);
            p0.z = cvtpk(a4 * sc * wq0[4], a5 * sc * wq0[5]); p0.w = cvtpk(a6 * sc * wq0[6], a7 * sc * wq0[7]);
            p1.x = cvtpk(c0 * sc * wq1[0], c1 * sc * wq1[1]); p1.y = cvtpk(c2 * sc * wq1[2], c3 * sc * wq1[3]);
            p1.z = cvtpk(c4 * sc * wq1[4], c5 * sc * wq1[5]); p1.w = cvtpk(c6 * sc * wq1[6], c7 * sc * wq1[7]);
            qf[qb][0] = __builtin_bit_cast(bf16x8, p0); qf[qb][1] = __builtin_bit_cast(bf16x8, p1);
        }
        __syncthreads();
        if (unit + G < BATCH * 4 * 64) SWA_FETCH(unit + G);
        f32x4 s[10][2];
#pragma unroll
        for (int i = 0; i < 10; ++i) { s[i][0] = (f32x4){0.f, 0.f, 0.f, 0.f}; s[i][1] = (f32x4){0.f, 0.f, 0.f, 0.f}; }
#pragma unroll
        for (int i = 0; i < 10; ++i)
#pragma unroll
            for (int ks = 0; ks < 2; ++ks) { const bf16x8 a = *(const LAS bf16x8*)(Kl + ((kb0 + i) * 16 + fr) * 72 + ks * 32 + fq * 8);
                if (i < 9) s[i][0] = __builtin_amdgcn_mfma_f32_16x16x32_bf16(a, qf[0][ks], s[i][0], 0, 0, 0);
                if (i > 0) s[i][1] = __builtin_amdgcn_mfma_f32_16x16x32_bf16(a, qf[1][ks], s[i][1], 0, 0, 0); }
        const float sinkl = in[28][hq] * LOG2E;
        float linv[2];
#pragma unroll
        for (int qb = 0; qb < 2; ++qb) {
#pragma unroll
            for (int e = 0; e < 4; ++e) { if (!(4 * fq + e > fr)) s[qb][qb][e] = -INFINITY; if (!(4 * fq + e <= fr)) s[qb + 8][qb][e] = -INFINITY; }
            if (t0 < 128) {
#pragma unroll
                for (int d = 0; d < 9; ++d)
#pragma unroll
                    for (int e = 0; e < 4; ++e) if (t0 - 128 + (kb0 + qb + d) * 16 + 4 * fq + e < 0) s[qb + d][qb][e] = -INFINITY;
            }
            float mx = sinkl;
#pragma unroll
            for (int d = 0; d < 9; ++d) mx = fmaxf(mx, fmaxf(fmaxf(s[qb + d][qb][0], s[qb + d][qb][1]), fmaxf(s[qb + d][qb][2], s[qb + d][qb][3])));
            mx = fmaxf(mx, __shfl_xor(mx, 16)); mx = fmaxf(mx, __shfl_xor(mx, 32));
            float l = 0.f;
#pragma unroll
            for (int d = 0; d < 9; ++d)
#pragma unroll
                for (int e = 0; e < 4; ++e) { const float pv = __builtin_amdgcn_exp2f(s[qb + d][qb][e] - mx); s[qb + d][qb][e] = pv; l += pv; }
            l += __shfl_xor(l, 16); l += __shfl_xor(l, 32);
            l += __builtin_amdgcn_exp2f(sinkl - mx);
            linv[qb] = 1.0f / l;
        }
        s[9][0] = (f32x4){0.f, 0.f, 0.f, 0.f}; s[0][1] = (f32x4){0.f, 0.f, 0.f, 0.f};
        f32x4 o[4][2];
#pragma unroll
        for (int hb = 0; hb < 4; ++hb) { o[hb][0] = (f32x4){0.f, 0.f, 0.f, 0.f}; o[hb][1] = (f32x4){0.f, 0.f, 0.f, 0.f}; }
#pragma unroll
        for (int st = 0; st < 5; ++st) {
            bf16x8 pf[2];
#pragma unroll
            for (int qb = 0; qb < 2; ++qb) { v4u w; w.x = cvtpk(s[2 * st][qb][0], s[2 * st][qb][1]); w.y = cvtpk(s[2 * st][qb][2], s[2 * st][qb][3]);
                w.z = cvtpk(s[2 * st + 1][qb][0], s[2 * st + 1][qb][1]); w.w = cvtpk(s[2 * st + 1][qb][2], s[2 * st + 1][qb][3]); pf[qb] = __builtin_bit_cast(bf16x8, w); }
#pragma unroll
            for (int hb = 0; hb < 4; ++hb) {
                const v2u lo = tr16(Vl + ((kb0 + 2 * st) * 16 + 4 * fq + tq) * 72 + 16 * hb + 4 * tp), hi = tr16(Vl + ((kb0 + 2 * st + 1) * 16 + 4 * fq + tq) * 72 + 16 * hb + 4 * tp);
                v4u aw; aw.x = lo.x; aw.y = lo.y; aw.z = hi.x; aw.w = hi.y;
                const bf16x8 a = __builtin_bit_cast(bf16x8, aw);
                o[hb][0] = __builtin_amdgcn_mfma_f32_16x16x32_bf16(a, pf[0], o[hb][0], 0, 0, 0);
                o[hb][1] = __builtin_amdgcn_mfma_f32_16x16x32_bf16(a, pf[1], o[hb][1], 0, 0, 0); }
        }
#pragma unroll
        for (int qb = 0; qb < 2; ++qb) { const size_t r = row0 + qo + qb * 16 + fr;
#pragma unroll
            for (int hb = 0; hb < 4; ++hb) { const f32x4 v = o[hb][qb] * linv[qb]; v2u w; w.x = cvtpk(v[0], v[1]); w.y = cvtpk(v[2], v[3]);
                *(v2u*)(Y + r * D + hq * 64 + hb * 16 + 4 * fq) = w; } }
    }
#undef SWA_FETCH
}
DI void gla_pre(const InTab in, unsigned char* ws, LAS unsigned char* lds, int bx, int G, int tid, int lane, int wave) {
    typedef short bf16x8 __attribute__((ext_vector_type(8)));
    const bf16* QD = (const bf16*)(ws + WS_QD); const bf16* KD = (const bf16*)(ws + WS_KD); const float* GLR = (const float*)(ws + WS_GLR);
    bf16* QT = (bf16*)(ws + WS_QT); bf16* KTT = (bf16*)(ws + WS_KTT); bf16* ATT = (bf16*)(ws + WS_ATT); float* DEC = (float*)(ws + WS_DEC);
    LAS bf16* Ql = (LAS bf16*)(lds + RING_OFF);
    LAS bf16* Kl = Ql + 64 * 136;
    LAS float* gl = (LAS float*)(Kl + 64 * 136);
    LAS float* tot = gl + 64 * 16;
    const int fr = lane & 15, fq = lane >> 4, kc = tid & 127, sg = tid >> 7;
    constexpr int NU = BATCH * 64 * 4;
    if (bx >= NU) return;
    float w2n[16], gbn; f32x4 rgn; bf16 rqn[16], rkn[16];
#define GP_FETCH(u_) do { const int h_ = (u_) & 3, bc2_ = (u_) >> 2; const size_t r0_ = (size_t)(bc2_ >> 6) * SEQ + (size_t)(bc2_ & 63) * 64; \
        _Pragma("unroll") for (int r = 0; r < 16; ++r) w2n[r] = in[29][r * 512 + h_ * 128 + kc]; \
        gbn = in[30][h_ * 128 + kc]; \
        rgn = *(const f32x4*)(GLR + r0_ * 16 + (tid & 255) * 4); \
        _Pragma("unroll") for (int i = 0; i < 16; ++i) { rqn[i] = QD[(r0_ + 16 * sg + i) * 512 + h_ * 128 + kc]; rkn[i] = KD[(r0_ + 16 * sg + i) * 512 + h_ * 128 + kc]; } } while (0)
    GP_FETCH(bx);
    for (int unit = bx;; unit += G) {
        const int h = unit & 3, bc_ = unit >> 2, b = bc_ >> 6, c = bc_ & 63;
        const size_t row0 = (size_t)b * SEQ + c * 64;
        float w2[16]; bf16 rq[16], rk[16];
#pragma unroll
        for (int r = 0; r < 16; ++r) { w2[r] = w2n[r]; rq[r] = rqn[r]; rk[r] = rkn[r]; }
        const float gb = gbn; const f32x4 rg = rgn;
        GP_FETCH(unit + G < NU ? unit + G : unit);
        __syncthreads();
        if (tid < 256) *(LAS f32x4*)(gl + tid * 4) = rg;
        __syncthreads();
        float pre[16]; float run = 0.f;
#pragma unroll
        for (int i = 0; i < 16; ++i) { const LAS f32x4* gp = (const LAS f32x4*)(gl + (16 * sg + i) * 16); const f32x4 g0 = gp[0], g1 = gp[1], g2 = gp[2], g3 = gp[3];
            float x = gb;
#pragma unroll
            for (int e = 0; e < 4; ++e) x += g0[e] * w2[e] + g1[e] * w2[4 + e] + g2[e] * w2[8 + e] + g3[e] * w2[12 + e];
            const float ls = fminf(x, 0.f) - __logf(1.0f + __expf(-fabsf(x)));
            run += ls * (1.0f / 16.0f); pre[i] = run; }
        tot[sg * 128 + kc] = run;
        __syncthreads();
        const float t0 = tot[kc], t1 = tot[128 + kc], t2 = tot[256 + kc], t3 = tot[384 + kc];
        const float offs = (sg > 0 ? t0 : 0.f) + (sg > 1 ? t1 : 0.f) + (sg > 2 ? t2 : 0.f), blast = (t0 + t1) + (t2 + t3);
        if (sg == 0) DEC[(size_t)unit * 128 + kc] = __expf(blast);
        float k2[16];
#pragma unroll
        for (int i = 0; i < 16; ++i) { const int t = 16 * sg + i; const float bcv = pre[i] + offs;
            const float q = bf2f(rq[i]), k = bf2f(rk[i]);
            const float qt = q * __expf(bcv) * 0.08838834764831845f, kt = k * __expf(-bcv);
            k2[i] = k * __expf(blast - bcv);
            const bf16 qb = (bf16)f2bf(qt);
            QT[(row0 + t) * 512 + h * 128 + kc] = qb; Ql[t * 136 + kc] = qb; Kl[t * 136 + kc] = (bf16)f2bf(kt); }
        { v4u o0, o1; o0.x = cvtpk(k2[0], k2[1]); o0.y = cvtpk(k2[2], k2[3]); o0.z = cvtpk(k2[4], k2[5]); o0.w = cvtpk(k2[6], k2[7]);
          o1.x = cvtpk(k2[8], k2[9]); o1.y = cvtpk(k2[10], k2[11]); o1.z = cvtpk(k2[12], k2[13]); o1.w = cvtpk(k2[14], k2[15]);
          v4u* dst = (v4u*)(KTT + ((size_t)unit * 128 + kc) * 64 + 16 * sg); dst[0] = o0; dst[1] = o1; }
        __syncthreads();
#pragma unroll
        for (int ti = 0; ti < 2; ++ti) { const int tile = wave * 2 + ti, sb = tile >> 2, lb = tile & 3;
            f32x4 acc = {0.f, 0.f, 0.f, 0.f};
            if (sb <= lb) {
#pragma unroll
                for (int ks = 0; ks < 4; ++ks) { const bf16x8 a = *(const LAS bf16x8*)(Kl + (16 * sb + fr) * 136 + 32 * ks + 8 * fq), bq = *(const LAS bf16x8*)(Ql + (16 * lb + fr) * 136 + 32 * ks + 8 * fq);
                    acc = __builtin_amdgcn_mfma_f32_16x16x32_bf16(a, bq, acc, 0, 0, 0); }
            }
            const int l = 16 * lb + fr, s0 = 16 * sb + 4 * fq;
            v2u w; w.x = cvtpk(s0 <= l ? acc[0] : 0.f, s0 + 1 <= l ? acc[1] : 0.f); w.y = cvtpk(s0 + 2 <= l ? acc[2] : 0.f, s0 + 3 <= l ? acc[3] : 0.f);
            *(v2u*)(ATT + ((size_t)unit * 64 + l) * 64 + s0) = w; }
        if (unit + G >= NU) break;
    }
#undef GP_FETCH
}
DI void gla_seq(const InTab in, unsigned char* ws, LAS unsigned char* lds, int bx, int G, int tid, int lane, int wave) {
    typedef short bf16x8 __attribute__((ext_vector_type(8)));
    const bf16* VD = (const bf16*)(ws + WS_VD); const bf16* QT = (const bf16*)(ws + WS_QT); const bf16* KTT = (const bf16*)(ws + WS_KTT); const bf16* ATT = (const bf16*)(ws + WS_ATT);
    const float* DEC = (const float*)(ws + WS_DEC); bf16* GO = (bf16*)(ws + WS_GLAO);
    LAS bf16* vl0 = (LAS bf16*)(lds + RING_OFF);
    LAS bf16* ST = vl0 + 2 * 64 * 40;
    const int fr = lane & 15, fq = lane >> 4, lb = wave & 3, tq = fr >> 2, tp = fr & 3; const bool owave = wave < 4;
    for (int unit = bx; unit < BATCH * 32; unit += G) {
        const int b = unit >> 5, h = (unit >> 3) & 3, sl = unit & 7;
        f32x4 st[2]; st[0] = (f32x4){0.f, 0.f, 0.f, 0.f}; st[1] = (f32x4){0.f, 0.f, 0.f, 0.f};
        __syncthreads();
        for (int i = tid; i < 32 * 136 / 2; i += 512) ((LAS unsigned*)ST)[i] = 0u;
        v4u rV[2]; bf16x8 rA[2][2], rQ[2][4], rK[2][2]; f32x4 rD[2];
        rV[0] = rV[1] = (v4u){0u, 0u, 0u, 0u};
#pragma unroll
        for (int s_ = 0; s_ < 2; ++s_) {
#pragma unroll
            for (int ks = 0; ks < 2; ++ks) rA[s_][ks] = (bf16x8){0, 0, 0, 0, 0, 0, 0, 0};
#pragma unroll
            for (int ks = 0; ks < 4; ++ks) rQ[s_][ks] = (bf16x8){0, 0, 0, 0, 0, 0, 0, 0}; }
#define GLA_FETCH(set, chunk) do { const size_t r0_ = (size_t)b * SEQ + (size_t)(chunk) * 64; const size_t cu_ = (size_t)(b * 64 + (chunk)) * 4 + h; \
            if (tid < 256) rV[set] = *(const v4u*)(VD + (r0_ + (tid >> 2)) * 1024 + h * 256 + sl * 32 + (tid & 3) * 8); \
            _Pragma("unroll") for (int ks = 0; ks < 2; ++ks) rK[set][ks] = *(const bf16x8*)(KTT + (cu_ * 128 + 16 * wave + fr) * 64 + 32 * ks + 8 * fq); \
            if (owave) { _Pragma("unroll") for (int ks = 0; ks < 2; ++ks) rA[set][ks] = *(const bf16x8*)(ATT + (cu_ * 64 + 16 * lb + fr) * 64 + 32 * ks + 8 * fq); \
                _Pragma("unroll") for (int ks = 0; ks < 4; ++ks) rQ[set][ks] = *(const bf16x8*)(QT + (r0_ + 16 * lb + fr) * 512 + h * 128 + 32 * ks + 8 * fq); } \
            rD[set] = *(const f32x4*)(DEC + cu_ * 128 + 16 * wave + 4 * fq); } while (0)
#define GLA_STEP(set, chunk) do { const int ch_ = (chunk); const size_t row0 = (size_t)b * SEQ + (size_t)ch_ * 64; \
            const LAS bf16* vl = vl0 + (ch_ & 1) * (64 * 40); \
            bf16x8 wA[2], wQ[4], wK[2]; const f32x4 wD = rD[set]; \
            _Pragma("unroll") for (int ks = 0; ks < 2; ++ks) { wA[ks] = rA[set][ks]; wK[ks] = rK[set][ks]; } \
            _Pragma("unroll") for (int ks = 0; ks < 4; ++ks) wQ[ks] = rQ[set][ks]; \
            if (ch_ + 2 < SEQ / 64) GLA_FETCH(set, ch_ + 2); \
            const LAS bf16* Scur = ST + (ch_ & 1) * (32 * 136); LAS bf16* Snxt = ST + ((ch_ + 1) & 1) * (32 * 136); \
            bf16x8 vf[2][2]; \
            _Pragma("unroll") for (int d2 = 0; d2 < 2; ++d2) _Pragma("unroll") for (int ks = 0; ks < 2; ++ks) { \
                const v2u lo = tr16(vl + (32 * ks + 8 * fq + tq) * 40 + 16 * d2 + 4 * tp), hi = tr16(vl + (32 * ks + 8 * fq + 4 + tq) * 40 + 16 * d2 + 4 * tp); \
                v4u aw; aw.x = lo.x; aw.y = lo.y; aw.z = hi.x; aw.w = hi.y; vf[d2][ks] = __builtin_bit_cast(bf16x8, aw); } \
            if (owave) { _Pragma("unroll") for (int d2 = 0; d2 < 2; ++d2) { f32x4 o = {0.f, 0.f, 0.f, 0.f}, o2 = {0.f, 0.f, 0.f, 0.f}; \
                _Pragma("unroll") for (int ks = 0; ks < 2; ++ks) if (2 * ks <= lb) o = __builtin_amdgcn_mfma_f32_16x16x32_bf16(vf[d2][ks], wA[ks], o, 0, 0, 0); \
                _Pragma("unroll") for (int ks = 0; ks < 4; ++ks) { const bf16x8 a = *(const LAS bf16x8*)(Scur + (16 * d2 + fr) * 136 + 32 * ks + 8 * fq); \
                    if (ks & 1) o2 = __builtin_amdgcn_mfma_f32_16x16x32_bf16(a, wQ[ks], o2, 0, 0, 0); else o = __builtin_amdgcn_mfma_f32_16x16x32_bf16(a, wQ[ks], o, 0, 0, 0); } \
                o = o + o2; \
                v2u w; w.x = cvtpk(o[0], o[1]); w.y = cvtpk(o[2], o[3]); \
                *(v2u*)(GO + (row0 + 16 * lb + fr) * 1024 + h * 256 + sl * 32 + 16 * d2 + 4 * fq) = w; } } \
            _Pragma("unroll") for (int d2 = 0; d2 < 2; ++d2) { st[d2] = st[d2] * wD; \
                _Pragma("unroll") for (int ks = 0; ks < 2; ++ks) st[d2] = __builtin_amdgcn_mfma_f32_16x16x32_bf16(wK[ks], vf[d2][ks], st[d2], 0, 0, 0); \
                v2u sw; sw.x = cvtpk(st[d2][0], st[d2][1]); sw.y = cvtpk(st[d2][2], st[d2][3]); \
                *(LAS v2u*)(Snxt + (16 * d2 + fr) * 136 + 16 * wave + 4 * fq) = sw; } \
            if (tid < 256) *(LAS v4u*)(vl0 + ((ch_ + 1) & 1) * (64 * 40) + (tid >> 2) * 40 + (tid & 3) * 8) = rV[(set) ^ 1];     \
            BAR_LDS(); } while (0)
        GLA_FETCH(0, 0); GLA_FETCH(1, 1);
        if (tid < 256) *(LAS v4u*)(vl0 + (tid >> 2) * 40 + (tid & 3) * 8) = rV[0];
        __syncthreads();
        for (int ch = 0; ch < SEQ / 64; ch += 2) { GLA_STEP(0, ch); GLA_STEP(1, ch + 1); }
#undef GLA_FETCH
#undef GLA_STEP
    }
}
DI void gla_finalize(const InTab in, unsigned char* ws, int gw, int NGW, int lane) {
    const bf16* GO = (const bf16*)(ws + WS_GLAO); const bf16* GOUT = (const bf16*)(ws + WS_GOUT); bf16* Y = (bf16*)(ws + WS_A);
    const f32x4 g = *(const f32x4*)(in[31] + lane * 4);
    for (int m = 2 * gw; m < M; m += 2 * NGW) {
        v2u wo[2][4], wg[2][4];
#pragma unroll
        for (int r = 0; r < 2; ++r)
#pragma unroll
            for (int h = 0; h < 4; ++h) { wo[r][h] = *(const v2u*)(GO + (size_t)(m + r) * 1024 + h * 256 + lane * 4); wg[r][h] = *(const v2u*)(GOUT + (size_t)(m + r) * 1024 + h * 256 + lane * 4); }
#pragma unroll
        for (int r = 0; r < 2; ++r)
#pragma unroll
            for (int h = 0; h < 4; ++h) {
                const float v0 = bflo(wo[r][h].x), v1 = bfhi(wo[r][h].x), v2 = bflo(wo[r][h].y), v3 = bfhi(wo[r][h].y);
                const float rstd = __builtin_amdgcn_rsqf(wave_sum(v0 * v0 + v1 * v1 + v2 * v2 + v3 * v3) * (1.f / 256.f) + RMS_EPS);
                v2u o; o.x = cvtpk(v0 * rstd * g.x * silu_f(bflo(wg[r][h].x)), v1 * rstd * g.y * silu_f(bfhi(wg[r][h].x)));
                o.y = cvtpk(v2 * rstd * g.z * silu_f(bflo(wg[r][h].y)), v3 * rstd * g.w * silu_f(bfhi(wg[r][h].y)));
                *(v2u*)(Y + (size_t)(m + r) * D + 1024 + h * 256 + lane * 4) = o;
            }
    }
}
#define RT(base, first, ld) {(unsigned long long)(base) + 512ull * (unsigned long long)(first), (ld), 0}
__device__ const pg8::Route ROUTES[2][19] = {
  { RT(WS_U, 0, 512), RT(WS_U, 1, 512),
    RT(WS_Z, 0, 1536), RT(WS_Z, 1, 1536), RT(WS_Z, 2, 1536), RT(WS_Z, 3, 1536), RT(WS_Z, 4, 1536), RT(WS_Z, 5, 1536),
    RT(WS_XBC, 0, 2560), RT(WS_XBC, 1, 2560), RT(WS_XBC, 2, 2560), RT(WS_XBC, 3, 2560), RT(WS_XBC, 4, 2560), RT(WS_XBC, 5, 2560), RT(WS_XBC, 6, 2560), RT(WS_XBC, 7, 2560), RT(WS_XBC, 8, 2560), RT(WS_XBC, 9, 2560),
    RT(WS_DT, 0, 32) },
  { RT(WS_Q, 0, 1024), RT(WS_Q, 1, 1024), RT(WS_Q, 2, 1024), RT(WS_Q, 3, 1024),
    RT(WS_K, 0, 256), RT(WS_V, 0, 256),
    RT(WS_QD, 0, 512), RT(WS_QD, 1, 512), RT(WS_KD, 0, 512), RT(WS_KD, 1, 512),
    RT(WS_VD, 0, 1024), RT(WS_VD, 1, 1024), RT(WS_VD, 2, 1024), RT(WS_VD, 3, 1024),
    RT(WS_GOUT, 0, 1024), RT(WS_GOUT, 1, 1024), RT(WS_GOUT, 2, 1024), RT(WS_GOUT, 3, 1024),
    RT(WS_GLR, 0, 16) } };
#undef RT
constexpr bool USE_HB5 = XMANT < 7;
DI pg8::ssq_t* ssq(unsigned char* ws, int k) { return k == 0 ? (pg8::ssq_t*)(ws + WS_SS0) : (pg8::ssq_t*)(ws + WS_SS) + (size_t)(k - 1) * M; }
struct Args { const float* in[37]; float* out; unsigned char* ws; int ph_lo, ph_hi; };
#define IN(k) (lo <= (k) && (k) < hi)
#define SEAM(k) do { if (IN(k) && IN((k) + 1)) xcd_barrier(bar); } while (0)
template <int LAYER, int HF>
DI void ffn_half(const InTab in, float* out, unsigned char* ws, LAS unsigned char* lds, const XcdBarrier& bar, int G, int bx) {
    constexpr int MH = M / 2; constexpr size_t R0 = (size_t)HF * MH;
    bf16* HB = (bf16*)(ws + WS_HB) + R0 * D; bf16* Hh = (bf16*)(ws + WS_H) + R0 * FF;
    const bf16* W13 = (const bf16*)(ws + (LAYER ? WS_W13_1 : WS_W13_0)); const bf16* W2 = (const bf16*)(ws + (LAYER ? WS_W2_1 : WS_W2_0));
    { pg8::Gemm g{USE_HB5 ? (const bf16*)(ws + WS_HB5) + R0 * D : HB, W13, MH, 2 * FF, D}; pg8::RevOrder S; S.init(MH, 2 * FF, G, bx);
      pg8::EpiSwiGLU E{Hh, FF, ssq(ws, LAYER ? 3 : 1) + R0, 1.0f / D, RMS_EPS};
      pg8::gemm_phase<pg8::EpiSwiGLU, pg8::RevOrder, true, true>(lds + RING_OFF, g, S, E); }
    xcd_barrier(bar);
    { pg8::Gemm g{Hh, W2, MH, D, FF}; pg8::StaticOrder S; S.init(MH, D, G, bx);
      if (LAYER == 0) { pg8::EpiResidBf<false> E{nullptr, HB, D, ssq(ws, 2) + R0, nullptr};
          pg8::gemm_phase<pg8::EpiResidBf<false>, pg8::StaticOrder, true, true>(lds + RING_OFF, g, S, E); }
      else { pg8::EpiResidOut E{HB, out + R0 * D, D};
          pg8::gemm_phase<pg8::EpiResidOut, pg8::StaticOrder, true, true>(lds + RING_OFF, g, S, E); } }
}
template <int LAYER>
DI void layer_body(const InTab in, float* out, unsigned char* ws, LAS unsigned char* lds, const XcdBarrier& bar, int lo, int hi, int tid, int lane, int wave, int G, int bx) {
    constexpr int pb = LAYER * 9;
    const int gw = bx * NWAVES + wave, NGW = G * NWAVES, gt = bx * NWAVES * 64 + tid, NGT = G * NWAVES * 64;
    bf16* HB = (bf16*)(ws + WS_HB); bf16* YM = (bf16*)(ws + WS_A);
    const bf16* WIN = (const bf16*)(ws + (LAYER ? WS_WIN1 : WS_WIN0)); const bf16* WOUT = (const bf16*)(ws + (LAYER ? WS_WOUT1 : WS_WOUT0));
    const bf16* W13 = (const bf16*)(ws + (LAYER ? WS_W13_1 : WS_W13_0)); const bf16* W2 = (const bf16*)(ws + (LAYER ? WS_W2_1 : WS_W2_0));
    if (LAYER == 0) {
        if (IN(pb + 0)) { prologue(in, ws, lds, gw, NGW, lane, wave); s5_tables(in, ws, gt); x_to_hb_phase(in[0], HB, ssq(ws, 0), gw, NGW, lane); }
        SEAM(pb + 0);
    }
    if (IN(pb + 1)) {
        if (LAYER == 0) { s5_tables2(in, ws, lds, bx, G, tid); __syncthreads(); }
        pg8::Gemm g{HB, WIN, M, N_MAIN, D};
        pg8::EpiRoute E; E.ws = ws; E.tab = ROUTES[LAYER]; E.ftile = -1; E.fbase = nullptr; E.fld = 0; E.fcols = 0; E.ss = ssq(ws, LAYER ? 2 : 0); E.inv_n = 1.0f / D; E.eps = RMS_EPS;
        pg8::TailOrder<LAYER == 0 ? 2 : 1> S; S.init(M, N_MAIN, G, bx); S.A = HB; S.Bt = WIN + (size_t)N_MAIN * D; S.tail_pn = N_MAIN / 256 - 1; S.ss = ssq(ws, LAYER ? 2 : 0); S.inv_n = 1.0f / D; S.eps = RMS_EPS;
        if (LAYER == 0) { S.out = (float*)(ws + WS_DT); S.ldo = 32; S.ncols = 24; }
        else { S.out = (float*)(ws + WS_GLR); S.ldo = 16; S.ncols = 16; }
        pg8::gemm_phase<pg8::EpiRoute, pg8::TailOrder<LAYER == 0 ? 2 : 1>, true, true>(lds + RING_OFF, g, S, E);
    }
    SEAM(pb + 1);
    if (IN(pb + 2)) {
        if (LAYER == 0) {
            const int ha = G / 4;
            if (bx < ha) s5_fast(in, ws, lds, bx, 64, ha, tid, lane, wave);
            else conv_phase(in, ws, (bx - ha) * NWAVES * 64 + tid, (G - ha) * NWAVES * 64);
        }
        else { gla_pre(in, ws, lds, bx, G, tid, lane, wave); __syncthreads(); swa_fast(in, ws, lds, bx, G, tid, lane, wave); }
    }
    SEAM(pb + 2);
    if (IN(pb + 3)) {
        if (LAYER == 0) { ssd_fast(in, ws, lds, bx, G, tid, lane, wave);
            const bool spare = G > 192;
            if (!spare || bx >= 192) s5_fast(in, ws, lds, 64 + (spare ? bx - 192 : bx), 256, spare ? G - 192 : G, tid, lane, wave); }
        else gla_seq(in, ws, lds, bx, G, tid, lane, wave);
    }
    SEAM(pb + 3);
    if (IN(pb + 4)) {
        if (LAYER == 0) {
            ssd_finalize(in, ws, gw, NGW, lane);
            __syncthreads();
            pg8::Gemm g{(const bf16*)(ws + WS_YPRE), (const bf16*)(ws + WS_GLUW), M, 512, 512}; pg8::StaticOrder S; S.init(M, 512, G, bx);
            pg8::EpiGLU E{(const bf16*)(ws + WS_YPRE), 512, YM, D, in[12]};
            pg8::gemm_phase<pg8::EpiGLU, pg8::StaticOrder, true, true>(lds + RING_OFF, g, S, E);
        } else gla_finalize(in, ws, gw, NGW, lane);
    }
    SEAM(pb + 4);
    if (IN(pb + 5)) {
        pg8::Gemm g{YM, WOUT, M, D, D}; pg8::StaticOrder S; S.init(M, D, G, bx);
        pg8::EpiResidBf<false, USE_HB5> E{nullptr, HB, D, ssq(ws, LAYER ? 3 : 1), (bf16*)(ws + WS_HB5)};
        pg8::gemm_phase<pg8::EpiResidBf<false, USE_HB5>, pg8::StaticOrder, true, true>(lds + RING_OFF, g, S, E);
    }
    if (IN(pb + 5) && IN(pb + 7)) xcd_barrier(bar);
    if (IN(pb + 7)) {
        ffn_half<LAYER, 0>(in, out, ws, lds, bar, G, bx);
        ffn_half<LAYER, 1>(in, out, ws, lds, bar, G, bx);
    }
    if (LAYER == 0) { if (IN(pb + 7) && IN(pb + 10)) xcd_barrier(bar); }
}
__global__ void __launch_bounds__(NWAVES * 64, 2) fwd(Args args) {
    extern __shared__ __attribute__((aligned(16))) unsigned char lds_raw[];
    LAS unsigned char* lds = (LAS unsigned char*)lds_raw;
    volatile LAS unsigned* MISC = (volatile LAS unsigned*)(lds + MISC_OFF);
    const int tid = threadIdx.x, lane = tid & 63, wave = __builtin_amdgcn_readfirstlane(tid >> 6);
    const int G = gridDim.x, bx = blockIdx.x;
    unsigned char* ws = args.ws;
    if (tid < 32) MISC[tid] = 0u;
    if (tid < 37) ((LAS unsigned long long*)(lds + PT_OFF))[tid] = (unsigned long long)args.in[tid];
    __syncthreads();
    InTab in; in.t = (const LAS unsigned long long*)(lds + PT_OFF);
    const int lo = args.ph_lo, hi = args.ph_hi;
    XcdBarrier bar; bar.bar = (unsigned*)(ws + WS_CTL) + CW_BAR; bar.x = 0; bar.st = nullptr;
    if (hi - lo > 1) bar = xcd_barrier_post((unsigned*)(ws + WS_CTL) + CW_BAR, MISC + 8);
    layer_body<0>(in, args.out, ws, lds, bar, lo, hi, tid, lane, wave, G, bx);
    layer_body<1>(in, args.out, ws, lds, bar, lo, hi, tid, lane, wave, G, bx);
}
#undef IN
#undef SEAM

extern "C" void kernel_launch(void* const* d_in, const int* in_sizes, int n_in, void* d_out, int out_size, void* d_ws, size_t ws_size, hipStream_t stream) {
    static int grid = 0;
    if (grid == 0) {
        if (n_in != 37 || in_sizes[0] != M * D || out_size != M * D || ws_size < WS_END) { fprintf(stderr, "kernel_launch: unexpected shapes (n_in %d, in0 %d, out %d, ws %zu)\n", n_in, n_in > 0 ? in_sizes[0] : -1, out_size, ws_size); grid = -1; return; }
        int dev = 0, cus = 0;
        if (hipGetDevice(&dev) != hipSuccess || hipDeviceGetAttribute(&cus, hipDeviceAttributeMultiprocessorCount, dev) != hipSuccess) { grid = -1; return; }
        if (hipFuncSetAttribute((const void*)fwd, hipFuncAttributeMaxDynamicSharedMemorySize, LDS_BYTES) != hipSuccess) { fprintf(stderr, "kernel_launch: hipFuncSetAttribute failed\n"); grid = -1; return; }
        int per_cu = 0;
        if (hipOccupancyMaxActiveBlocksPerMultiprocessor(&per_cu, (const void*)fwd, NWAVES * 64, LDS_BYTES) != hipSuccess || per_cu < 1) fprintf(stderr, "kernel_launch: occupancy query reports %d\n", per_cu);
        (void)hipGetLastError();
        grid = cus;
    }
    if (grid < 0) return;
    if (hipMemsetAsync((char*)d_ws + WS_CTL, 0, CTL_ZERO_BYTES, stream) != hipSuccess) return;
    Args a{};
    for (int i = 0; i < 37; ++i) a.in[i] = (const float*)d_in[i];
    a.out = (float*)d_out; a.ws = (unsigned char*)d_ws;
    a.ph_lo = 0; a.ph_hi = NPHASE;
    hipLaunchKernelGGL(fwd, dim3(grid), dim3(NWAVES * 64), LDS_BYTES, stream, a);
}
```

```cpp
#include <hip/hip_runtime.h>
#include <cstdio>
#include <cstdint>
#include <cmath>
#ifndef WM_IN
#define WM_IN 7
#endif
#ifndef WM_OUT
#define WM_OUT 7
#endif
#ifndef WM_FFN
#define WM_FFN 5
#endif
#ifndef AMANT
#define AMANT 7
#endif
#ifndef HMANT
#define HMANT 7
#endif
#ifndef XMANT
#define XMANT 7
#endif
namespace pg8 {
#define PG8_LAS __attribute__((address_space(3)))
typedef unsigned short bf16_t;
typedef short bf16x8 __attribute__((ext_vector_type(8)));
typedef float f32x4 __attribute__((ext_vector_type(4)));
typedef unsigned u32x4 __attribute__((ext_vector_type(4)));
constexpr int BM = 256, BK = 64, HALF = 128, HTB = HALF * BK * 2  , STAGE_BYTES = 8 * HTB, NXCD = 8, WGM = 8;

__host__ __device__ __forceinline__ int lds_byte(int r, int c) { const int st = (r >> 4) * 2 + (c >> 5), rr = r & 15, cc = c & 31, ob = rr * 64 + cc * 2; return st * 1024 + (ob ^ (((ob >> 9) & 1) << 5)); }
__host__ __device__ __forceinline__ void stage_rc(int b, int& R, int& C) { const int st = b / 1024, sb = b % 1024, swz = sb ^ (((sb >> 9) & 1) << 5); R = (st >> 1) * 16 + swz / 64; C = (st & 1) * 32 + (swz % 64) / 2; }
__host__ __device__ __forceinline__ int perm32(int rho) { const int n = rho >> 4, i = rho & 15; return 8 * (i >> 2) + 4 * n + (i & 3); }

struct Unit { int pm, pn; };
struct Gemm { const bf16_t* A; const bf16_t* Bt; int M, N, K; };

struct StaticOrder {
    int nM, nN, nwg, G, c;
    __host__ __device__ void init(int M, int N, int G_, int c_) { nM = M / BM; nN = N / BM; nwg = nM * nN; G = G_; c = c_; }
    __host__ __device__ bool next(int i, Unit& u) const {
        const long L = (long)i * G + c; if (L >= nwg) return false;
        int wgid = (int)L; { const int q = nwg / NXCD, r = nwg % NXCD, xcd = wgid % NXCD, off = wgid / NXCD; wgid = (xcd < r ? xcd * (q + 1) : r * (q + 1) + (xcd - r) * q) + off; }
        const int nig = WGM * nN, gid = wgid / nig, fm = gid * WGM, gsz = (nM - fm) < WGM ? (nM - fm) : WGM;
        u.pm = fm + ((wgid % nig) % gsz); u.pn = (wgid % nig) / gsz; return true;
    }
    __device__ __forceinline__ void a_ready(const Unit&) const {}
    __device__ __forceinline__ void done(const Unit&) const {}
};
__device__ __forceinline__ unsigned cvt_pk_bf16(float lo, float hi) { unsigned r; asm volatile("v_cvt_pk_bf16_f32 %0, %1, %2" : "=v"(r) : "v"(lo), "v"(hi)); return r; }
typedef unsigned long long ssq_t;
__device__ __forceinline__ float ssq_to_f(ssq_t q) { return ((float)(unsigned)(q >> 32) * 4294967296.0f + (float)(unsigned)q) * (1.0f / 16777216.0f); }
__device__ __forceinline__ ssq_t ssq_from_f(float s) { return (ssq_t)(s * 16777216.0f); }
struct RevOrder : StaticOrder {
    __host__ __device__ bool next(int i, Unit& u) const {
        const long L = (long)nwg - (long)G * (i + 1) + c; if (L < 0) return false;
        int wgid = (int)L; { const int q = nwg / NXCD, r = nwg % NXCD, xcd = wgid % NXCD, off = wgid / NXCD; wgid = (xcd < r ? xcd * (q + 1) : r * (q + 1) + (xcd - r) * q) + off; }
        const int nig = WGM * nN, gid = wgid / nig, fm = gid * WGM, gsz = (nM - fm) < WGM ? (nM - fm) : WGM;
        u.pm = fm + ((wgid % nig) % gsz); u.pn = (wgid % nig) / gsz; return true;
    }
};
template <int NB> struct TailOrder : StaticOrder {
    const bf16_t* A; const bf16_t* Bt; float* out; int ldo, ncols, tail_pn; const ssq_t* ss; float inv_n, eps;
    __device__ __forceinline__ void done(const Unit& u) const {
        if (u.pn != tail_pn) return;
        const int lane = threadIdx.x & 63, wave = __builtin_amdgcn_readfirstlane(threadIdx.x >> 6), fr = lane & 15, fq = lane >> 4;
        const int row0 = u.pm * BM + wave * 32;
        f32x4 c[2][NB];
#pragma unroll
        for (int rb = 0; rb < 2; ++rb)
#pragma unroll
            for (int nb = 0; nb < NB; ++nb) c[rb][nb] = (f32x4){0.f, 0.f, 0.f, 0.f};
        const bf16_t* ap = A + (size_t)(row0 + fr) * 2048 + 8 * fq; const bf16_t* bp = Bt + (size_t)fr * 2048 + 8 * fq;
#pragma unroll 1
        for (int kc = 0; kc < 64; kc += 8) {
            bf16x8 a0[8], a1[8], bb[NB][8];
#pragma unroll
            for (int j = 0; j < 8; ++j) { a0[j] = *(const bf16x8*)(ap + 32 * (kc + j)); a1[j] = *(const bf16x8*)(ap + 16 * 2048 + 32 * (kc + j));
#pragma unroll
                for (int nb = 0; nb < NB; ++nb) bb[nb][j] = *(const bf16x8*)(bp + (size_t)nb * 16 * 2048 + 32 * (kc + j)); }
#pragma unroll
            for (int j = 0; j < 8; ++j)
#pragma unroll
                for (int nb = 0; nb < NB; ++nb) { c[0][nb] = __builtin_amdgcn_mfma_f32_16x16x32_bf16(a0[j], bb[nb][j], c[0][nb], 0, 0, 0); c[1][nb] = __builtin_amdgcn_mfma_f32_16x16x32_bf16(a1[j], bb[nb][j], c[1][nb], 0, 0, 0); }
        }
        float rsv[2][4];
#pragma unroll
        for (int rb = 0; rb < 2; ++rb)
#pragma unroll
            for (int e = 0; e < 4; ++e) rsv[rb][e] = ss ? __builtin_amdgcn_rsqf(ssq_to_f(ss[row0 + 16 * rb + 4 * fq + e]) * inv_n + eps) : 1.0f;
#pragma unroll
        for (int rb = 0; rb < 2; ++rb)
#pragma unroll
            for (int e = 0; e < 4; ++e) { const int row = row0 + 16 * rb + 4 * fq + e; const float rs = rsv[rb][e];
#pragma unroll
                for (int nb = 0; nb < NB; ++nb) { const int col = 16 * nb + fr; if (col < ncols) out[(size_t)row * ldo + col] = c[rb][nb][e] * rs; } }
    }
};
__device__ __forceinline__ float rnd_am(float f) { if (AMANT >= 7) return f; constexpr int sh = 16 + (7 - AMANT); unsigned u = __builtin_bit_cast(unsigned, f); u = (u + ((1u << (sh - 1)) - 1u) + ((u >> sh) & 1u)) & ~((1u << sh) - 1u); return __builtin_bit_cast(float, u); }
template <int MB> __device__ __forceinline__ float rnd_m(float f) { if (MB >= 7) return f; constexpr int sh = 16 + (7 - (MB >= 7 ? 7 : MB)); unsigned u = __builtin_bit_cast(unsigned, f); u = (u + ((1u << (sh - 1)) - 1u) + ((u >> sh) & 1u)) & ~((1u << sh) - 1u); return __builtin_bit_cast(float, u); }
__device__ __forceinline__ float fast_silu(float x) { return x * __builtin_amdgcn_rcpf(1.0f + __expf(-x)); }
__device__ __forceinline__ float fast_sigmoid(float x) { return __builtin_amdgcn_rcpf(1.0f + __expf(-x)); }

struct Route { unsigned long long off; int ld; int pad; };
struct EpiRoute {
    static constexpr bool PERM = true, AFTER_DRAIN = false;
    unsigned char* ws; const Route* tab;
    float* fbase; int fld, fcols, ftile;
    const ssq_t* ss; float inv_n, eps;
    __device__ __forceinline__ void operator()(const f32x4 (&acc)[2][2][4][2], const Unit& u, int wr, int wc, int fr, int fq) const {
        const int row0 = u.pm * BM + wr * 64 + fr;
        float rs[2][4];
#pragma unroll
        for (int ai = 0; ai < 2; ++ai)
#pragma unroll
            for (int m = 0; m < 4; ++m) rs[ai][m] = ss ? __builtin_amdgcn_rsqf(ssq_to_f(ss[row0 + ai * HALF + m * 16]) * inv_n + eps) : 1.0f;
        if (u.pn == ftile) {
            if (wc == 0) {
#pragma unroll
                for (int ai = 0; ai < 2; ++ai)
#pragma unroll
                    for (int m = 0; m < 4; ++m) { float* rowp = fbase + (size_t)(row0 + ai * HALF + m * 16) * fld;
#pragma unroll
                        for (int n = 0; n < 2; ++n) { const int col = 8 * fq + 4 * n; if (col < fcols) *(f32x4*)(rowp + col) = acc[ai][0][m][n] * rs[ai][m]; } }
            }
            return;
        }
        const Route r = tab[u.pn];
        bf16_t* base = (bf16_t*)(ws + r.off); const int ld = r.ld;
        const int col0 = wc * 32 + 8 * fq;
#pragma unroll
        for (int ai = 0; ai < 2; ++ai)
#pragma unroll
            for (int m = 0; m < 4; ++m) { bf16_t* rowp = base + (size_t)(row0 + ai * HALF + m * 16) * ld + col0;
#pragma unroll
                for (int bj = 0; bj < 2; ++bj) { const f32x4 v0 = acc[ai][bj][m][0] * rs[ai][m], v1 = acc[ai][bj][m][1] * rs[ai][m];
                    u32x4 w; w.x = cvt_pk_bf16(v0[0], v0[1]); w.y = cvt_pk_bf16(v0[2], v0[3]); w.z = cvt_pk_bf16(v1[0], v1[1]); w.w = cvt_pk_bf16(v1[2], v1[3]);
                    *(u32x4*)(rowp + bj * HALF) = w; } }
    }
};

template <bool F32IN, bool COPY = false> struct EpiResidBf {
    static_assert(!F32IN, "the residual stream is read from hb");
    static constexpr bool PERM = true, AFTER_DRAIN = false;
    const float* xin; bf16_t* hb; int ldc; ssq_t* ss; bf16_t* hb5;
    __device__ __forceinline__ void load_half(u32x4 (&w)[4][2], int rbase, int col0) const {
#pragma unroll
        for (int m = 0; m < 4; ++m) { const size_t off = (size_t)(rbase + m * 16) * ldc + col0;
#pragma unroll
            for (int bj = 0; bj < 2; ++bj) w[m][bj] = *(const u32x4*)(hb + off + bj * HALF); }
    }
    __device__ __forceinline__ void store_half(const u32x4 (&w)[4][2], const f32x4 (&acc)[2][4][2], float (&sv)[4], int rbase, int col0) const {
#pragma unroll
        for (int m = 0; m < 4; ++m) { const size_t off = (size_t)(rbase + m * 16) * ldc + col0;
            float s = 0.f;
#pragma unroll
            for (int bj = 0; bj < 2; ++bj) { const u32x4 q = w[m][bj];
                const f32x4 r0 = {__uint_as_float(q.x << 16), __uint_as_float(q.x & 0xffff0000u), __uint_as_float(q.y << 16), __uint_as_float(q.y & 0xffff0000u)};
                const f32x4 r1 = {__uint_as_float(q.z << 16), __uint_as_float(q.z & 0xffff0000u), __uint_as_float(q.w << 16), __uint_as_float(q.w & 0xffff0000u)};
                const f32x4 v0 = r0 + acc[bj][m][0], v1 = r1 + acc[bj][m][1];
                s += (v0[0] * v0[0] + v0[1] * v0[1]) + (v0[2] * v0[2] + v0[3] * v0[3]) + (v1[0] * v1[0] + v1[1] * v1[1]) + (v1[2] * v1[2] + v1[3] * v1[3]);
                u32x4 o; o.x = cvt_pk_bf16(v0[0], v0[1]); o.y = cvt_pk_bf16(v0[2], v0[3]); o.z = cvt_pk_bf16(v1[0], v1[1]); o.w = cvt_pk_bf16(v1[2], v1[3]);
                *(u32x4*)(hb + off + bj * HALF) = o;
                if (COPY) { u32x4 c; c.x = cvt_pk_bf16(rnd_m<XMANT>(v0[0]), rnd_m<XMANT>(v0[1])); c.y = cvt_pk_bf16(rnd_m<XMANT>(v0[2]), rnd_m<XMANT>(v0[3])); c.z = cvt_pk_bf16(rnd_m<XMANT>(v1[0]), rnd_m<XMANT>(v1[1])); c.w = cvt_pk_bf16(rnd_m<XMANT>(v1[2]), rnd_m<XMANT>(v1[3]));
                    *(u32x4*)(hb5 + off + bj * HALF) = c; } }
            s += __shfl_xor(s, 16); s += __shfl_xor(s, 32); sv[m] = s; }
    }
    __device__ __forceinline__ void add_half(const float (&sv)[4], int rbase, int fq) const {
#pragma unroll
        for (int m = 0; m < 4; ++m) if (fq == 0) (void)__hip_atomic_fetch_add(ss + rbase + m * 16, ssq_from_f(sv[m]), __ATOMIC_RELAXED, __HIP_MEMORY_SCOPE_AGENT);
    }
    __device__ __forceinline__ void operator()(const f32x4 (&acc)[2][2][4][2], const Unit& u, int wr, int wc, int fr, int fq) const {
        const int row0 = u.pm * BM + wr * 64 + fr, col0 = u.pn * BM + wc * 32 + 8 * fq;
        u32x4 w0[4][2], w1[4][2]; float s0[4], s1[4];
        load_half(w0, row0, col0);
        store_half(w0, acc[0], s0, row0, col0);
        load_half(w1, row0 + HALF, col0);
        add_half(s0, row0, fq);
        store_half(w1, acc[1], s1, row0 + HALF, col0);
        add_half(s1, row0 + HALF, fq);
    }
};
struct EpiResidOut {
    static constexpr bool PERM = true, AFTER_DRAIN = false;
    const bf16_t* hb; float* out; int ldc;
    __device__ __forceinline__ void operator()(const f32x4 (&acc)[2][2][4][2], const Unit& u, int wr, int wc, int fr, int fq) const {
        const int row0 = u.pm * BM + wr * 64 + fr, col0 = u.pn * BM + wc * 32 + 8 * fq;
#pragma unroll
        for (int ai = 0; ai < 2; ++ai) {
            u32x4 w[4][2];
#pragma unroll
            for (int m = 0; m < 4; ++m) { const size_t off = (size_t)(row0 + ai * HALF + m * 16) * ldc + col0;
#pragma unroll
                for (int bj = 0; bj < 2; ++bj) w[m][bj] = *(const u32x4*)(hb + off + bj * HALF); }
#pragma unroll
            for (int m = 0; m < 4; ++m) { const size_t off = (size_t)(row0 + ai * HALF + m * 16) * ldc + col0;
#pragma unroll
                for (int bj = 0; bj < 2; ++bj) {
                    const f32x4 r0 = {__uint_as_float(w[m][bj].x << 16), __uint_as_float(w[m][bj].x & 0xffff0000u), __uint_as_float(w[m][bj].y << 16), __uint_as_float(w[m][bj].y & 0xffff0000u)};
                    const f32x4 r1 = {__uint_as_float(w[m][bj].z << 16), __uint_as_float(w[m][bj].z & 0xffff0000u), __uint_as_float(w[m][bj].w << 16), __uint_as_float(w[m][bj].w & 0xffff0000u)};
                    *(f32x4*)(out + off + bj * HALF) = r0 + acc[ai][bj][m][0]; *(f32x4*)(out + off + bj * HALF + 4) = r1 + acc[ai][bj][m][1]; } }
        }
    }
};

struct EpiSwiGLU {
    static constexpr bool PERM = true, AFTER_DRAIN = false;
    bf16_t* H; int ldc; const ssq_t* ss; float inv_n, eps;
    __device__ __forceinline__ void operator()(const f32x4 (&acc)[2][2][4][2], const Unit& u, int wr, int wc, int fr, int fq) const {
        const int row0 = u.pm * BM + wr * 64 + fr, col0 = u.pn * HALF + wc * 32 + 8 * fq;
        ssq_t q[2][4];
#pragma unroll
        for (int ai = 0; ai < 2; ++ai)
#pragma unroll
            for (int m = 0; m < 4; ++m) q[ai][m] = ss[row0 + ai * HALF + m * 16];
#pragma unroll
        for (int ai = 0; ai < 2; ++ai)
#pragma unroll
            for (int m = 0; m < 4; ++m) { bf16_t* rowp = H + (size_t)(row0 + ai * HALF + m * 16) * ldc + col0;
                const float rs = __builtin_amdgcn_rsqf(ssq_to_f(q[ai][m]) * inv_n + eps);
                float o[8];
#pragma unroll
                for (int n = 0; n < 2; ++n)
#pragma unroll
                    for (int e = 0; e < 4; ++e) o[4 * n + e] = rnd_m<HMANT>(fast_silu(acc[ai][0][m][n][e] * rs) * (acc[ai][1][m][n][e] * rs));
                u32x4 w; w.x = cvt_pk_bf16(o[0], o[1]); w.y = cvt_pk_bf16(o[2], o[3]); w.z = cvt_pk_bf16(o[4], o[5]); w.w = cvt_pk_bf16(o[6], o[7]);
                *(u32x4*)rowp = w; }
    }
};

struct EpiGLU {
    static constexpr bool PERM = true, AFTER_DRAIN = false;
    const bf16_t* Y; int ldy; bf16_t* O; int ldo; const float* bias;
    __device__ __forceinline__ void operator()(const f32x4 (&acc)[2][2][4][2], const Unit& u, int wr, int wc, int fr, int fq) const {
        const int row0 = u.pm * BM + wr * 64 + fr, col0 = u.pn * BM + wc * 32 + 8 * fq;
        f32x4 bv[2][2];
#pragma unroll
        for (int bj = 0; bj < 2; ++bj)
#pragma unroll
            for (int n = 0; n < 2; ++n) bv[bj][n] = *(const f32x4*)(bias + col0 + bj * HALF + 4 * n);
#pragma unroll
        for (int ai = 0; ai < 2; ++ai) {
          u32x4 yy[4][2];
#pragma unroll
          for (int m = 0; m < 4; ++m)
#pragma unroll
              for (int bj = 0; bj < 2; ++bj) yy[m][bj] = *(const u32x4*)(Y + (size_t)(row0 + ai * HALF + m * 16) * ldy + col0 + bj * HALF);
#pragma unroll
            for (int m = 0; m < 4; ++m) { const size_t r = (size_t)(row0 + ai * HALF + m * 16);
#pragma unroll
                for (int bj = 0; bj < 2; ++bj) { const u32x4 yv = yy[m][bj];
                    const f32x4 g0 = acc[ai][bj][m][0] + bv[bj][0], g1 = acc[ai][bj][m][1] + bv[bj][1];
                    float o[8];
                    o[0] = __uint_as_float(yv.x << 16) * fast_sigmoid(g0[0]); o[1] = __uint_as_float(yv.x & 0xffff0000u) * fast_sigmoid(g0[1]);
                    o[2] = __uint_as_float(yv.y << 16) * fast_sigmoid(g0[2]); o[3] = __uint_as_float(yv.y & 0xffff0000u) * fast_sigmoid(g0[3]);
                    o[4] = __uint_as_float(yv.z << 16) * fast_sigmoid(g1[0]); o[5] = __uint_as_float(yv.z & 0xffff0000u) * fast_sigmoid(g1[1]);
                    o[6] = __uint_as_float(yv.w << 16) * fast_sigmoid(g1[2]); o[7] = __uint_as_float(yv.w & 0xffff0000u) * fast_sigmoid(g1[3]);
                    u32x4 w; w.x = cvt_pk_bf16(o[0], o[1]); w.y = cvt_pk_bf16(o[2], o[3]); w.z = cvt_pk_bf16(o[4], o[5]); w.w = cvt_pk_bf16(o[6], o[7]);
                    *(u32x4*)(O + r * ldo + col0 + bj * HALF) = w; } }
        }
    }
};
template <class Epi, class Sched, bool ALIGN_EPI = false, bool SP2 = false>
__device__ __forceinline__ void gemm_phase(PG8_LAS unsigned char* lds, const Gemm g, const Sched& S, const Epi& E) {
    const int tid = threadIdx.x, wid = __builtin_amdgcn_readfirstlane(tid >> 6), lane = tid & 63, wr = wid >> 2, wc = wid & 3, fr = lane & 15, fq = lane >> 4;
    const int K = g.K, nt = K / BK;
    unsigned voffA[2], voffB[2];
#pragma unroll
    for (int i = 0; i < 2; ++i) { int R, C; stage_rc(tid * 16 + i * 8192, R, C); const int Rb = Epi::PERM ? ((R & ~31) + perm32(R & 31)) : R;
        voffA[i] = (unsigned)(R * K + C) * 2u; voffB[i] = (unsigned)(Rb * K + C) * 2u; }
    const size_t kstep = (size_t)(BK * 2);
    const size_t hstep = (size_t)HALF * K * 2;
    const size_t tstep = 2 * hstep;
    const unsigned ldsw = (unsigned)wid * 1024u;
    const int aoff = lds_byte(wr * 64 + fr, fq * 8), boff = lds_byte(wc * 32 + fr, fq * 8);
#define PG8_SA(b, h) (((b) * 2 + (h)) * HTB)
#define PG8_SB(b, h) ((4 + (b) * 2 + (h)) * HTB)
#define PG8_STAGE(bufoff, gbase, voff) do { _Pragma("unroll") for (int _i = 0; _i < 2; ++_i) \
        __builtin_amdgcn_global_load_lds((const unsigned*)((const char*)(gbase) + (voff)[_i]), (PG8_LAS unsigned*)(lds + (bufoff) + ldsw + _i * 8192), 16, 0, 0); } while (0)
#define PG8_LDA(dst, b, h) do { _Pragma("unroll") for (int m = 0; m < 4; ++m) _Pragma("unroll") for (int k = 0; k < 2; ++k) dst[m][k] = *(const PG8_LAS bf16x8*)(lds + PG8_SA(b, h) + aoff + m * 2048 + k * 1024); } while (0)
#define PG8_LDB(dst, b, h) do { _Pragma("unroll") for (int n = 0; n < 2; ++n) _Pragma("unroll") for (int k = 0; k < 2; ++k) dst[n][k] = *(const PG8_LAS bf16x8*)(lds + PG8_SB(b, h) + boff + n * 2048 + k * 1024); } while (0)
#define PG8_MMA(ai, bj, At, Bt) do { __builtin_amdgcn_s_setprio(1); _Pragma("unroll") for (int m = 0; m < 4; ++m) _Pragma("unroll") for (int n = 0; n < 2; ++n) _Pragma("unroll") for (int k = 0; k < 2; ++k) \
        acc[ai][bj][m][n] = __builtin_amdgcn_mfma_f32_16x16x32_bf16(Bt[n][k], At[m][k], acc[ai][bj][m][n], 0, 0, 0); __builtin_amdgcn_s_setprio(0); } while (0)
#define PG8_WAIT_V(n) asm volatile("s_waitcnt vmcnt(" #n ")" ::: "memory")
#define PG8_WAIT_L(n) asm volatile("s_waitcnt lgkmcnt(" #n ")" ::: "memory")
#define PG8_BAR __builtin_amdgcn_s_barrier()
#define PG8_SCHED __builtin_amdgcn_sched_barrier(0)
    Unit cur, nxt; int ui = 0;
    if (!S.next(0, cur)) return;
    f32x4 acc[2][2][4][2];
#pragma unroll
    for (int a = 0; a < 2; ++a)
#pragma unroll
        for (int b = 0; b < 2; ++b)
#pragma unroll
            for (int m = 0; m < 4; ++m)
#pragma unroll
                for (int n = 0; n < 2; ++n) acc[a][b][m][n] = (f32x4){0.f, 0.f, 0.f, 0.f};
    bf16x8 At[4][2], B0[2][2], B1[2][2];
    const char* cA = (const char*)g.A + (size_t)cur.pm * tstep; const char* cB = (const char*)g.Bt + (size_t)cur.pn * tstep;
    S.a_ready(cur);
    if constexpr (SP2) {
        PG8_STAGE(PG8_SB(0, 0), cB, voffB); PG8_STAGE(PG8_SB(0, 1), cB + hstep, voffB); PG8_STAGE(PG8_SA(0, 0), cA, voffA); PG8_STAGE(PG8_SA(0, 1), cA + hstep, voffA);
        if (wr == 1) PG8_BAR;
        PG8_WAIT_V(2); PG8_BAR;
        PG8_STAGE(PG8_SB(1, 0), cB + kstep, voffB); PG8_STAGE(PG8_SA(1, 0), cA + kstep, voffA); PG8_STAGE(PG8_SB(1, 1), cB + hstep + kstep, voffB);
        PG8_WAIT_V(6); PG8_BAR;
    } else {
        PG8_STAGE(PG8_SB(0, 0), cB, voffB); PG8_STAGE(PG8_SA(0, 0), cA, voffA); PG8_STAGE(PG8_SB(0, 1), cB + hstep, voffB); PG8_STAGE(PG8_SA(0, 1), cA + hstep, voffA);
        if (wr == 1) PG8_BAR;
        PG8_WAIT_V(4); PG8_BAR;
        PG8_STAGE(PG8_SB(1, 0), cB + kstep, voffB); PG8_STAGE(PG8_SA(1, 0), cA + kstep, voffA); PG8_STAGE(PG8_SB(1, 1), cB + hstep + kstep, voffB);
        PG8_WAIT_V(6); PG8_BAR;
    }
    for (;;) {
        const bool has_next = S.next(ui + 1, nxt);
        const char* nA = has_next ? (const char*)g.A + (size_t)nxt.pm * tstep : cA; const char* nB = has_next ? (const char*)g.Bt + (size_t)nxt.pn * tstep : cB;
        for (int t = 0; t < nt; t += 2) {
            const bool last = (t == nt - 2);
            const char* a1 = cA + (size_t)(t + 1) * kstep;
            const char* a2 = last ? nA : cA + (size_t)(t + 2) * kstep; const char* b2 = last ? nB : cB + (size_t)(t + 2) * kstep;
            const char* a3 = a2 + kstep; const char* b3 = b2 + kstep;
            if (last && has_next) S.a_ready(nxt);
            if constexpr (SP2) {
            PG8_LDB(B0, 0, 0); PG8_LDB(B1, 0, 1); PG8_SCHED; PG8_LDA(At, 0, 0); PG8_STAGE(PG8_SA(1, 1), a1 + hstep, voffA);
            PG8_WAIT_V(8); PG8_WAIT_L(0); PG8_BAR; PG8_MMA(0, 0, At, B0); PG8_MMA(0, 1, At, B1); PG8_BAR; PG8_SCHED;
            PG8_LDA(At, 0, 1); PG8_STAGE(PG8_SB(0, 0), b2, voffB); PG8_STAGE(PG8_SB(0, 1), b2 + hstep, voffB); PG8_STAGE(PG8_SA(0, 0), a2, voffA);
            PG8_WAIT_V(8); PG8_WAIT_L(0); PG8_BAR; PG8_MMA(1, 0, At, B0); PG8_MMA(1, 1, At, B1); PG8_BAR; PG8_SCHED;
            PG8_LDB(B0, 1, 0); PG8_LDB(B1, 1, 1); PG8_SCHED; PG8_LDA(At, 1, 0); PG8_STAGE(PG8_SA(0, 1), a2 + hstep, voffA);
            PG8_WAIT_V(8); PG8_WAIT_L(0); PG8_BAR; PG8_MMA(0, 0, At, B0); PG8_MMA(0, 1, At, B1); PG8_BAR; PG8_SCHED;
            PG8_LDA(At, 1, 1); PG8_STAGE(PG8_SB(1, 0), b3, voffB); PG8_STAGE(PG8_SB(1, 1), b3 + hstep, voffB); PG8_STAGE(PG8_SA(1, 0), a3, voffA);
            PG8_WAIT_V(8); PG8_WAIT_L(0); PG8_BAR; PG8_MMA(1, 0, At, B0); PG8_MMA(1, 1, At, B1); PG8_BAR; PG8_SCHED;
            } else {
            PG8_LDB(B0, 0, 0); PG8_SCHED; PG8_LDA(At, 0, 0); PG8_STAGE(PG8_SA(1, 1), a1 + hstep, voffA);
            PG8_WAIT_L(8); PG8_BAR; PG8_WAIT_L(0); PG8_MMA(0, 0, At, B0); PG8_BAR; PG8_SCHED;
            PG8_LDB(B1, 0, 1); PG8_STAGE(PG8_SB(0, 0), b2, voffB);
            PG8_BAR; PG8_WAIT_L(0); PG8_MMA(0, 1, At, B1); PG8_BAR;
            PG8_LDA(At, 0, 1); PG8_STAGE(PG8_SA(0, 0), a2, voffA);
            PG8_BAR; PG8_WAIT_L(0); PG8_MMA(1, 0, At, B0); PG8_BAR; PG8_SCHED;
            PG8_STAGE(PG8_SB(0, 1), b2 + hstep, voffB);
            PG8_WAIT_V(6); PG8_BAR; PG8_MMA(1, 1, At, B1); PG8_BAR;
            PG8_LDB(B0, 1, 0); PG8_SCHED; PG8_LDA(At, 1, 0); PG8_STAGE(PG8_SA(0, 1), a2 + hstep, voffA);
            PG8_WAIT_L(8); PG8_BAR; PG8_WAIT_L(0); PG8_MMA(0, 0, At, B0); PG8_BAR; PG8_SCHED;
            PG8_LDB(B1, 1, 1); PG8_STAGE(PG8_SB(1, 0), b3, voffB);
            PG8_BAR; PG8_WAIT_L(0); PG8_MMA(0, 1, At, B1); PG8_BAR;
            PG8_LDA(At, 1, 1); PG8_STAGE(PG8_SA(1, 0), a3, voffA);
            PG8_BAR; PG8_WAIT_L(0); PG8_MMA(1, 0, At, B0); PG8_BAR; PG8_SCHED;
            PG8_STAGE(PG8_SB(1, 1), b3 + hstep, voffB);
            PG8_WAIT_V(6); PG8_BAR; PG8_MMA(1, 1, At, B1); PG8_BAR;
            }
        }
        if constexpr (ALIGN_EPI) { if (wr == 0) PG8_BAR; }
        if constexpr (!Epi::AFTER_DRAIN) { E(acc, cur, wr, wc, fr, fq); S.done(cur); }
        if (!has_next) break;
#pragma unroll
        for (int a = 0; a < 2; ++a)
#pragma unroll
            for (int b = 0; b < 2; ++b)
#pragma unroll
                for (int m = 0; m < 4; ++m)
#pragma unroll
                    for (int n = 0; n < 2; ++n) acc[a][b][m][n] = (f32x4){0.f, 0.f, 0.f, 0.f};
        cur = nxt; cA = nA; cB = nB; ++ui;
        if constexpr (ALIGN_EPI) { if (wr == 1) PG8_BAR; }
    }
    PG8_WAIT_V(0);
    if constexpr (!ALIGN_EPI) { if (wr == 0) PG8_BAR; }
    PG8_BAR;
    if constexpr (Epi::AFTER_DRAIN) { E.fused(acc, cur, wr, wc, fr, fq, lds, wid, lane); S.done(cur); }
#undef PG8_SA
#undef PG8_SB
#undef PG8_STAGE
#undef PG8_LDA
#undef PG8_LDB
#undef PG8_MMA
#undef PG8_WAIT_V
#undef PG8_WAIT_L
#undef PG8_BAR
#undef PG8_SCHED
}
}

constexpr int NWAVES = 8;
constexpr int D = 2048, BATCH = 8, SEQ = 4096, M = BATCH * SEQ, FF = 5632;
constexpr int N_IN0 = 4632, N_IN1 = 4624, N_INP = 4640, N_MAIN = 4608;
constexpr float RMS_EPS = 1e-6f;
constexpr int NPHASE = 18;

constexpr size_t MiB = 1u << 20;
constexpr size_t WS_CTL = 0, CTL_ZERO_BYTES = 1 * MiB;
constexpr size_t WS_TAB = 1 * MiB;
constexpr size_t WS_WIN0 = 8 * MiB, WS_WOUT0 = 27 * MiB, WS_W13_0 = 35 * MiB, WS_W2_0 = 79 * MiB;
constexpr size_t WS_WIN1 = 101 * MiB, WS_WOUT1 = 120 * MiB, WS_W13_1 = 128 * MiB, WS_W2_1 = 172 * MiB, WS_GLUW = 194 * MiB;
constexpr size_t WS_A = 200 * MiB;
constexpr size_t WS_B = 360 * MiB;
constexpr size_t WS_U = WS_B, WS_Z = WS_B + 32 * MiB, WS_XBC = WS_B + 128 * MiB, WS_DT = WS_B + 288 * MiB, WS_YPRE = WS_B + 292 * MiB, WS_YSSD = WS_XBC;
constexpr size_t WS_Q = WS_B, WS_K = WS_B + 64 * MiB, WS_V = WS_B + 80 * MiB, WS_QD = WS_B + 96 * MiB, WS_KD = WS_B + 128 * MiB, WS_VD = WS_B + 160 * MiB,
                 WS_GOUT = WS_B + 224 * MiB, WS_GLR = WS_B + 288 * MiB, WS_GLAO = WS_B + 292 * MiB;
constexpr size_t WS_QT = 328 * MiB;
constexpr size_t WS_KTT = WS_B + 356 * MiB, WS_ATT = WS_B + 388 * MiB, WS_DEC = WS_B + 404 * MiB;
constexpr size_t WS_H = WS_B;
constexpr size_t WS_HB = 768 * MiB;
constexpr size_t WS_HB5 = 896 * MiB;
constexpr size_t WS_END = (XMANT < 7 ? 1024 : 896) * MiB;
constexpr int CW_BAR = 4096;
constexpr size_t WS_SS = 131072;
constexpr size_t WS_SS0 = 8 * MiB - 262144;
constexpr size_t TAB_TOEP = 0, TAB_QM = 4 * MiB, TAB_ABARD = 6 * MiB, TAB_BTD = 6 * MiB + 65536, TAB_A16 = 6 * MiB + 65536 + 524288;
constexpr size_t WS_PM = 195 * MiB;
constexpr size_t WS_POW = 198 * MiB;

constexpr int RING_OFF = 0, RING_BYTES = 131072;
constexpr int LDS_BYTES = 147456;
constexpr int MISC_OFF = LDS_BYTES - 1024;
constexpr int PT_OFF = MISC_OFF + 512;

#define GAS __attribute__((address_space(1)))
#define LAS __attribute__((address_space(3)))
typedef unsigned short bf16;
typedef unsigned v4u __attribute__((ext_vector_type(4)));
typedef unsigned v2u __attribute__((ext_vector_type(2)));
typedef float f32x4 __attribute__((ext_vector_type(4)));
typedef float f32x2 __attribute__((ext_vector_type(2)));
typedef GAS unsigned gu32;
#define RLX_AGENT __ATOMIC_RELAXED, __HIP_MEMORY_SCOPE_AGENT
#define LDS_WAIT() asm volatile("s_waitcnt lgkmcnt(0)" ::: "memory")
#define VM_WAIT() asm volatile("s_waitcnt vmcnt(0)" ::: "memory")
#define DI __device__ __forceinline__
#define BAR_LDS() do { asm volatile("s_waitcnt lgkmcnt(0)" ::: "memory"); __builtin_amdgcn_s_barrier(); asm volatile("" ::: "memory"); } while (0)
DI unsigned f2bf(float f) { unsigned u = __builtin_bit_cast(unsigned, f); return (u + 0x7fffu + ((u >> 16) & 1u)) >> 16; }
DI unsigned pk2(float lo, float hi) { return f2bf(lo) | (f2bf(hi) << 16); }
typedef __bf16 bf16x2_t __attribute__((ext_vector_type(2)));
DI unsigned cvtpk(float lo, float hi) { const f32x2 v = {lo, hi}; const bf16x2_t b = __builtin_convertvector(v, bf16x2_t); return __builtin_bit_cast(unsigned, b); }
DI float bflo(unsigned w) { return __uint_as_float(w << 16); }
DI float bfhi(unsigned w) { return __uint_as_float(w & 0xffff0000u); }
DI float bf2f(bf16 b) { return __uint_as_float((unsigned)b << 16); }
DI float wave_sum(float v) {
#pragma unroll
    for (int o = 1; o < 64; o <<= 1) v += __shfl_xor(v, o);
    return v;
}
DI float wave_max(float v) {
#pragma unroll
    for (int o = 1; o < 64; o <<= 1) v = fmaxf(v, __shfl_xor(v, o));
    return v;
}
DI float silu_f(float x) { return x * __builtin_amdgcn_rcpf(1.0f + __expf(-x)); }
DI float gelu_tanh_f(float x) { const float z = 0.7978845608028654f * (x + 0.044715f * x * x * x); const float t = 1.0f - 2.0f * __builtin_amdgcn_rcpf(__expf(2.0f * z) + 1.0f); return 0.5f * x * (1.0f + t); }
DI float softplus_f(float x) { const float e = __expf(-fabsf(x)); const float l = e < 0.01f ? e * (1.0f - e * (0.5f - e * 0.33333333f)) : __logf(1.0f + e); return fmaxf(x, 0.f) + l; }

typedef short v4i16_t __attribute__((ext_vector_type(4)));
DI v2u tr16(const LAS bf16* p) { return __builtin_bit_cast(v2u, __builtin_amdgcn_ds_read_tr16_b64_v4i16((LAS v4i16_t*)p)); }
struct InTab { const LAS unsigned long long* t;
    DI const float* operator[](int i) const { const unsigned long long v = t[i];
        const unsigned lo = __builtin_amdgcn_readfirstlane((unsigned)v), hi = __builtin_amdgcn_readfirstlane((unsigned)(v >> 32));
        return (const float*)(const GAS float*)(((unsigned long long)hi << 32) | lo); } };
#define XB_TMO      128
#define XB_XCNT(j)  (256  + 64 * (j))
#define XB_XSUB(j)  (1280 + 64 * (j))
#define XB_XGEN(j)  (2304 + 64 * (j))
#define XB_TOP      3328
#define XB_TOPGEN   3392
#define XCD_BAR_WORDS 3456
#define XB_SPIN_CAP (1u << 18)

__device__ __forceinline__ unsigned xb_ld(unsigned* p)              { return __hip_atomic_load(p, __ATOMIC_RELAXED, __HIP_MEMORY_SCOPE_AGENT); }
__device__ __forceinline__ unsigned xb_add(unsigned* p, unsigned v) { return __hip_atomic_fetch_add(p, v, __ATOMIC_RELAXED, __HIP_MEMORY_SCOPE_AGENT); }
__device__ __forceinline__ unsigned xb_xcc_id() { return (unsigned)__builtin_amdgcn_s_getreg((3 << 11) | 20) & 0xFu; }
#define XB_SPIN(cond, bar) do { unsigned _sp = 0; while (cond) { __builtin_amdgcn_s_sleep(1); \
    if ((++_sp & 255u) == 0u) { if (xb_ld(&(bar)[XB_TMO])) break; if (_sp > XB_SPIN_CAP) { atomicAdd(&(bar)[XB_TMO], 1u); break; } } } } while (0)

struct XcdBarrier {
    unsigned* bar; unsigned x;
    volatile LAS unsigned* st;
};

__device__ __forceinline__ XcdBarrier xcd_barrier_post(unsigned* bar, volatile LAS unsigned* st) {
    XcdBarrier b; b.bar = bar; b.x = xb_xcc_id(); b.st = st;
    if (threadIdx.x == 0) (void)xb_add(&bar[XB_XCNT(b.x)], 1u);
    return b;
}
__device__ __forceinline__ void xcd_barrier_complete(unsigned* bar, unsigned x, unsigned& nloc, unsigned& nx) {
    const unsigned G = gridDim.x * gridDim.y * gridDim.z;
    unsigned sum, cnt, mine, sp = 0u;
    for (;;) {
        sum = 0u; cnt = 0u; mine = 0u;
#pragma unroll
        for (unsigned j = 0; j < 16; ++j) { const unsigned c = xb_ld(&bar[XB_XCNT(j)]); sum += c; cnt += (c > 0u) ? 1u : 0u; mine = (j == x) ? c : mine; }
        if (sum == G) break;
        __builtin_amdgcn_s_sleep(1);
        if ((++sp & 255u) == 0u) { if (xb_ld(&bar[XB_TMO])) break; if (sp > XB_SPIN_CAP) { atomicAdd(&bar[XB_TMO], 1u); break; } }
    }
    nloc = mine > 0u ? mine : 1u; nx = cnt > 0u ? cnt : 1u;
}

__device__ __forceinline__ void xcd_barrier(const XcdBarrier& b) {
    asm volatile("s_waitcnt vmcnt(0)" ::: "memory");
    __syncthreads();
    if (threadIdx.x == 0) {
        unsigned* bar = b.bar;
        __builtin_amdgcn_s_waitcnt(0);
        unsigned nloc = b.st[0], nx = b.st[1];
        if (nloc == 0u) { xcd_barrier_complete(bar, b.x, nloc, nx); b.st[0] = nloc; b.st[1] = nx; }
        const unsigned old = xb_add(&bar[XB_XSUB(b.x)], 1u);
        const unsigned gen = old / nloc;
        if (old + 1u == (gen + 1u) * nloc) {
            __builtin_amdgcn_fence(__ATOMIC_RELEASE, "agent");
            asm volatile("s_waitcnt vmcnt(0)" ::: "memory");
            const unsigned og = xb_add(&bar[XB_TOP], 1u);
            const unsigned tg = og / nx;
            if (og + 1u == (tg + 1u) * nx) xb_add(&bar[XB_TOPGEN], 1u);
            else XB_SPIN(xb_ld(&bar[XB_TOPGEN]) == tg, bar);
            __builtin_amdgcn_fence(__ATOMIC_ACQUIRE, "agent");
            xb_add(&bar[XB_XGEN(b.x)], 1u);
            asm volatile("s_waitcnt vmcnt(0)" ::: "memory");
        } else {
            XB_SPIN(xb_ld(&bar[XB_XGEN(b.x)]) == gen, bar);
            __builtin_amdgcn_fence(__ATOMIC_ACQUIRE, "agent");
            asm volatile("s_waitcnt vmcnt(0)" ::: "memory");
        }
    }
    __syncthreads();
}

template <int MB> DI unsigned f2bfm(float f) { constexpr int sh = 16 + (7 - MB); unsigned u = __builtin_bit_cast(unsigned, f); u = (u + ((1u << (sh - 1)) - 1u) + ((u >> sh) & 1u)) & ~((1u << sh) - 1u); return u >> 16; }
template <int MB> DI unsigned pk2m(float lo, float hi) { return f2bfm<MB>(lo) | (f2bfm<MB>(hi) << 16); }
template <int MB = 7> DI void transpose_item(const float* W, int K, int N, bf16* WT, int mode, LAS float* scr, int item, int nblk, int lane, const float* gain = nullptr) {
    const int kb = item / nblk, nb = item % nblk, k0 = 64 * kb, n0 = 32 * nb;
    const int nn = n0 + (lane & 31); const bool ok = nn < N;
    float wv[32];
#pragma unroll
    for (int i = 0; i < 32; ++i) { const int kk = 2 * i + (lane >> 5); wv[i] = ok ? W[(size_t)(k0 + kk) * N + nn] : 0.f; }
    if (gain) {
#pragma unroll
        for (int i = 0; i < 32; ++i) wv[i] *= gain[k0 + 2 * i + (lane >> 5)]; }
#pragma unroll
    for (int i = 0; i < 32; ++i) scr[(2 * i + (lane >> 5)) * 33 + (lane & 31)] = wv[i];
    LDS_WAIT(); asm volatile("" ::: "memory");
    const int c = lane & 7;
    const int drow0 = (mode == 0) ? n0 : (256 * (n0 >> 7) + (n0 & 127) + (mode == 2 ? 128 : 0));
#pragma unroll
    for (int j = 0; j < 4; ++j) { const int n = (lane >> 3) + 8 * j; const LAS float* s = scr + (8 * c) * 33 + n;
        v4u o; o.x = pk2m<MB>(s[0 * 33], s[1 * 33]); o.y = pk2m<MB>(s[2 * 33], s[3 * 33]); o.z = pk2m<MB>(s[4 * 33], s[5 * 33]); o.w = pk2m<MB>(s[6 * 33], s[7 * 33]);
        *(v4u*)(WT + (size_t)(drow0 + n) * K + k0 + 8 * c) = o; }
    LDS_WAIT(); asm volatile("" ::: "memory");
}
DI void prologue(const InTab in, unsigned char* ws, LAS unsigned char* lds, int gw, int NGW, int lane, int wave) {
    LAS float* scr = (LAS float*)(lds + RING_OFF + wave * 16384);
    constexpr int I_IN = (D / 64) * (N_INP / 32), I_OUT = (D / 64) * (D / 32), I_W1 = (D / 64) * (FF / 32), I_W2 = (FF / 64) * (D / 32), I_GLU = (512 / 64) * (512 / 32);
    constexpr int I_LAYER = I_IN + I_OUT + 2 * I_W1 + I_W2;
    constexpr int NITEMS = 2 * I_LAYER + I_GLU;
    for (int it = gw; it < NITEMS; it += NGW) {
        int r = it;
        if (r >= 2 * I_LAYER) { r -= 2 * I_LAYER; transpose_item(in[11], 512, 512, (bf16*)(ws + WS_GLUW), 0, scr, r, 512 / 32, lane); continue; }
        const int layer = r >= I_LAYER; if (layer) r -= I_LAYER;
        const float* win = layer ? in[25] : in[2]; const float* wout = layer ? in[32] : in[19];
        const float* w1 = layer ? in[34] : in[21]; const float* w3 = layer ? in[35] : in[22]; const float* w2 = layer ? in[36] : in[23];
        const float* gmix = layer ? in[24] : in[1]; const float* gffn = layer ? in[33] : in[20];
        bf16* WIN = (bf16*)(ws + (layer ? WS_WIN1 : WS_WIN0)); bf16* WOUT = (bf16*)(ws + (layer ? WS_WOUT1 : WS_WOUT0));
        bf16* W13 = (bf16*)(ws + (layer ? WS_W13_1 : WS_W13_0)); bf16* W2 = (bf16*)(ws + (layer ? WS_W2_1 : WS_W2_0));
        if (r < I_IN) { transpose_item<WM_IN>(win, D, layer ? N_IN1 : N_IN0, WIN, 0, scr, r, N_INP / 32, lane, gmix); continue; } r -= I_IN;
        if (r < I_OUT) { transpose_item<WM_OUT>(wout, D, D, WOUT, 0, scr, r, D / 32, lane); continue; } r -= I_OUT;
        if (r < I_W1) { transpose_item<WM_FFN>(w1, D, FF, W13, 1, scr, r, FF / 32, lane, gffn); continue; } r -= I_W1;
        if (r < I_W1) { transpose_item<WM_FFN>(w3, D, FF, W13, 2, scr, r, FF / 32, lane, gffn); continue; } r -= I_W1;
        transpose_item<WM_FFN>(w2, FF, D, W2, 0, scr, r, D / 32, lane);
    }
}
DI void s5_tables(const InTab in, unsigned char* ws, int gt) {
    if (gt >= 32 * 64) return;
    const int g = gt >> 6;
    const double are = (double)in[3][gt], aim = (double)in[4][gt], dt = exp((double)in[5][g]);
    const double mag = exp(are * dt), abr = mag * cos(aim * dt), abi = mag * sin(aim * dt);
    const double er = abr - 1.0, ei = abi, den = are * are + aim * aim;
    const double cr = (er * are + ei * aim) / den, ci = (ei * are - er * aim) / den;
    double* ABARD = (double*)(ws + WS_TAB + TAB_ABARD); double* BTD = (double*)(ws + WS_TAB + TAB_BTD); float* A16 = (float*)(ws + WS_TAB + TAB_A16);
    ABARD[gt * 2] = abr; ABARD[gt * 2 + 1] = abi;
    { double* POW = (double*)(ws + WS_POW) + (size_t)gt * 34; double qr = 1.0, qi = 0.0; POW[0] = 1.0; POW[1] = 0.0;
      for (int p = 1; p <= 16; ++p) { const double nr = qr * abr - qi * abi, ni = qr * abi + qi * abr; qr = nr; qi = ni; POW[2 * p] = qr; POW[2 * p + 1] = qi; } }
    double pr = abr, pi = abi;
#pragma unroll
    for (int i = 0; i < 4; ++i) { const double nr = pr * pr - pi * pi, ni = 2.0 * pr * pi; pr = nr; pi = ni; }
    A16[gt * 2] = (float)pr; A16[gt * 2 + 1] = (float)pi;
    for (int c = 0; c < 16; ++c) { const double br = (double)in[6][gt * 16 + c], bi = (double)in[7][gt * 16 + c];
        BTD[(gt * 16 + c) * 2] = cr * br - ci * bi; BTD[(gt * 16 + c) * 2 + 1] = cr * bi + ci * br; }
}
DI void cpow(double ar, double ai, int p, double& pr, double& pi) { pr = 1.0; pi = 0.0; for (int i = 0; i < p; ++i) { const double nr = pr * ar - pi * ai, ni = pr * ai + pi * ar; pr = nr; pi = ni; } }
DI void s5_tables2(const InTab in, unsigned char* ws, LAS unsigned char* lds, int bx, int G, int tid) {
    bf16* TOEP = (bf16*)(ws + WS_TAB + TAB_TOEP); bf16* QM = (bf16*)(ws + WS_TAB + TAB_QM); bf16* PM = (bf16*)(ws + WS_PM);
    LAS double* POW = (LAS double*)(lds + RING_OFF);
    LAS double* BTD = POW + 64 * 34;
    LAS float* Crl = (LAS float*)(BTD + 64 * 32);
    LAS float* Cil = Crl + 16 * 64;
    for (int gi = bx; gi < 32 * 8; gi += G) {
        const int g = gi >> 3, idx = (gi & 7) * 512 + tid;
        __syncthreads();
        { const v4u* s0 = (const v4u*)((const double*)(ws + WS_POW) + (size_t)g * 64 * 34); LAS v4u* d0 = (LAS v4u*)POW;
          for (int k = tid; k < 64 * 34 * 8 / 16; k += 512) d0[k] = s0[k];
          const v4u* s1 = (const v4u*)((const double*)(ws + WS_TAB + TAB_BTD) + (size_t)g * 64 * 32); LAS v4u* d1 = (LAS v4u*)BTD;
          for (int k = tid; k < 64 * 32 * 8 / 16; k += 512) d1[k] = s1[k];
          if (tid < 256) ((LAS v4u*)Crl)[tid] = ((const v4u*)(in[8] + (size_t)g * 16 * 64))[tid];
          else ((LAS v4u*)Cil)[tid - 256] = ((const v4u*)(in[9] + (size_t)g * 16 * 64))[tid - 256]; }
        __syncthreads();
        {   const int d = idx >> 8, cp = (idx >> 4) & 15, c = idx & 15;
            double sum = 0.0;
            for (int n = 0; n < 64; ++n) { const double pr = POW[n * 34 + 2 * d], pi = POW[n * 34 + 2 * d + 1];
                const double br = BTD[(n * 16 + c) * 2], bi = BTD[(n * 16 + c) * 2 + 1], xr = pr * br - pi * bi, xi = pr * bi + pi * br;
                sum += (double)Crl[cp * 64 + n] * xr - (double)Cil[cp * 64 + n] * xi; }
            if (d == 0 && cp == c) sum += (double)in[10][g * 16 + c];
            const bf16 v = (bf16)f2bf((float)sum);
            for (int s = 0; s + d < 16; ++s) { const int j = s + d;
                TOEP[((size_t)(g * 256 + 16 * j + cp)) * 256 + 16 * s + c] = v;
                if (d > 0) TOEP[((size_t)(g * 256 + 16 * s + cp)) * 256 + 16 * j + c] = (bf16)0; } }
        {   const int np = (idx >> 5) & 127, s = (idx >> 1) & 15, half = idx & 1, n = np & 63;
            const double pr = POW[n * 34 + 2 * (15 - s)], pi = POW[n * 34 + 2 * (15 - s) + 1];
            float v[8];
#pragma unroll
            for (int e = 0; e < 8; ++e) { const int c = half * 8 + e; const double br = BTD[(n * 16 + c) * 2], bi = BTD[(n * 16 + c) * 2 + 1];
                v[e] = (float)((np < 64) ? (pr * br - pi * bi) : (pr * bi + pi * br)); }
            v4u o; o.x = pk2(v[0], v[1]); o.y = pk2(v[2], v[3]); o.z = pk2(v[4], v[5]); o.w = pk2(v[6], v[7]);
            *(v4u*)(QM + ((size_t)(g * 128 + np)) * 256 + 16 * s + 8 * half) = o; }
        {   const int j = idx >> 8, cp = (idx >> 4) & 15, o8 = idx & 15;
            float v[8];
#pragma unroll
            for (int e = 0; e < 8; ++e) { const int kp = o8 * 8 + e, n = kp & 63; const double pr = POW[n * 34 + 2 * (j + 1)], pi = POW[n * 34 + 2 * (j + 1) + 1];
                const double cr = (double)Crl[cp * 64 + n], ci = (double)Cil[cp * 64 + n];
                v[e] = (float)((kp < 64) ? (cr * pr - ci * pi) : -(cr * pi + ci * pr)); }
            v4u o; o.x = pk2(v[0], v[1]); o.y = pk2(v[2], v[3]); o.z = pk2(v[4], v[5]); o.w = pk2(v[6], v[7]);
            *(v4u*)(PM + ((size_t)(g * 256 + 16 * j + cp)) * 128 + o8 * 8) = o; }
    }
}
DI void x_to_hb_phase(const float* x, bf16* HB, pg8::ssq_t* ss, int gw, int NGW, int lane) {
    for (int m = gw; m < M; m += NGW) {
        const f32x4* xr = (const f32x4*)(x + (size_t)m * D) + lane;
        f32x4 v[8]; float s = 0.f;
#pragma unroll
        for (int j = 0; j < 8; ++j) { v[j] = xr[64 * j]; s += (v[j].x * v[j].x + v[j].y * v[j].y) + (v[j].z * v[j].z + v[j].w * v[j].w); }
        s = wave_sum(s);
        v2u* o8 = (v2u*)(HB + (size_t)m * D) + lane;
#pragma unroll
        for (int j = 0; j < 8; ++j) { v2u w; w.x = cvtpk(pg8::rnd_am(v[j].x), pg8::rnd_am(v[j].y)); w.y = cvtpk(pg8::rnd_am(v[j].z), pg8::rnd_am(v[j].w)); o8[64 * j] = w; }
        if (lane == 0) ss[m] = pg8::ssq_from_f(s);
    }
}

DI void s5_fast(const InTab in, unsigned char* ws, LAS unsigned char* lds, int u0, int u1, int ustep, int tid, int lane, int wave) {
    typedef short bf16x8 __attribute__((ext_vector_type(8)));
    const bf16* U = (const bf16*)(ws + WS_U); bf16* YPRE = (bf16*)(ws + WS_YPRE);
    const bf16* TOEP = (const bf16*)(ws + WS_TAB + TAB_TOEP); const bf16* QM = (const bf16*)(ws + WS_TAB + TAB_QM); const bf16* PM = (const bf16*)(ws + WS_PM);
    const float* A16 = (const float*)(ws + WS_TAB + TAB_A16);
    LAS float* Sf = (LAS float*)(lds + RING_OFF);
    const int fr = lane & 15, fq = lane >> 4;
    for (int unit = u0; unit < u1; unit += ustep) {
        const int b = unit >> 5, g = unit & 31;
        const bf16* Ub = U + (size_t)b * SEQ * 512 + g * 16;
        bf16x8 af[2][8];
#pragma unroll
        for (int rb = 0; rb < 2; ++rb)
#pragma unroll
            for (int ks = 0; ks < 8; ++ks) { const int token = (32 * wave + 16 * rb + fr) * 16 + 2 * ks + (fq >> 1);
                af[rb][ks] = *(const bf16x8*)(Ub + (size_t)token * 512 + 8 * (fq & 1)); }
        __syncthreads();
        {
            bf16x8 bq[2][8];
#pragma unroll
            for (int ks = 0; ks < 8; ++ks) bq[0][ks] = *(const bf16x8*)(QM + ((size_t)(g * 128 + fr)) * 256 + 32 * ks + 8 * fq);
#pragma unroll
            for (int nb = 0; nb < 8; ++nb) {
                if (nb + 1 < 8) {
#pragma unroll
                    for (int ks = 0; ks < 8; ++ks) bq[(nb + 1) & 1][ks] = *(const bf16x8*)(QM + ((size_t)(g * 128 + 16 * (nb + 1) + fr)) * 256 + 32 * ks + 8 * fq); }
                f32x4 a0 = {0.f, 0.f, 0.f, 0.f}, a1 = {0.f, 0.f, 0.f, 0.f};
#pragma unroll
                for (int ks = 0; ks < 8; ++ks) { a0 = __builtin_amdgcn_mfma_f32_16x16x32_bf16(af[0][ks], bq[nb & 1][ks], a0, 0, 0, 0); a1 = __builtin_amdgcn_mfma_f32_16x16x32_bf16(af[1][ks], bq[nb & 1][ks], a1, 0, 0, 0); }
#pragma unroll
                for (int e = 0; e < 4; ++e) { Sf[(32 * wave + 4 * fq + e) * 132 + 16 * nb + fr] = a0[e]; Sf[(32 * wave + 16 + 4 * fq + e) * 132 + 16 * nb + fr] = a1[e]; }
            }
        }
        __syncthreads();
        if (wave == 0) {
            const float ar = A16[(g * 64 + lane) * 2], ai = A16[(g * 64 + lane) * 2 + 1];
            float hr = 0.f, hi = 0.f;
            for (int c0 = 0; c0 < 256; c0 += 16) {
                float sr[16], si[16];
#pragma unroll
                for (int i = 0; i < 16; ++i) { sr[i] = Sf[(c0 + i) * 132 + lane]; si[i] = Sf[(c0 + i) * 132 + 64 + lane]; }
#pragma unroll
                for (int i = 0; i < 16; ++i) { Sf[(c0 + i) * 132 + lane] = hr; Sf[(c0 + i) * 132 + 64 + lane] = hi;
                    const float nhr = ar * hr - ai * hi + sr[i], nhi = ar * hi + ai * hr + si[i]; hr = nhr; hi = nhi; }
            }
        }
        __syncthreads();
        bf16x8 hf[2][4];
#pragma unroll
        for (int rb = 0; rb < 2; ++rb)
#pragma unroll
            for (int ks = 0; ks < 4; ++ks) { const LAS f32x4* hp = (const LAS f32x4*)(Sf + (32 * wave + 16 * rb + fr) * 132 + 32 * ks + 8 * fq); const f32x4 h0 = hp[0], h1 = hp[1];
                v4u w; w.x = cvtpk(h0[0], h0[1]); w.y = cvtpk(h0[2], h0[3]); w.z = cvtpk(h1[0], h1[1]); w.w = cvtpk(h1[2], h1[3]);
                hf[rb][ks] = __builtin_bit_cast(bf16x8, w); }
        {
            bf16x8 bt[2][8], bp[2][4];
            bt[0][0] = *(const bf16x8*)(TOEP + ((size_t)(g * 256 + fr)) * 256 + 8 * fq);
#pragma unroll
            for (int ks = 0; ks < 4; ++ks) bp[0][ks] = *(const bf16x8*)(PM + ((size_t)(g * 256 + fr)) * 128 + 32 * ks + 8 * fq);
#pragma unroll
            for (int nb = 0; nb < 16; ++nb) {
                if (nb + 1 < 16) {
#pragma unroll
                    for (int ks = 0; ks < 8; ++ks) if (2 * ks <= nb + 1) bt[(nb + 1) & 1][ks] = *(const bf16x8*)(TOEP + ((size_t)(g * 256 + 16 * (nb + 1) + fr)) * 256 + 32 * ks + 8 * fq);
#pragma unroll
                    for (int ks = 0; ks < 4; ++ks) bp[(nb + 1) & 1][ks] = *(const bf16x8*)(PM + ((size_t)(g * 256 + 16 * (nb + 1) + fr)) * 128 + 32 * ks + 8 * fq); }
                f32x4 a0 = {0.f, 0.f, 0.f, 0.f}, a1 = {0.f, 0.f, 0.f, 0.f};
#pragma unroll
                for (int ks = 0; ks < 8; ++ks) if (2 * ks <= nb) { a0 = __builtin_amdgcn_mfma_f32_16x16x32_bf16(af[0][ks], bt[nb & 1][ks], a0, 0, 0, 0); a1 = __builtin_amdgcn_mfma_f32_16x16x32_bf16(af[1][ks], bt[nb & 1][ks], a1, 0, 0, 0); }
#pragma unroll
                for (int ks = 0; ks < 4; ++ks) { a0 = __builtin_amdgcn_mfma_f32_16x16x32_bf16(hf[0][ks], bp[nb & 1][ks], a0, 0, 0, 0); a1 = __builtin_amdgcn_mfma_f32_16x16x32_bf16(hf[1][ks], bp[nb & 1][ks], a1, 0, 0, 0); }
#pragma unroll
                for (int e = 0; e < 4; ++e) {
                    const size_t t0 = (size_t)b * SEQ + (size_t)(32 * wave + 4 * fq + e) * 16 + nb, t1 = t0 + 256;
                    YPRE[t0 * 512 + g * 16 + fr] = (bf16)f2bf(gelu_tanh_f(a0[e]));
                    YPRE[t1 * 512 + g * 16 + fr] = (bf16)f2bf(gelu_tanh_f(a1[e])); }
            }
        }
    }
}
DI void conv_phase(const InTab in, unsigned char* ws, int gt, int NGT) {
    const bf16* XBC = (const bf16*)(ws + WS_XBC); bf16* XC = (bf16*)(ws + WS_A);
    const float* cw = in[13]; const float* cb = in[14];
    for (int i = gt; i < (M / 8) * 320; i += NGT) {
        const int tb = i / 320, c8 = (i % 320) * 8, t0 = tb * 8, ts0 = t0 & (SEQ - 1);
        v4u r[11];
#pragma unroll
        for (int k = 0; k < 11; ++k) { r[k] = (v4u){0u, 0u, 0u, 0u}; if (ts0 - 3 + k >= 0) r[k] = *(const v4u*)(XBC + (size_t)(t0 - 3 + k) * 2560 + c8); }
        float w[4][8], bs[8];
#pragma unroll
        for (int k = 0; k < 4; ++k) { const f32x4 w0 = *(const f32x4*)(cw + k * 2560 + c8), w1 = *(const f32x4*)(cw + k * 2560 + c8 + 4);
            w[k][0] = w0.x; w[k][1] = w0.y; w[k][2] = w0.z; w[k][3] = w0.w; w[k][4] = w1.x; w[k][5] = w1.y; w[k][6] = w1.z; w[k][7] = w1.w; }
        { const f32x4 b0 = *(const f32x4*)(cb + c8), b1 = *(const f32x4*)(cb + c8 + 4); bs[0] = b0.x; bs[1] = b0.y; bs[2] = b0.z; bs[3] = b0.w; bs[4] = b1.x; bs[5] = b1.y; bs[6] = b1.z; bs[7] = b1.w; }
        float x[11][8];
#pragma unroll
        for (int k = 0; k < 11; ++k) { x[k][0] = bflo(r[k].x); x[k][1] = bfhi(r[k].x); x[k][2] = bflo(r[k].y); x[k][3] = bfhi(r[k].y); x[k][4] = bflo(r[k].z); x[k][5] = bfhi(r[k].z); x[k][6] = bflo(r[k].w); x[k][7] = bfhi(r[k].w); }
#pragma unroll
        for (int j = 0; j < 8; ++j) { float acc[8];
#pragma unroll
            for (int e = 0; e < 8; ++e) acc[e] = bs[e] + w[0][e] * x[j][e] + w[1][e] * x[j + 1][e] + w[2][e] * x[j + 2][e] + w[3][e] * x[j + 3][e];
            v4u o; o.x = cvtpk(silu_f(acc[0]), silu_f(acc[1])); o.y = cvtpk(silu_f(acc[2]), silu_f(acc[3])); o.z = cvtpk(silu_f(acc[4]), silu_f(acc[5])); o.w = cvtpk(silu_f(acc[6]), silu_f(acc[7]));
            *(v4u*)(XC + (size_t)(t0 + j) * 2560 + c8) = o; }
    }
}
DI void ssd_fast(const InTab in, unsigned char* ws, LAS unsigned char* lds, int bx, int G, int tid, int lane, int wave) {
    typedef short bf16x8 __attribute__((ext_vector_type(8)));
    const bf16* XC = (const bf16*)(ws + WS_A); const float* DT = (const float*)(ws + WS_DT); const bf16* Z = (const bf16*)(ws + WS_Z); bf16* YS = (bf16*)(ws + WS_YSSD);
    constexpr int SET = 64 * 136 * 2 + 64 * 72 * 2 + 256;
    LAS bf16* T0 = (LAS bf16*)(lds + RING_OFF);
    LAS bf16* Sl = T0 + 2 * SET;
    const int fr = lane & 15, fq = lane >> 4, lb = wave & 3, ph = wave >> 2, tq = fr >> 2, tp = fr & 3;
    const float LOG2E = 1.4426950408889634f;
    for (int unit = bx; unit < BATCH * 24; unit += G) {
        const int b = unit / 24, h = unit % 24, grp = h / 6;
        const float A = -__expf(in[16][h]), Dh = in[17][h], dtb = in[15][h];
        f32x4 st[4];
#pragma unroll
        for (int i = 0; i < 4; ++i) st[i] = (f32x4){0.f, 0.f, 0.f, 0.f};
        __syncthreads();
        for (int i = tid; i < 64 * 136 / 2; i += 512) ((LAS unsigned*)Sl)[i] = 0u;
        v4u rB[2], rC[2], rX; float rdt;
#define SSD_FETCH(chunk) do { const size_t r0_ = (size_t)b * SEQ + (size_t)(chunk) * 64; \
            _Pragma("unroll") for (int i = 0; i < 2; ++i) { const int pc = tid + 512 * i, s = pc >> 4, n0 = (pc & 15) * 8; \
                rB[i] = *(const v4u*)(XC + (r0_ + s) * 2560 + 1536 + grp * 128 + n0); rC[i] = *(const v4u*)(XC + (r0_ + s) * 2560 + 2048 + grp * 128 + n0); } \
            rX = *(const v4u*)(XC + (r0_ + (tid >> 3)) * 2560 + h * 64 + (tid & 7) * 8); \
            rdt = DT[(r0_ + lane) * 32 + h]; } while (0)
#define SSD_STAGE(set) do { LAS bf16* Bl_ = T0 + (set) * SET; LAS bf16* Cl_ = Bl_ + 64 * 136; LAS bf16* Xl_ = Cl_ + 64 * 136; LAS bf16* Xw_ = Xl_ + 64 * 72; LAS float* cs_ = (LAS float*)(Xw_ + 64 * 72); \
            const float dt = softplus_f(rdt + dtb); float cs = dt * A; \
            _Pragma("unroll") for (int off = 1; off < 64; off <<= 1) { const float t = __shfl_up(cs, off); if (lane >= off) cs += t; } \
            const float cs_last = __shfl(cs, 63); const float wgt = __expf(cs_last - cs) * dt; \
            if (wave == 0) { cs_[lane] = cs; cs_[64 + lane] = dt; } \
            _Pragma("unroll") for (int i = 0; i < 2; ++i) { const int pc = tid + 512 * i, s = pc >> 4, n0 = (pc & 15) * 8; \
                *(LAS v4u*)(Bl_ + s * 136 + n0) = rB[i]; *(LAS v4u*)(Cl_ + s * 136 + n0) = rC[i]; } \
            { const int l = tid >> 3, p0 = (tid & 7) * 8; const float wl = __shfl(wgt, l); \
              *(LAS v4u*)(Xl_ + l * 72 + p0) = rX; \
              v4u xs; xs.x = cvtpk(bflo(rX.x) * wl, bfhi(rX.x) * wl); xs.y = cvtpk(bflo(rX.y) * wl, bfhi(rX.y) * wl); xs.z = cvtpk(bflo(rX.z) * wl, bfhi(rX.z) * wl); xs.w = cvtpk(bflo(rX.w) * wl, bfhi(rX.w) * wl); \
              *(LAS v4u*)(Xw_ + l * 72 + p0) = xs; } } while (0)
        SSD_FETCH(0); SSD_STAGE(0); SSD_FETCH(1);
        __syncthreads();
        for (int ch = 0; ch < SEQ / 64; ++ch) {
            const size_t row0 = (size_t)b * SEQ + ch * 64;
            const LAS bf16* Bl = T0 + (ch & 1) * SET; const LAS bf16* Cl = Bl + 64 * 136; const LAS bf16* Xl = Cl + 64 * 136; const LAS bf16* Xw = Xl + 64 * 72; const LAS float* csl = (const LAS float*)(Xw + 64 * 72);
            const LAS bf16* Scur = Sl + (ch & 1) * (64 * 136); LAS bf16* Snxt = Sl + ((ch + 1) & 1) * (64 * 136);
            const size_t row = row0 + 16 * lb + fr;
            v2u zw[2];
#pragma unroll
            for (int pi = 0; pi < 2; ++pi) zw[pi] = *(const v2u*)(Z + row * 1536 + h * 64 + 16 * (2 * ph + pi) + 4 * fq);
            bf16x8 cf[4];
#pragma unroll
            for (int ks = 0; ks < 4; ++ks) cf[ks] = *(const LAS bf16x8*)(Cl + (16 * lb + fr) * 136 + 32 * ks + 8 * fq);
            const float cs_l = csl[16 * lb + fr];
            f32x4 gt[4];
#pragma unroll
            for (int sb = 0; sb < 4; ++sb) { gt[sb] = (f32x4){0.f, 0.f, 0.f, 0.f};
                if (sb <= lb) {
#pragma unroll
                    for (int ks = 0; ks < 4; ++ks) { const bf16x8 a = *(const LAS bf16x8*)(Bl + (16 * sb + fr) * 136 + 32 * ks + 8 * fq);
                        gt[sb] = __builtin_amdgcn_mfma_f32_16x16x32_bf16(a, cf[ks], gt[sb], 0, 0, 0); }
                    const f32x4 css = *(const LAS f32x4*)(csl + 16 * sb + 4 * fq), dts = *(const LAS f32x4*)(csl + 64 + 16 * sb + 4 * fq);
#pragma unroll
                    for (int e = 0; e < 4; ++e) { const int s = 16 * sb + 4 * fq + e, l = 16 * lb + fr;
                        gt[sb][e] = (s <= l) ? gt[sb][e] * __builtin_amdgcn_exp2f((cs_l - css[e]) * LOG2E) * dts[e] : 0.f; }
                } }
            bf16x8 mt[2];
#pragma unroll
            for (int kk = 0; kk < 2; ++kk) { v4u w; w.x = cvtpk(gt[2 * kk][0], gt[2 * kk][1]); w.y = cvtpk(gt[2 * kk][2], gt[2 * kk][3]);
                w.z = cvtpk(gt[2 * kk + 1][0], gt[2 * kk + 1][1]); w.w = cvtpk(gt[2 * kk + 1][2], gt[2 * kk + 1][3]); mt[kk] = __builtin_bit_cast(bf16x8, w); }
            const float el = __builtin_amdgcn_exp2f(cs_l * LOG2E);
#pragma unroll
            for (int pi = 0; pi < 2; ++pi) { const int pb = 2 * ph + pi;
                f32x4 y = {0.f, 0.f, 0.f, 0.f};
#pragma unroll
                for (int ks = 0; ks < 4; ++ks) { const bf16x8 a = *(const LAS bf16x8*)(Scur + (16 * pb + fr) * 136 + 32 * ks + 8 * fq);
                    y = __builtin_amdgcn_mfma_f32_16x16x32_bf16(a, cf[ks], y, 0, 0, 0); }
                y = y * el;
#pragma unroll
                for (int kk = 0; kk < 2; ++kk) if (2 * kk <= lb) {
                    const v2u lo = tr16(Xl + (32 * kk + 4 * fq + tq) * 72 + 16 * pb + 4 * tp), hi = tr16(Xl + (32 * kk + 16 + 4 * fq + tq) * 72 + 16 * pb + 4 * tp);
                    v4u aw; aw.x = lo.x; aw.y = lo.y; aw.z = hi.x; aw.w = hi.y;
                    y = __builtin_amdgcn_mfma_f32_16x16x32_bf16(__builtin_bit_cast(bf16x8, aw), mt[kk], y, 0, 0, 0); }
                const v2u xw = *(const LAS v2u*)(Xl + (16 * lb + fr) * 72 + 16 * pb + 4 * fq);
                const float o0 = (y[0] + Dh * bflo(xw.x)) * pg8::fast_silu(bflo(zw[pi].x)), o1 = (y[1] + Dh * bfhi(xw.x)) * pg8::fast_silu(bfhi(zw[pi].x));
                const float o2 = (y[2] + Dh * bflo(xw.y)) * pg8::fast_silu(bflo(zw[pi].y)), o3 = (y[3] + Dh * bfhi(xw.y)) * pg8::fast_silu(bfhi(zw[pi].y));
                v2u ow; ow.x = cvtpk(o0, o1); ow.y = cvtpk(o2, o3);
                *(v2u*)(YS + row * 1536 + h * 64 + 16 * pb + 4 * fq) = ow;
            }
            const float dec = __builtin_amdgcn_exp2f(csl[63] * LOG2E);
            bf16x8 ba[2];
#pragma unroll
            for (int ks = 0; ks < 2; ++ks) { const v2u lo = tr16(Bl + (32 * ks + 8 * fq + tq) * 136 + 16 * wave + 4 * tp), hi = tr16(Bl + (32 * ks + 8 * fq + 4 + tq) * 136 + 16 * wave + 4 * tp);
                v4u aw; aw.x = lo.x; aw.y = lo.y; aw.z = hi.x; aw.w = hi.y; ba[ks] = __builtin_bit_cast(bf16x8, aw); }
#pragma unroll
            for (int pb = 0; pb < 4; ++pb) { st[pb] = st[pb] * dec;
#pragma unroll
                for (int ks = 0; ks < 2; ++ks) { const v2u lo = tr16(Xw + (32 * ks + 8 * fq + tq) * 72 + 16 * pb + 4 * tp), hi = tr16(Xw + (32 * ks + 8 * fq + 4 + tq) * 72 + 16 * pb + 4 * tp);
                    v4u xv; xv.x = lo.x; xv.y = lo.y; xv.z = hi.x; xv.w = hi.y;
                    st[pb] = __builtin_amdgcn_mfma_f32_16x16x32_bf16(ba[ks], __builtin_bit_cast(bf16x8, xv), st[pb], 0, 0, 0); }
                v2u sw; sw.x = cvtpk(st[pb][0], st[pb][1]); sw.y = cvtpk(st[pb][2], st[pb][3]);
                *(LAS v2u*)(Snxt + (16 * pb + fr) * 136 + 16 * wave + 4 * fq) = sw; }
            if (ch + 1 < SEQ / 64) { SSD_STAGE((ch + 1) & 1); if (ch + 2 < SEQ / 64) SSD_FETCH(ch + 2); }
            BAR_LDS();
        }
#undef SSD_FETCH
#undef SSD_STAGE
    }
}
DI void ssd_finalize(const InTab in, unsigned char* ws, int gw, int NGW, int lane) {
    const bf16* YS = (const bf16*)(ws + WS_YSSD); bf16* Y = (bf16*)(ws + WS_A); const float* nw = in[18];
    for (int m = 2 * gw; m < M; m += 2 * NGW) {
        unsigned w[2][4][3];
#pragma unroll
        for (int r = 0; r < 2; ++r)
#pragma unroll
            for (int grp = 0; grp < 4; ++grp) { const unsigned* src = (const unsigned*)(YS + (size_t)(m + r) * 1536 + grp * 384) + lane * 3; w[r][grp][0] = src[0]; w[r][grp][1] = src[1]; w[r][grp][2] = src[2]; }
#pragma unroll
        for (int r = 0; r < 2; ++r)
#pragma unroll
            for (int grp = 0; grp < 4; ++grp) {
                const float v[6] = {bflo(w[r][grp][0]), bfhi(w[r][grp][0]), bflo(w[r][grp][1]), bfhi(w[r][grp][1]), bflo(w[r][grp][2]), bfhi(w[r][grp][2])};
                float s = 0.f;
#pragma unroll
                for (int j = 0; j < 6; ++j) s += v[j] * v[j];
                const float rstd = __builtin_amdgcn_rsqf(wave_sum(s) * (1.f / 384.f) + RMS_EPS);
                const float* g = nw + grp * 384 + lane * 6;
                unsigned* dst = (unsigned*)(Y + (size_t)(m + r) * D + 512 + grp * 384) + lane * 3;
                dst[0] = cvtpk(v[0] * rstd * g[0], v[1] * rstd * g[1]); dst[1] = cvtpk(v[2] * rstd * g[2], v[3] * rstd * g[3]); dst[2] = cvtpk(v[4] * rstd * g[4], v[5] * rstd * g[5]);
            }
    }
}
DI void swa_fast(const InTab in, unsigned char* ws, LAS unsigned char* lds, int bx, int G, int tid, int lane, int wave) {
    typedef short bf16x8 __attribute__((ext_vector_type(8)));
    const bf16* Q = (const bf16*)(ws + WS_Q); const bf16* Kb = (const bf16*)(ws + WS_K); const bf16* Vb = (const bf16*)(ws + WS_V); bf16* Y = (bf16*)(ws + WS_A);
    LAS bf16* Kl = (LAS bf16*)(lds + RING_OFF);
    LAS bf16* Vl = (LAS bf16*)(lds + RING_OFF + 192 * 144);
    const int fr = lane & 15, fq = lane >> 4, piece = tid & 7, tq = fr >> 2, tp = fr & 3;
    const int hql = wave >> 1, qo = (wave & 1) * 32, kb0 = qo >> 4;
    const float LOG2E = 1.4426950408889634f;
    float wk8[8], wq0[8], wq1[8];
#pragma unroll
    for (int j = 0; j < 8; ++j) { wk8[j] = in[27][piece * 8 + j]; wq0[j] = in[26][fq * 8 + j]; wq1[j] = in[26][32 + fq * 8 + j]; }
    v4u kw[3], vw[3], qw[2][2];
#define SWA_FETCH(u_) do { const int b_ = (u_) >> 8, kvh_ = ((u_) >> 6) & 3, t0_ = ((u_) & 63) * 64; \
        _Pragma("unroll") for (int i = 0; i < 3; ++i) { const int idx_ = (tid + 512 * i) >> 3, pos_ = t0_ - 128 + idx_; kw[i] = (v4u){0u, 0u, 0u, 0u}; vw[i] = (v4u){0u, 0u, 0u, 0u}; \
            if (pos_ >= 0) { const size_t r_ = (size_t)b_ * SEQ + pos_; kw[i] = *(const v4u*)(Kb + r_ * 256 + kvh_ * 64 + piece * 8); vw[i] = *(const v4u*)(Vb + r_ * 256 + kvh_ * 64 + piece * 8); } } \
        _Pragma("unroll") for (int qb = 0; qb < 2; ++qb) { const size_t r_ = (size_t)b_ * SEQ + t0_ + qo + qb * 16 + fr; \
            qw[qb][0] = *(const v4u*)(Q + r_ * 1024 + (kvh_ * 4 + hql) * 64 + fq * 8); qw[qb][1] = *(const v4u*)(Q + r_ * 1024 + (kvh_ * 4 + hql) * 64 + 32 + fq * 8); } } while (0)
    if (bx < BATCH * 4 * 64) SWA_FETCH(bx);
    for (int unit = bx; unit < BATCH * 4 * 64; unit += G) {
        const int b = unit >> 8, kvh = (unit >> 6) & 3, t0 = (unit & 63) * 64;
        const size_t row0 = (size_t)b * SEQ + t0;
        __syncthreads();
#pragma unroll
        for (int i = 0; i < 3; ++i) {
            const int pc = tid + 512 * i, idx = pc >> 3;
            const float k0 = bflo(kw[i].x), k1 = bfhi(kw[i].x), k2 = bflo(kw[i].y), k3 = bfhi(kw[i].y), k4 = bflo(kw[i].z), k5 = bfhi(kw[i].z), k6 = bflo(kw[i].w), k7 = bfhi(kw[i].w);
            float ss = (k0 * k0 + k1 * k1) + (k2 * k2 + k3 * k3) + (k4 * k4 + k5 * k5) + (k6 * k6 + k7 * k7);
            ss += __shfl_xor(ss, 1); ss += __shfl_xor(ss, 2); ss += __shfl_xor(ss, 4);
            const float rs = __builtin_amdgcn_rsqf(ss * (1.f / 64.f) + RMS_EPS);
            v4u o; o.x = cvtpk(k0 * rs * wk8[0], k1 * rs * wk8[1]); o.y = cvtpk(k2 * rs * wk8[2], k3 * rs * wk8[3]);
            o.z = cvtpk(k4 * rs * wk8[4], k5 * rs * wk8[5]); o.w = cvtpk(k6 * rs * wk8[6], k7 * rs * wk8[7]);
            *(LAS v4u*)(Kl + idx * 72 + piece * 8) = o;
            *(LAS v4u*)(Vl + idx * 72 + piece * 8) = vw[i];
        }
        const int hq = kvh * 4 + hql;
        bf16x8 qf[2][2];
#pragma unroll
        for (int qb = 0; qb < 2; ++qb) {
            const v4u w0 = qw[qb][0], w1 = qw[qb][1];
            const float a0 = bflo(w0.x), a1 = bfhi(w0.x), a2 = bflo(w0.y), a3 = bfhi(w0.y), a4 = bflo(w0.z), a5 = bfhi(w0.z), a6 = bflo(w0.w), a7 = bfhi(w0.w);
            const float c0 = bflo(w1.x), c1 = bfhi(w1.x), c2 = bflo(w1.y), c3 = bfhi(w1.y), c4 = bflo(w1.z), c5 = bfhi(w1.z), c6 = bflo(w1.w), c7 = bfhi(w1.w);
            float ss = (a0 * a0 + a1 * a1) + (a2 * a2 + a3 * a3) + (a4 * a4 + a5 * a5) + (a6 * a6 + a7 * a7) + (c0 * c0 + c1 * c1) + (c2 * c2 + c3 * c3) + (c4 * c4 + c5 * c5) + (c6 * c6 + c7 * c7);
            ss += __shfl_xor(ss, 16); ss += __shfl_xor(ss, 32);
            const float sc = __builtin_amdgcn_rsqf(ss * (1.f / 64.f) + RMS_EPS) * 0.125f * LOG2E;
            v4u p0, p1;
            p0.x = cvtpk(a0 * sc * wq0[0], a1 * sc * wq0[1]); p0.y = cvtpk(a2 * sc * wq0[2], a3 * sc * wq0[3]);
            p0.z = cvtpk(a4 * sc * wq0[4], a5 * sc * wq0[5]); p0.w = cvtpk(a6 * sc * wq0[6], a7 * sc * wq0[7]);
            p1.x = cvtpk(c0 * sc * wq1[0], c1 * sc * wq1[1]); p1.y = cvtpk(c2 * sc * wq1[2], c3 * sc * wq1[3]);
            p1.z = cvtpk(c4 * sc * wq1[4], c5 * sc * wq1[5]); p1.w = cvtpk(c6 * sc * wq1[6], c7 * sc * wq1[7]);
            qf[qb][0] = __builtin_bit_cast(bf16x8, p0); qf[qb][1] = __builtin_bit_cast(bf16x8, p1);
        }
        __syncthreads();
        if (unit + G < BATCH * 4 * 64) SWA_FETCH(unit + G);
        f32x4 s[10][2];
#pragma unroll
        for (int i = 0; i < 10; ++i) { s[i][0] = (f32x4){0.f, 0.f, 0.f, 0.f}; s[i][1] = (f32x4){0.f, 0.f, 0.f, 0.f}; }
#pragma unroll
        for (int i = 0; i < 10; ++i)
#pragma unroll
            for (int ks = 0; ks < 2; ++ks) { const bf16x8 a = *(const LAS bf16x8*)(Kl + ((kb0 + i) * 16 + fr) * 72 + ks * 32 + fq * 8);
                if (i < 9) s[i][0] = __builtin_amdgcn_mfma_f32_16x16x32_bf16(a, qf[0][ks], s[i][0], 0, 0, 0);
                if (i > 0) s[i][1] = __builtin_amdgcn_mfma_f32_16x16x32_bf16(a, qf[1][ks], s[i][1], 0, 0, 0); }
        const float sinkl = in[28][hq] * LOG2E;
        float linv[2];
#pragma unroll
        for (int qb = 0; qb < 2; ++qb) {
#pragma unroll
            for (int e = 0; e < 4; ++e) { if (!(4 * fq + e > fr)) s[qb][qb][e] = -INFINITY; if (!(4 * fq + e <= fr)) s[qb + 8][qb][e] = -INFINITY; }
            if (t0 < 128) {
#pragma unroll
                for (int d = 0; d < 9; ++d)
#pragma unroll
                    for (int e = 0; e < 4; ++e) if (t0 - 128 + (kb0 + qb + d) * 16 + 4 * fq + e < 0) s[qb + d][qb][e] = -INFINITY;
            }
            float mx = sinkl;
#pragma unroll
            for (int d = 0; d < 9; ++d) mx = fmaxf(mx, fmaxf(fmaxf(s[qb + d][qb][0], s[qb + d][qb][1]), fmaxf(s[qb + d][qb][2], s[qb + d][qb][3])));
            mx = fmaxf(mx, __shfl_xor(mx, 16)); mx = fmaxf(mx, __shfl_xor(mx, 32));
            float l = 0.f;
#pragma unroll
            for (int d = 0; d < 9; ++d)
#pragma unroll
                for (int e = 0; e < 4; ++e) { const float pv = __builtin_amdgcn_exp2f(s[qb + d][qb][e] - mx); s[qb + d][qb][e] = pv; l += pv; }
            l += __shfl_xor(l, 16); l += __shfl_xor(l, 32);
            l += __builtin_amdgcn_exp2f(sinkl - mx);
            linv[qb] = 1.0f / l;
        }
        s[9][0] = (f32x4){0.f, 0.f, 0.f, 0.f}; s[0][1] = (f32x4){0.f, 0.f, 0.f, 0.f};
        f32x4 o[4][2];
#pragma unroll
        for (int hb = 0; hb < 4; ++hb) { o[hb][0] = (f32x4){0.f, 0.f, 0.f, 0.f}; o[hb][1] = (f32x4){0.f, 0.f, 0.f, 0.f}; }
#pragma unroll
        for (int st = 0; st < 5; ++st) {
            bf16x8 pf[2];
#pragma unroll
            for (int qb = 0; qb < 2; ++qb) { v4u w; w.x = cvtpk(s[2 * st][qb][0], s[2 * st][qb][1]); w.y = cvtpk(s[2 * st][qb][2], s[2 * st][qb][3]);
                w.z = cvtpk(s[2 * st + 1][qb][0], s[2 * st + 1][qb][1]); w.w = cvtpk(s[2 * st + 1][qb][2], s[2 * st + 1][qb][3]); pf[qb] = __builtin_bit_cast(bf16x8, w); }
#pragma unroll
            for (int hb = 0; hb < 4; ++hb) {
                const v2u lo = tr16(Vl + ((kb0 + 2 * st) * 16 + 4 * fq + tq) * 72 + 16 * hb + 4 * tp), hi = tr16(Vl + ((kb0 + 2 * st + 1) * 16 + 4 * fq + tq) * 72 + 16 * hb + 4 * tp);
                v4u aw; aw.x = lo.x; aw.y = lo.y; aw.z = hi.x; aw.w = hi.y;
                const bf16x8 a = __builtin_bit_cast(bf16x8, aw);
                o[hb][0] = __builtin_amdgcn_mfma_f32_16x16x32_bf16(a, pf[0], o[hb][0], 0, 0, 0);
                o[hb][1] = __builtin_amdgcn_mfma_f32_16x16x32_bf16(a, pf[1], o[hb][1], 0, 0, 0); }
        }
#pragma unroll
        for (int qb = 0; qb < 2; ++qb) { const size_t r = row0 + qo + qb * 16 + fr;
#pragma unroll
            for (int hb = 0; hb < 4; ++hb) { const f32x4 v = o[hb][qb] * linv[qb]; v2u w; w.x = cvtpk(v[0], v[1]); w.y = cvtpk(v[2], v[3]);
                *(v2u*)(Y + r * D + hq * 64 + hb * 16 + 4 * fq) = w; } }
    }
#undef SWA_FETCH
}
DI void gla_pre(const InTab in, unsigned char* ws, LAS unsigned char* lds, int bx, int G, int tid, int lane, int wave) {
    typedef short bf16x8 __attribute__((ext_vector_type(8)));
    const bf16* QD = (const bf16*)(ws + WS_QD); const bf16* KD = (const bf16*)(ws + WS_KD); const float* GLR = (const float*)(ws + WS_GLR);
    bf16* QT = (bf16*)(ws + WS_QT); bf16* KTT = (bf16*)(ws + WS_KTT); bf16* ATT = (bf16*)(ws + WS_ATT); float* DEC = (float*)(ws + WS_DEC);
    LAS bf16* Ql = (LAS bf16*)(lds + RING_OFF);
    LAS bf16* Kl = Ql + 64 * 136;
    LAS float* gl = (LAS float*)(Kl + 64 * 136);
    LAS float* tot = gl + 64 * 16;
    const int fr = lane & 15, fq = lane >> 4, kc = tid & 127, sg = tid >> 7;
    constexpr int NU = BATCH * 64 * 4;
    if (bx >= NU) return;
    float w2n[16], gbn; f32x4 rgn; bf16 rqn[16], rkn[16];
#define GP_FETCH(u_) do { const int h_ = (u_) & 3, bc2_ = (u_) >> 2; const size_t r0_ = (size_t)(bc2_ >> 6) * SEQ + (size_t)(bc2_ & 63) * 64; \
        _Pragma("unroll") for (int r = 0; r < 16; ++r) w2n[r] = in[29][r * 512 + h_ * 128 + kc]; \
        gbn = in[30][h_ * 128 + kc]; \
        rgn = *(const f32x4*)(GLR + r0_ * 16 + (tid & 255) * 4); \
        _Pragma("unroll") for (int i = 0; i < 16; ++i) { rqn[i] = QD[(r0_ + 16 * sg + i) * 512 + h_ * 128 + kc]; rkn[i] = KD[(r0_ + 16 * sg + i) * 512 + h_ * 128 + kc]; } } while (0)
    GP_FETCH(bx);
    for (int unit = bx;; unit += G) {
        const int h = unit & 3, bc_ = unit >> 2, b = bc_ >> 6, c = bc_ & 63;
        const size_t row0 = (size_t)b * SEQ + c * 64;
        float w2[16]; bf16 rq[16], rk[16];
#pragma unroll
        for (int r = 0; r < 16; ++r) { w2[r] = w2n[r]; rq[r] = rqn[r]; rk[r] = rkn[r]; }
        const float gb = gbn; const f32x4 rg = rgn;
        GP_FETCH(unit + G < NU ? unit + G : unit);
        __syncthreads();
        if (tid < 256) *(LAS f32x4*)(gl + tid * 4) = rg;
        __syncthreads();
        float pre[16]; float run = 0.f;
#pragma unroll
        for (int i = 0; i < 16; ++i) { const LAS f32x4* gp = (const LAS f32x4*)(gl + (16 * sg + i) * 16); const f32x4 g0 = gp[0], g1 = gp[1], g2 = gp[2], g3 = gp[3];
            float x = gb;
#pragma unroll
            for (int e = 0; e < 4; ++e) x += g0[e] * w2[e] + g1[e] * w2[4 + e] + g2[e] * w2[8 + e] + g3[e] * w2[12 + e];
            const float ls = fminf(x, 0.f) - __logf(1.0f + __expf(-fabsf(x)));
            run += ls * (1.0f / 16.0f); pre[i] = run; }
        tot[sg * 128 + kc] = run;
        __syncthreads();
        const float t0 = tot[kc], t1 = tot[128 + kc], t2 = tot[256 + kc], t3 = tot[384 + kc];
        const float offs = (sg > 0 ? t0 : 0.f) + (sg > 1 ? t1 : 0.f) + (sg > 2 ? t2 : 0.f), blast = (t0 + t1) + (t2 + t3);
        if (sg == 0) DEC[(size_t)unit * 128 + kc] = __expf(blast);
        float k2[16];
#pragma unroll
        for (int i = 0; i < 16; ++i) { const int t = 16 * sg + i; const float bcv = pre[i] + offs;
            const float q = bf2f(rq[i]), k = bf2f(rk[i]);
            const float qt = q * __expf(bcv) * 0.08838834764831845f, kt = k * __expf(-bcv);
            k2[i] = k * __expf(blast - bcv);
            const bf16 qb = (bf16)f2bf(qt);
            QT[(row0 + t) * 512 + h * 128 + kc] = qb; Ql[t * 136 + kc] = qb; Kl[t * 136 + kc] = (bf16)f2bf(kt); }
        { v4u o0, o1; o0.x = cvtpk(k2[0], k2[1]); o0.y = cvtpk(k2[2], k2[3]); o0.z = cvtpk(k2[4], k2[5]); o0.w = cvtpk(k2[6], k2[7]);
          o1.x = cvtpk(k2[8], k2[9]); o1.y = cvtpk(k2[10], k2[11]); o1.z = cvtpk(k2[12], k2[13]); o1.w = cvtpk(k2[14], k2[15]);
          v4u* dst = (v4u*)(KTT + ((size_t)unit * 128 + kc) * 64 + 16 * sg); dst[0] = o0; dst[1] = o1; }
        __syncthreads();
#pragma unroll
        for (int ti = 0; ti < 2; ++ti) { const int tile = wave * 2 + ti, sb = tile >> 2, lb = tile & 3;
            f32x4 acc = {0.f, 0.f, 0.f, 0.f};
            if (sb <= lb) {
#pragma unroll
                for (int ks = 0; ks < 4; ++ks) { const bf16x8 a = *(const LAS bf16x8*)(Kl + (16 * sb + fr) * 136 + 32 * ks + 8 * fq), bq = *(const LAS bf16x8*)(Ql + (16 * lb + fr) * 136 + 32 * ks + 8 * fq);
                    acc = __builtin_amdgcn_mfma_f32_16x16x32_bf16(a, bq, acc, 0, 0, 0); }
            }
            const int l = 16 * lb + fr, s0 = 16 * sb + 4 * fq;
            v2u w; w.x = cvtpk(s0 <= l ? acc[0] : 0.f, s0 + 1 <= l ? acc[1] : 0.f); w.y = cvtpk(s0 + 2 <= l ? acc[2] : 0.f, s0 + 3 <= l ? acc[3] : 0.f);
            *(v2u*)(ATT + ((size_t)unit * 64 + l) * 64 + s0) = w; }
        if (unit + G >= NU) break;
    }
#undef GP_FETCH
}
DI void gla_seq(const InTab in, unsigned char* ws, LAS unsigned char* lds, int bx, int G, int tid, int lane, int wave) {
    typedef short bf16x8 __attribute__((ext_vector_type(8)));
    const bf16* VD = (const bf16*)(ws + WS_VD); const bf16* QT = (const bf16*)(ws + WS_QT); const bf16* KTT = (const bf16*)(ws + WS_KTT); const bf16* ATT = (const bf16*)(ws + WS_ATT);
    const float* DEC = (const float*)(ws + WS_DEC); bf16* GO = (bf16*)(ws + WS_GLAO);
    LAS bf16* vl0 = (LAS bf16*)(lds + RING_OFF);
    LAS bf16* ST = vl0 + 2 * 64 * 40;
    const int fr = lane & 15, fq = lane >> 4, lb = wave & 3, tq = fr >> 2, tp = fr & 3; const bool owave = wave < 4;
    for (int unit = bx; unit < BATCH * 32; unit += G) {
        const int b = unit >> 5, h = (unit >> 3) & 3, sl = unit & 7;
        f32x4 st[2]; st[0] = (f32x4){0.f, 0.f, 0.f, 0.f}; st[1] = (f32x4){0.f, 0.f, 0.f, 0.f};
        __syncthreads();
        for (int i = tid; i < 32 * 136 / 2; i += 512) ((LAS unsigned*)ST)[i] = 0u;
        v4u rV[2]; bf16x8 rA[2][2], rQ[2][4], rK[2][2]; f32x4 rD[2];
        rV[0] = rV[1] = (v4u){0u, 0u, 0u, 0u};
#pragma unroll
        for (int s_ = 0; s_ < 2; ++s_) {
#pragma unroll
            for (int ks = 0; ks < 2; ++ks) rA[s_][ks] = (bf16x8){0, 0, 0, 0, 0, 0, 0, 0};
#pragma unroll
            for (int ks = 0; ks < 4; ++ks) rQ[s_][ks] = (bf16x8){0, 0, 0, 0, 0, 0, 0, 0}; }
#define GLA_FETCH(set, chunk) do { const size_t r0_ = (size_t)b * SEQ + (size_t)(chunk) * 64; const size_t cu_ = (size_t)(b * 64 + (chunk)) * 4 + h; \
            if (tid < 256) rV[set] = *(const v4u*)(VD + (r0_ + (tid >> 2)) * 1024 + h * 256 + sl * 32 + (tid & 3) * 8); \
            _Pragma("unroll") for (int ks = 0; ks < 2; ++ks) rK[set][ks] = *(const bf16x8*)(KTT + (cu_ * 128 + 16 * wave + fr) * 64 + 32 * ks + 8 * fq); \
            if (owave) { _Pragma("unroll") for (int ks = 0; ks < 2; ++ks) rA[set][ks] = *(const bf16x8*)(ATT + (cu_ * 64 + 16 * lb + fr) * 64 + 32 * ks + 8 * fq); \
                _Pragma("unroll") for (int ks = 0; ks < 4; ++ks) rQ[set][ks] = *(const bf16x8*)(QT + (r0_ + 16 * lb + fr) * 512 + h * 128 + 32 * ks + 8 * fq); } \
            rD[set] = *(const f32x4*)(DEC + cu_ * 128 + 16 * wave + 4 * fq); } while (0)
#define GLA_STEP(set, chunk) do { const int ch_ = (chunk); const size_t row0 = (size_t)b * SEQ + (size_t)ch_ * 64; \
            const LAS bf16* vl = vl0 + (ch_ & 1) * (64 * 40); \
            bf16x8 wA[2], wQ[4], wK[2]; const f32x4 wD = rD[set]; \
            _Pragma("unroll") for (int ks = 0; ks < 2; ++ks) { wA[ks] = rA[set][ks]; wK[ks] = rK[set][ks]; } \
            _Pragma("unroll") for (int ks = 0; ks < 4; ++ks) wQ[ks] = rQ[set][ks]; \
            if (ch_ + 2 < SEQ / 64) GLA_FETCH(set, ch_ + 2); \
            const LAS bf16* Scur = ST + (ch_ & 1) * (32 * 136); LAS bf16* Snxt = ST + ((ch_ + 1) & 1) * (32 * 136); \
            bf16x8 vf[2][2]; \
            _Pragma("unroll") for (int d2 = 0; d2 < 2; ++d2) _Pragma("unroll") for (int ks = 0; ks < 2; ++ks) { \
                const v2u lo = tr16(vl + (32 * ks + 8 * fq + tq) * 40 + 16 * d2 + 4 * tp), hi = tr16(vl + (32 * ks + 8 * fq + 4 + tq) * 40 + 16 * d2 + 4 * tp); \
                v4u aw; aw.x = lo.x; aw.y = lo.y; aw.z = hi.x; aw.w = hi.y; vf[d2][ks] = __builtin_bit_cast(bf16x8, aw); } \
            if (owave) { _Pragma("unroll") for (int d2 = 0; d2 < 2; ++d2) { f32x4 o = {0.f, 0.f, 0.f, 0.f}, o2 = {0.f, 0.f, 0.f, 0.f}; \
                _Pragma("unroll") for (int ks = 0; ks < 2; ++ks) if (2 * ks <= lb) o = __builtin_amdgcn_mfma_f32_16x16x32_bf16(vf[d2][ks], wA[ks], o, 0, 0, 0); \
                _Pragma("unroll") for (int ks = 0; ks < 4; ++ks) { const bf16x8 a = *(const LAS bf16x8*)(Scur + (16 * d2 + fr) * 136 + 32 * ks + 8 * fq); \
                    if (ks & 1) o2 = __builtin_amdgcn_mfma_f32_16x16x32_bf16(a, wQ[ks], o2, 0, 0, 0); else o = __builtin_amdgcn_mfma_f32_16x16x32_bf16(a, wQ[ks], o, 0, 0, 0); } \
                o = o + o2; \
                v2u w; w.x = cvtpk(o[0], o[1]); w.y = cvtpk(o[2], o[3]); \
                *(v2u*)(GO + (row0 + 16 * lb + fr) * 1024 + h * 256 + sl * 32 + 16 * d2 + 4 * fq) = w; } } \
            _Pragma("unroll") for (int d2 = 0; d2 < 2; ++d2) { st[d2] = st[d2] * wD; \
                _Pragma("unroll") for (int ks = 0; ks < 2; ++ks) st[d2] = __builtin_amdgcn_mfma_f32_16x16x32_bf16(wK[ks], vf[d2][ks], st[d2], 0, 0, 0); \
                v2u sw; sw.x = cvtpk(st[d2][0], st[d2][1]); sw.y = cvtpk(st[d2][2], st[d2][3]); \
                *(LAS v2u*)(Snxt + (16 * d2 + fr) * 136 + 16 * wave + 4 * fq) = sw; } \
            if (tid < 256) *(LAS v4u*)(vl0 + ((ch_ + 1) & 1) * (64 * 40) + (tid >> 2) * 40 + (tid & 3) * 8) = rV[(set) ^ 1];     \
            BAR_LDS(); } while (0)
        GLA_FETCH(0, 0); GLA_FETCH(1, 1);
        if (tid < 256) *(LAS v4u*)(vl0 + (tid >> 2) * 40 + (tid & 3) * 8) = rV[0];
        __syncthreads();
        for (int ch = 0; ch < SEQ / 64; ch += 2) { GLA_STEP(0, ch); GLA_STEP(1, ch + 1); }
#undef GLA_FETCH
#undef GLA_STEP
    }
}
DI void gla_finalize(const InTab in, unsigned char* ws, int gw, int NGW, int lane) {
    const bf16* GO = (const bf16*)(ws + WS_GLAO); const bf16* GOUT = (const bf16*)(ws + WS_GOUT); bf16* Y = (bf16*)(ws + WS_A);
    const f32x4 g = *(const f32x4*)(in[31] + lane * 4);
    for (int m = 2 * gw; m < M; m += 2 * NGW) {
        v2u wo[2][4], wg[2][4];
#pragma unroll
        for (int r = 0; r < 2; ++r)
#pragma unroll
            for (int h = 0; h < 4; ++h) { wo[r][h] = *(const v2u*)(GO + (size_t)(m + r) * 1024 + h * 256 + lane * 4); wg[r][h] = *(const v2u*)(GOUT + (size_t)(m + r) * 1024 + h * 256 + lane * 4); }
#pragma unroll
        for (int r = 0; r < 2; ++r)
#pragma unroll
            for (int h = 0; h < 4; ++h) {
                const float v0 = bflo(wo[r][h].x), v1 = bfhi(wo[r][h].x), v2 = bflo(wo[r][h].y), v3 = bfhi(wo[r][h].y);
                const float rstd = __builtin_amdgcn_rsqf(wave_sum(v0 * v0 + v1 * v1 + v2 * v2 + v3 * v3) * (1.f / 256.f) + RMS_EPS);
                v2u o; o.x = cvtpk(v0 * rstd * g.x * silu_f(bflo(wg[r][h].x)), v1 * rstd * g.y * silu_f(bfhi(wg[r][h].x)));
                o.y = cvtpk(v2 * rstd * g.z * silu_f(bflo(wg[r][h].y)), v3 * rstd * g.w * silu_f(bfhi(wg[r][h].y)));
                *(v2u*)(Y + (size_t)(m + r) * D + 1024 + h * 256 + lane * 4) = o;
            }
    }
}
#define RT(base, first, ld) {(unsigned long long)(base) + 512ull * (unsigned long long)(first), (ld), 0}
__device__ const pg8::Route ROUTES[2][19] = {
  { RT(WS_U, 0, 512), RT(WS_U, 1, 512),
    RT(WS_Z, 0, 1536), RT(WS_Z, 1, 1536), RT(WS_Z, 2, 1536), RT(WS_Z, 3, 1536), RT(WS_Z, 4, 1536), RT(WS_Z, 5, 1536),
    RT(WS_XBC, 0, 2560), RT(WS_XBC, 1, 2560), RT(WS_XBC, 2, 2560), RT(WS_XBC, 3, 2560), RT(WS_XBC, 4, 2560), RT(WS_XBC, 5, 2560), RT(WS_XBC, 6, 2560), RT(WS_XBC, 7, 2560), RT(WS_XBC, 8, 2560), RT(WS_XBC, 9, 2560),
    RT(WS_DT, 0, 32) },
  { RT(WS_Q, 0, 1024), RT(WS_Q, 1, 1024), RT(WS_Q, 2, 1024), RT(WS_Q, 3, 1024),
    RT(WS_K, 0, 256), RT(WS_V, 0, 256),
    RT(WS_QD, 0, 512), RT(WS_QD, 1, 512), RT(WS_KD, 0, 512), RT(WS_KD, 1, 512),
    RT(WS_VD, 0, 1024), RT(WS_VD, 1, 1024), RT(WS_VD, 2, 1024), RT(WS_VD, 3, 1024),
    RT(WS_GOUT, 0, 1024), RT(WS_GOUT, 1, 1024), RT(WS_GOUT, 2, 1024), RT(WS_GOUT, 3, 1024),
    RT(WS_GLR, 0, 16) } };
#undef RT
template <int NB>
DI void tail_pass(const bf16* A, const bf16* Bt, float* out, int ldo, int ncols, const pg8::ssq_t* ss, LAS unsigned char* lds, int bx, int G, int lane, int wave) {
    typedef short bf16x8 __attribute__((ext_vector_type(8)));
    const int fr = lane & 15, fq = lane >> 4;
    LAS f32x4* P = (LAS f32x4*)(lds + RING_OFF);
    for (int job = bx; job < M / 128; job += G) {
        const int row_base = job * 128, kbase = wave * 256;
        f32x4 c[8][NB];
#pragma unroll
        for (int rb = 0; rb < 8; ++rb)
#pragma unroll
            for (int nb = 0; nb < NB; ++nb) c[rb][nb] = (f32x4){0.f, 0.f, 0.f, 0.f};
        const bf16* ap = A + (size_t)(row_base + fr) * 2048 + kbase + 8 * fq; const bf16* bp = Bt + (size_t)fr * 2048 + kbase + 8 * fq;
#pragma unroll 1
        for (int j0 = 0; j0 < 8; j0 += 2) {
            bf16x8 a[2][8], bb[2][NB];
#pragma unroll
            for (int j = 0; j < 2; ++j) {
#pragma unroll
                for (int rb = 0; rb < 8; ++rb) a[j][rb] = *(const bf16x8*)(ap + (size_t)rb * 16 * 2048 + 32 * (j0 + j));
#pragma unroll
                for (int nb = 0; nb < NB; ++nb) bb[j][nb] = *(const bf16x8*)(bp + (size_t)nb * 16 * 2048 + 32 * (j0 + j)); }
#pragma unroll
            for (int j = 0; j < 2; ++j)
#pragma unroll
                for (int rb = 0; rb < 8; ++rb)
#pragma unroll
                    for (int nb = 0; nb < NB; ++nb) c[rb][nb] = __builtin_amdgcn_mfma_f32_16x16x32_bf16(a[j][rb], bb[j][nb], c[rb][nb], 0, 0, 0);
        }
        __syncthreads();
#pragma unroll
        for (int rb = 0; rb < 8; ++rb)
#pragma unroll
            for (int nb = 0; nb < NB; ++nb) P[((wave * 8 + rb) * NB + nb) * 64 + lane] = c[rb][nb];
        __syncthreads();
        {   const int rb = wave;
#pragma unroll
            for (int nb = 0; nb < NB; ++nb) { f32x4 t = P[((0 * 8 + rb) * NB + nb) * 64 + lane];
#pragma unroll
                for (int w = 1; w < 8; ++w) t = t + P[((w * 8 + rb) * NB + nb) * 64 + lane];
#pragma unroll
                for (int e = 0; e < 4; ++e) { const int row = row_base + 16 * rb + 4 * fq + e, col = 16 * nb + fr;
                    const float rs = __builtin_amdgcn_rsqf(pg8::ssq_to_f(ss[row]) * (1.0f / D) + RMS_EPS);
                    if (col < ncols) out[(size_t)row * ldo + col] = t[e] * rs; } } }
    }
}
constexpr bool USE_HB5 = XMANT < 7;
DI pg8::ssq_t* ssq(unsigned char* ws, int k) { return k == 0 ? (pg8::ssq_t*)(ws + WS_SS0) : (pg8::ssq_t*)(ws + WS_SS) + (size_t)(k - 1) * M; }
struct Args { const float* in[37]; float* out; unsigned char* ws; int ph_lo, ph_hi; };
#define IN(k) (lo <= (k) && (k) < hi)
#define SEAM(k) do { if (IN(k) && IN((k) + 1)) xcd_barrier(bar); } while (0)
template <int LAYER, int HF>
DI void ffn_half(const InTab in, float* out, unsigned char* ws, LAS unsigned char* lds, const XcdBarrier& bar, int G, int bx) {
    constexpr int MH = M / 2; constexpr size_t R0 = (size_t)HF * MH;
    bf16* HB = (bf16*)(ws + WS_HB) + R0 * D; bf16* Hh = (bf16*)(ws + WS_H) + R0 * FF;
    const bf16* W13 = (const bf16*)(ws + (LAYER ? WS_W13_1 : WS_W13_0)); const bf16* W2 = (const bf16*)(ws + (LAYER ? WS_W2_1 : WS_W2_0));
    { pg8::Gemm g{USE_HB5 ? (const bf16*)(ws + WS_HB5) + R0 * D : HB, W13, MH, 2 * FF, D}; pg8::RevOrder S; S.init(MH, 2 * FF, G, bx);
      pg8::EpiSwiGLU E{Hh, FF, ssq(ws, LAYER ? 3 : 1) + R0, 1.0f / D, RMS_EPS};
      pg8::gemm_phase<pg8::EpiSwiGLU, pg8::RevOrder, true, true>(lds + RING_OFF, g, S, E); }
    xcd_barrier(bar);
    { pg8::Gemm g{Hh, W2, MH, D, FF}; pg8::StaticOrder S; S.init(MH, D, G, bx);
      if (LAYER == 0) { pg8::EpiResidBf<false> E{nullptr, HB, D, ssq(ws, 2) + R0, nullptr};
          pg8::gemm_phase<pg8::EpiResidBf<false>, pg8::StaticOrder, true, true>(lds + RING_OFF, g, S, E); }
      else { pg8::EpiResidOut E{HB, out + R0 * D, D};
          pg8::gemm_phase<pg8::EpiResidOut, pg8::StaticOrder, true, true>(lds + RING_OFF, g, S, E); } }
}
template <int LAYER>
DI void layer_body(const InTab in, float* out, unsigned char* ws, LAS unsigned char* lds, const XcdBarrier& bar, int lo, int hi, int tid, int lane, int wave, int G, int bx) {
    constexpr int pb = LAYER * 9;
    const int gw = bx * NWAVES + wave, NGW = G * NWAVES, gt = bx * NWAVES * 64 + tid, NGT = G * NWAVES * 64;
    bf16* HB = (bf16*)(ws + WS_HB); bf16* YM = (bf16*)(ws + WS_A);
    const bf16* WIN = (const bf16*)(ws + (LAYER ? WS_WIN1 : WS_WIN0)); const bf16* WOUT = (const bf16*)(ws + (LAYER ? WS_WOUT1 : WS_WOUT0));
    const bf16* W13 = (const bf16*)(ws + (LAYER ? WS_W13_1 : WS_W13_0)); const bf16* W2 = (const bf16*)(ws + (LAYER ? WS_W2_1 : WS_W2_0));
    if (LAYER == 0) {
        if (IN(pb + 0)) { prologue(in, ws, lds, gw, NGW, lane, wave); s5_tables(in, ws, gt); x_to_hb_phase(in[0], HB, ssq(ws, 0), gw, NGW, lane); }
        SEAM(pb + 0);
    }
    if (IN(pb + 1)) {
        if (LAYER == 0) { s5_tables2(in, ws, lds, bx, G, tid); __syncthreads(); }
        pg8::Gemm g{HB, WIN, M, N_MAIN, D};
        pg8::EpiRoute E; E.ws = ws; E.tab = ROUTES[LAYER]; E.ftile = -1; E.fbase = nullptr; E.fld = 0; E.fcols = 0; E.ss = ssq(ws, LAYER ? 2 : 0); E.inv_n = 1.0f / D; E.eps = RMS_EPS;
        pg8::TailOrder<LAYER == 0 ? 2 : 1> S; S.init(M, N_MAIN, G, bx); S.A = HB; S.Bt = WIN + (size_t)N_MAIN * D; S.tail_pn = -1  ; S.ss = ssq(ws, LAYER ? 2 : 0); S.inv_n = 1.0f / D; S.eps = RMS_EPS;
        if (LAYER == 0) { S.out = (float*)(ws + WS_DT); S.ldo = 32; S.ncols = 24; }
        else { S.out = (float*)(ws + WS_GLR); S.ldo = 16; S.ncols = 16; }
        pg8::gemm_phase<pg8::EpiRoute, pg8::TailOrder<LAYER == 0 ? 2 : 1>, true, true>(lds + RING_OFF, g, S, E);
        tail_pass<LAYER == 0 ? 2 : 1>(HB, WIN + (size_t)N_MAIN * D, S.out, S.ldo, S.ncols, ssq(ws, LAYER ? 2 : 0), lds, bx, G, lane, wave);
    }
    SEAM(pb + 1);
    if (IN(pb + 2)) {
        if (LAYER == 0) {
            const int ha = G / 4;
            if (bx < ha) s5_fast(in, ws, lds, bx, 64, ha, tid, lane, wave);
            else conv_phase(in, ws, (bx - ha) * NWAVES * 64 + tid, (G - ha) * NWAVES * 64);
        }
        else { gla_pre(in, ws, lds, bx, G, tid, lane, wave); __syncthreads(); swa_fast(in, ws, lds, bx, G, tid, lane, wave); }
    }
    SEAM(pb + 2);
    if (IN(pb + 3)) {
        if (LAYER == 0) { ssd_fast(in, ws, lds, bx, G, tid, lane, wave);
            const bool spare = G > 192;
            if (!spare || bx >= 192) s5_fast(in, ws, lds, 64 + (spare ? bx - 192 : bx), 256, spare ? G - 192 : G, tid, lane, wave); }
        else gla_seq(in, ws, lds, bx, G, tid, lane, wave);
    }
    SEAM(pb + 3);
    if (IN(pb + 4)) {
        if (LAYER == 0) {
            ssd_finalize(in, ws, gw, NGW, lane);
            __syncthreads();
            pg8::Gemm g{(const bf16*)(ws + WS_YPRE), (const bf16*)(ws + WS_GLUW), M, 512, 512}; pg8::StaticOrder S; S.init(M, 512, G, bx);
            pg8::EpiGLU E{(const bf16*)(ws + WS_YPRE), 512, YM, D, in[12]};
            pg8::gemm_phase<pg8::EpiGLU, pg8::StaticOrder, true, true>(lds + RING_OFF, g, S, E);
        } else gla_finalize(in, ws, gw, NGW, lane);
    }
    SEAM(pb + 4);
    if (IN(pb + 5)) {
        pg8::Gemm g{YM, WOUT, M, D, D}; pg8::StaticOrder S; S.init(M, D, G, bx);
        pg8::EpiResidBf<false, USE_HB5> E{nullptr, HB, D, ssq(ws, LAYER ? 3 : 1), (bf16*)(ws + WS_HB5)};
        pg8::gemm_phase<pg8::EpiResidBf<false, USE_HB5>, pg8::StaticOrder, true, true>(lds + RING_OFF, g, S, E);
    }
    if (IN(pb + 5) && IN(pb + 7)) xcd_barrier(bar);
    if (IN(pb + 7)) {
        ffn_half<LAYER, 0>(in, out, ws, lds, bar, G, bx);
        ffn_half<LAYER, 1>(in, out, ws, lds, bar, G, bx);
    }
    if (LAYER == 0) { if (IN(pb + 7) && IN(pb + 10)) xcd_barrier(bar); }
}
__global__ void __launch_bounds__(NWAVES * 64, 2) fwd(Args args) {
    extern __shared__ __attribute__((aligned(16))) unsigned char lds_raw[];
    LAS unsigned char* lds = (LAS unsigned char*)lds_raw;
    volatile LAS unsigned* MISC = (volatile LAS unsigned*)(lds + MISC_OFF);
    const int tid = threadIdx.x, lane = tid & 63, wave = __builtin_amdgcn_readfirstlane(tid >> 6);
    const int G = gridDim.x, bx = blockIdx.x;
    unsigned char* ws = args.ws;
    if (tid < 32) MISC[tid] = 0u;
    if (tid < 37) ((LAS unsigned long long*)(lds + PT_OFF))[tid] = (unsigned long long)args.in[tid];
    __syncthreads();
    InTab in; in.t = (const LAS unsigned long long*)(lds + PT_OFF);
    const int lo = args.ph_lo, hi = args.ph_hi;
    XcdBarrier bar; bar.bar = (unsigned*)(ws + WS_CTL) + CW_BAR; bar.x = 0; bar.st = nullptr;
    if (hi - lo > 1) bar = xcd_barrier_post((unsigned*)(ws + WS_CTL) + CW_BAR, MISC + 8);
    layer_body<0>(in, args.out, ws, lds, bar, lo, hi, tid, lane, wave, G, bx);
    layer_body<1>(in, args.out, ws, lds, bar, lo, hi, tid, lane, wave, G, bx);
}
#undef IN
#undef SEAM

extern "C" void kernel_launch(void* const* d_in, const int* in_sizes, int n_in, void* d_out, int out_size, void* d_ws, size_t ws_size, hipStream_t stream) {
    static int grid = 0;
    if (grid == 0) {
        if (n_in != 37 || in_sizes[0] != M * D || out_size != M * D || ws_size < WS_END) { fprintf(stderr, "kernel_launch: unexpected shapes (n_in %d, in0 %d, out %d, ws %zu)\n", n_in, n_in > 0 ? in_sizes[0] : -1, out_size, ws_size); grid = -1; return; }
        int dev = 0, cus = 0;
        if (hipGetDevice(&dev) != hipSuccess || hipDeviceGetAttribute(&cus, hipDeviceAttributeMultiprocessorCount, dev) != hipSuccess) { grid = -1; return; }
        if (hipFuncSetAttribute((const void*)fwd, hipFuncAttributeMaxDynamicSharedMemorySize, LDS_BYTES) != hipSuccess) { fprintf(stderr, "kernel_launch: hipFuncSetAttribute failed\n"); grid = -1; return; }
        int per_cu = 0;
        if (hipOccupancyMaxActiveBlocksPerMultiprocessor(&per_cu, (const void*)fwd, NWAVES * 64, LDS_BYTES) != hipSuccess || per_cu < 1) fprintf(stderr, "kernel_launch: occupancy query reports %d\n", per_cu);
        (void)hipGetLastError();
        grid = cus;
    }
    if (grid < 0) return;
    if (hipMemsetAsync((char*)d_ws + WS_CTL, 0, CTL_ZERO_BYTES, stream) != hipSuccess) return;
    Args a{};
    for (int i = 0; i < 37; ++i) a.in[i] = (const float*)d_in[i];
    a.out = (float*)d_out; a.ws = (unsigned char*)d_ws;
    a.ph_lo = 0; a.ph_hi = NPHASE;
    hipLaunchKernelGGL(fwd, dim3(grid), dim3(NWAVES * 64), LDS_BYTES, stream, a);
}
```

```cpp
#include <hip/hip_runtime.h>
#include <cstdio>
#include <cstdint>
#include <cmath>
#ifndef WM_IN
#define WM_IN 7
#endif
#ifndef WM_OUT
#define WM_OUT 7
#endif
#ifndef WM_FFN
#define WM_FFN 5
#endif
#ifndef AMANT
#define AMANT 7
#endif
#ifndef HMANT
#define HMANT 7
#endif
#ifndef XMANT
#define XMANT 7
#endif
namespace pg8 {
#define PG8_LAS __attribute__((address_space(3)))
typedef unsigned short bf16_t;
typedef short bf16x8 __attribute__((ext_vector_type(8)));
typedef float f32x4 __attribute__((ext_vector_type(4)));
typedef unsigned u32x4 __attribute__((ext_vector_type(4)));
constexpr int BM = 256, BK = 64, HALF = 128, HTB = HALF * BK * 2  , STAGE_BYTES = 8 * HTB, NXCD = 8, WGM = 8;

__host__ __device__ __forceinline__ int lds_byte(int r, int c) { const int st = (r >> 4) * 2 + (c >> 5), rr = r & 15, cc = c & 31, ob = rr * 64 + cc * 2; return st * 1024 + (ob ^ (((ob >> 9) & 1) << 5)); }
__host__ __device__ __forceinline__ void stage_rc(int b, int& R, int& C) { const int st = b / 1024, sb = b % 1024, swz = sb ^ (((sb >> 9) & 1) << 5); R = (st >> 1) * 16 + swz / 64; C = (st & 1) * 32 + (swz % 64) / 2; }
__host__ __device__ __forceinline__ int perm32(int rho) { const int n = rho >> 4, i = rho & 15; return 8 * (i >> 2) + 4 * n + (i & 3); }

struct Unit { int pm, pn; };
struct Gemm { const bf16_t* A; const bf16_t* Bt; int M, N, K; };

struct StaticOrder {
    int nM, nN, nwg, G, c;
    __host__ __device__ void init(int M, int N, int G_, int c_) { nM = M / BM; nN = N / BM; nwg = nM * nN; G = G_; c = c_; }
    __host__ __device__ bool next(int i, Unit& u) const {
        const long L = (long)i * G + c; if (L >= nwg) return false;
        int wgid = (int)L; { const int q = nwg / NXCD, r = nwg % NXCD, xcd = wgid % NXCD, off = wgid / NXCD; wgid = (xcd < r ? xcd * (q + 1) : r * (q + 1) + (xcd - r) * q) + off; }
        const int nig = WGM * nN, gid = wgid / nig, fm = gid * WGM, gsz = (nM - fm) < WGM ? (nM - fm) : WGM;
        u.pm = fm + ((wgid % nig) % gsz); u.pn = (wgid % nig) / gsz; return true;
    }
    __device__ __forceinline__ void a_ready(const Unit&) const {}
    __device__ __forceinline__ void done(const Unit&) const {}
};
__device__ __forceinline__ unsigned cvt_pk_bf16(float lo, float hi) { unsigned r; asm volatile("v_cvt_pk_bf16_f32 %0, %1, %2" : "=v"(r) : "v"(lo), "v"(hi)); return r; }
typedef unsigned long long ssq_t;
__device__ __forceinline__ float ssq_to_f(ssq_t q) { return ((float)(unsigned)(q >> 32) * 4294967296.0f + (float)(unsigned)q) * (1.0f / 16777216.0f); }
__device__ __forceinline__ ssq_t ssq_from_f(float s) { return (ssq_t)(s * 16777216.0f); }
struct RevOrder : StaticOrder {
    __host__ __device__ bool next(int i, Unit& u) const {
        const long L = (long)nwg - (long)G * (i + 1) + c; if (L < 0) return false;
        int wgid = (int)L; { const int q = nwg / NXCD, r = nwg % NXCD, xcd = wgid % NXCD, off = wgid / NXCD; wgid = (xcd < r ? xcd * (q + 1) : r * (q + 1) + (xcd - r) * q) + off; }
        const int nig = WGM * nN, gid = wgid / nig, fm = gid * WGM, gsz = (nM - fm) < WGM ? (nM - fm) : WGM;
        u.pm = fm + ((wgid % nig) % gsz); u.pn = (wgid % nig) / gsz; return true;
    }
};
template <int NB> struct TailOrder : StaticOrder {
    const bf16_t* A; const bf16_t* Bt; float* out; int ldo, ncols, tail_pn; const ssq_t* ss; float inv_n, eps;
    __device__ __forceinline__ void done(const Unit& u) const {
        if (u.pn != tail_pn) return;
        const int lane = threadIdx.x & 63, wave = __builtin_amdgcn_readfirstlane(threadIdx.x >> 6), fr = lane & 15, fq = lane >> 4;
        const int row0 = u.pm * BM + wave * 32;
        f32x4 c[2][NB];
#pragma unroll
        for (int rb = 0; rb < 2; ++rb)
#pragma unroll
            for (int nb = 0; nb < NB; ++nb) c[rb][nb] = (f32x4){0.f, 0.f, 0.f, 0.f};
        const bf16_t* ap = A + (size_t)(row0 + fr) * 2048 + 8 * fq; const bf16_t* bp = Bt + (size_t)fr * 2048 + 8 * fq;
#pragma unroll 1
        for (int kc = 0; kc < 64; kc += 8) {
            bf16x8 a0[8], a1[8], bb[NB][8];
#pragma unroll
            for (int j = 0; j < 8; ++j) { a0[j] = *(const bf16x8*)(ap + 32 * (kc + j)); a1[j] = *(const bf16x8*)(ap + 16 * 2048 + 32 * (kc + j));
#pragma unroll
                for (int nb = 0; nb < NB; ++nb) bb[nb][j] = *(const bf16x8*)(bp + (size_t)nb * 16 * 2048 + 32 * (kc + j)); }
#pragma unroll
            for (int j = 0; j < 8; ++j)
#pragma unroll
                for (int nb = 0; nb < NB; ++nb) { c[0][nb] = __builtin_amdgcn_mfma_f32_16x16x32_bf16(a0[j], bb[nb][j], c[0][nb], 0, 0, 0); c[1][nb] = __builtin_amdgcn_mfma_f32_16x16x32_bf16(a1[j], bb[nb][j], c[1][nb], 0, 0, 0); }
        }
        float rsv[2][4];
#pragma unroll
        for (int rb = 0; rb < 2; ++rb)
#pragma unroll
            for (int e = 0; e < 4; ++e) rsv[rb][e] = ss ? __builtin_amdgcn_rsqf(ssq_to_f(ss[row0 + 16 * rb + 4 * fq + e]) * inv_n + eps) : 1.0f;
#pragma unroll
        for (int rb = 0; rb < 2; ++rb)
#pragma unroll
            for (int e = 0; e < 4; ++e) { const int row = row0 + 16 * rb + 4 * fq + e; const float rs = rsv[rb][e];
#pragma unroll
                for (int nb = 0; nb < NB; ++nb) { const int col = 16 * nb + fr; if (col < ncols) out[(size_t)row * ldo + col] = c[rb][nb][e] * rs; } }
    }
};
__device__ __forceinline__ float rnd_am(float f) { if (AMANT >= 7) return f; constexpr int sh = 16 + (7 - AMANT); unsigned u = __builtin_bit_cast(unsigned, f); u = (u + ((1u << (sh - 1)) - 1u) + ((u >> sh) & 1u)) & ~((1u << sh) - 1u); return __builtin_bit_cast(float, u); }
template <int MB> __device__ __forceinline__ float rnd_m(float f) { if (MB >= 7) return f; constexpr int sh = 16 + (7 - (MB >= 7 ? 7 : MB)); unsigned u = __builtin_bit_cast(unsigned, f); u = (u + ((1u << (sh - 1)) - 1u) + ((u >> sh) & 1u)) & ~((1u << sh) - 1u); return __builtin_bit_cast(float, u); }
__device__ __forceinline__ float fast_silu(float x) { return x * __builtin_amdgcn_rcpf(1.0f + __expf(-x)); }
__device__ __forceinline__ float fast_sigmoid(float x) { return __builtin_amdgcn_rcpf(1.0f + __expf(-x)); }

struct Route { unsigned long long off; int ld; int pad; };
struct EpiRoute {
    static constexpr bool PERM = true, AFTER_DRAIN = false;
    unsigned char* ws; const Route* tab;
    float* fbase; int fld, fcols, ftile;
    const ssq_t* ss; float inv_n, eps;
    __device__ __forceinline__ void operator()(const f32x4 (&acc)[2][2][4][2], const Unit& u, int wr, int wc, int fr, int fq) const {
        const int row0 = u.pm * BM + wr * 64 + fr;
        float rs[2][4];
#pragma unroll
        for (int ai = 0; ai < 2; ++ai)
#pragma unroll
            for (int m = 0; m < 4; ++m) rs[ai][m] = ss ? __builtin_amdgcn_rsqf(ssq_to_f(ss[row0 + ai * HALF + m * 16]) * inv_n + eps) : 1.0f;
        if (u.pn == ftile) {
            if (wc == 0) {
#pragma unroll
                for (int ai = 0; ai < 2; ++ai)
#pragma unroll
                    for (int m = 0; m < 4; ++m) { float* rowp = fbase + (size_t)(row0 + ai * HALF + m * 16) * fld;
#pragma unroll
                        for (int n = 0; n < 2; ++n) { const int col = 8 * fq + 4 * n; if (col < fcols) *(f32x4*)(rowp + col) = acc[ai][0][m][n] * rs[ai][m]; } }
            }
            return;
        }
        const Route r = tab[u.pn];
        bf16_t* base = (bf16_t*)(ws + r.off); const int ld = r.ld;
        const int col0 = wc * 32 + 8 * fq;
#pragma unroll
        for (int ai = 0; ai < 2; ++ai)
#pragma unroll
            for (int m = 0; m < 4; ++m) { bf16_t* rowp = base + (size_t)(row0 + ai * HALF + m * 16) * ld + col0;
#pragma unroll
                for (int bj = 0; bj < 2; ++bj) { const f32x4 v0 = acc[ai][bj][m][0] * rs[ai][m], v1 = acc[ai][bj][m][1] * rs[ai][m];
                    u32x4 w; w.x = cvt_pk_bf16(v0[0], v0[1]); w.y = cvt_pk_bf16(v0[2], v0[3]); w.z = cvt_pk_bf16(v1[0], v1[1]); w.w = cvt_pk_bf16(v1[2], v1[3]);
                    *(u32x4*)(rowp + bj * HALF) = w; } }
    }
};

template <bool F32IN, bool COPY = false> struct EpiResidBf {
    static_assert(!F32IN, "the residual stream is read from hb");
    static constexpr bool PERM = true, AFTER_DRAIN = false;
    const float* xin; bf16_t* hb; int ldc; ssq_t* ss; bf16_t* hb5;
    __device__ __forceinline__ void load_half(u32x4 (&w)[4][2], int rbase, int col0) const {
#pragma unroll
        for (int m = 0; m < 4; ++m) { const size_t off = (size_t)(rbase + m * 16) * ldc + col0;
#pragma unroll
            for (int bj = 0; bj < 2; ++bj) w[m][bj] = *(const u32x4*)(hb + off + bj * HALF); }
    }
    __device__ __forceinline__ void store_half(const u32x4 (&w)[4][2], const f32x4 (&acc)[2][4][2], float (&sv)[4], int rbase, int col0) const {
#pragma unroll
        for (int m = 0; m < 4; ++m) { const size_t off = (size_t)(rbase + m * 16) * ldc + col0;
            float s = 0.f;
#pragma unroll
            for (int bj = 0; bj < 2; ++bj) { const u32x4 q = w[m][bj];
                const f32x4 r0 = {__uint_as_float(q.x << 16), __uint_as_float(q.x & 0xffff0000u), __uint_as_float(q.y << 16), __uint_as_float(q.y & 0xffff0000u)};
                const f32x4 r1 = {__uint_as_float(q.z << 16), __uint_as_float(q.z & 0xffff0000u), __uint_as_float(q.w << 16), __uint_as_float(q.w & 0xffff0000u)};
                const f32x4 v0 = r0 + acc[bj][m][0], v1 = r1 + acc[bj][m][1];
                s += (v0[0] * v0[0] + v0[1] * v0[1]) + (v0[2] * v0[2] + v0[3] * v0[3]) + (v1[0] * v1[0] + v1[1] * v1[1]) + (v1[2] * v1[2] + v1[3] * v1[3]);
                u32x4 o; o.x = cvt_pk_bf16(v0[0], v0[1]); o.y = cvt_pk_bf16(v0[2], v0[3]); o.z = cvt_pk_bf16(v1[0], v1[1]); o.w = cvt_pk_bf16(v1[2], v1[3]);
                *(u32x4*)(hb + off + bj * HALF) = o;
                if (COPY) { u32x4 c; c.x = cvt_pk_bf16(rnd_m<XMANT>(v0[0]), rnd_m<XMANT>(v0[1])); c.y = cvt_pk_bf16(rnd_m<XMANT>(v0[2]), rnd_m<XMANT>(v0[3])); c.z = cvt_pk_bf16(rnd_m<XMANT>(v1[0]), rnd_m<XMANT>(v1[1])); c.w = cvt_pk_bf16(rnd_m<XMANT>(v1[2]), rnd_m<XMANT>(v1[3]));
                    *(u32x4*)(hb5 + off + bj * HALF) = c; } }
            s += __shfl_xor(s, 16); s += __shfl_xor(s, 32); sv[m] = s; }
    }
    __device__ __forceinline__ void add_half(const float (&sv)[4], int rbase, int fq) const {
#pragma unroll
        for (int m = 0; m < 4; ++m) if (fq == 0) (void)__hip_atomic_fetch_add(ss + rbase + m * 16, ssq_from_f(sv[m]), __ATOMIC_RELAXED, __HIP_MEMORY_SCOPE_AGENT);
    }
    __device__ __forceinline__ void operator()(const f32x4 (&acc)[2][2][4][2], const Unit& u, int wr, int wc, int fr, int fq) const {
        const int row0 = u.pm * BM + wr * 64 + fr, col0 = u.pn * BM + wc * 32 + 8 * fq;
        u32x4 w0[4][2], w1[4][2]; float s0[4], s1[4];
        load_half(w0, row0, col0);
        store_half(w0, acc[0], s0, row0, col0);
        load_half(w1, row0 + HALF, col0);
        add_half(s0, row0, fq);
        store_half(w1, acc[1], s1, row0 + HALF, col0);
        add_half(s1, row0 + HALF, fq);
    }
};
struct EpiResidOut {
    static constexpr bool PERM = true, AFTER_DRAIN = false;
    const bf16_t* hb; float* out; int ldc;
    __device__ __forceinline__ void operator()(const f32x4 (&acc)[2][2][4][2], const Unit& u, int wr, int wc, int fr, int fq) const {
        const int row0 = u.pm * BM + wr * 64 + fr, col0 = u.pn * BM + wc * 32 + 8 * fq;
#pragma unroll
        for (int ai = 0; ai < 2; ++ai) {
            u32x4 w[4][2];
#pragma unroll
            for (int m = 0; m < 4; ++m) { const size_t off = (size_t)(row0 + ai * HALF + m * 16) * ldc + col0;
#pragma unroll
                for (int bj = 0; bj < 2; ++bj) w[m][bj] = *(const u32x4*)(hb + off + bj * HALF); }
#pragma unroll
            for (int m = 0; m < 4; ++m) { const size_t off = (size_t)(row0 + ai * HALF + m * 16) * ldc + col0;
#pragma unroll
                for (int bj = 0; bj < 2; ++bj) {
                    const f32x4 r0 = {__uint_as_float(w[m][bj].x << 16), __uint_as_float(w[m][bj].x & 0xffff0000u), __uint_as_float(w[m][bj].y << 16), __uint_as_float(w[m][bj].y & 0xffff0000u)};
                    const f32x4 r1 = {__uint_as_float(w[m][bj].z << 16), __uint_as_float(w[m][bj].z & 0xffff0000u), __uint_as_float(w[m][bj].w << 16), __uint_as_float(w[m][bj].w & 0xffff0000u)};
                    *(f32x4*)(out + off + bj * HALF) = r0 + acc[ai][bj][m][0]; *(f32x4*)(out + off + bj * HALF + 4) = r1 + acc[ai][bj][m][1]; } }
        }
    }
};

struct EpiSwiGLU {
    static constexpr bool PERM = true, AFTER_DRAIN = false;
    bf16_t* H; int ldc; const ssq_t* ss; float inv_n, eps;
    __device__ __forceinline__ void operator()(const f32x4 (&acc)[2][2][4][2], const Unit& u, int wr, int wc, int fr, int fq) const {
        const int row0 = u.pm * BM + wr * 64 + fr, col0 = u.pn * HALF + wc * 32 + 8 * fq;
        ssq_t q[2][4];
#pragma unroll
        for (int ai = 0; ai < 2; ++ai)
#pragma unroll
            for (int m = 0; m < 4; ++m) q[ai][m] = ss[row0 + ai * HALF + m * 16];
#pragma unroll
        for (int ai = 0; ai < 2; ++ai)
#pragma unroll
            for (int m = 0; m < 4; ++m) { bf16_t* rowp = H + (size_t)(row0 + ai * HALF + m * 16) * ldc + col0;
                const float rs = __builtin_amdgcn_rsqf(ssq_to_f(q[ai][m]) * inv_n + eps);
                float o[8];
#pragma unroll
                for (int n = 0; n < 2; ++n)
#pragma unroll
                    for (int e = 0; e < 4; ++e) o[4 * n + e] = rnd_m<HMANT>(fast_silu(acc[ai][0][m][n][e] * rs) * (acc[ai][1][m][n][e] * rs));
                u32x4 w; w.x = cvt_pk_bf16(o[0], o[1]); w.y = cvt_pk_bf16(o[2], o[3]); w.z = cvt_pk_bf16(o[4], o[5]); w.w = cvt_pk_bf16(o[6], o[7]);
                *(u32x4*)rowp = w; }
    }
};

struct EpiGLU {
    static constexpr bool PERM = true, AFTER_DRAIN = false;
    const bf16_t* Y; int ldy; bf16_t* O; int ldo; const float* bias;
    __device__ __forceinline__ void operator()(const f32x4 (&acc)[2][2][4][2], const Unit& u, int wr, int wc, int fr, int fq) const {
        const int row0 = u.pm * BM + wr * 64 + fr, col0 = u.pn * BM + wc * 32 + 8 * fq;
        f32x4 bv[2][2];
#pragma unroll
        for (int bj = 0; bj < 2; ++bj)
#pragma unroll
            for (int n = 0; n < 2; ++n) bv[bj][n] = *(const f32x4*)(bias + col0 + bj * HALF + 4 * n);
#pragma unroll
        for (int ai = 0; ai < 2; ++ai) {
          u32x4 yy[4][2];
#pragma unroll
          for (int m = 0; m < 4; ++m)
#pragma unroll
              for (int bj = 0; bj < 2; ++bj) yy[m][bj] = *(const u32x4*)(Y + (size_t)(row0 + ai * HALF + m * 16) * ldy + col0 + bj * HALF);
#pragma unroll
            for (int m = 0; m < 4; ++m) { const size_t r = (size_t)(row0 + ai * HALF + m * 16);
#pragma unroll
                for (int bj = 0; bj < 2; ++bj) { const u32x4 yv = yy[m][bj];
                    const f32x4 g0 = acc[ai][bj][m][0] + bv[bj][0], g1 = acc[ai][bj][m][1] + bv[bj][1];
                    float o[8];
                    o[0] = __uint_as_float(yv.x << 16) * fast_sigmoid(g0[0]); o[1] = __uint_as_float(yv.x & 0xffff0000u) * fast_sigmoid(g0[1]);
                    o[2] = __uint_as_float(yv.y << 16) * fast_sigmoid(g0[2]); o[3] = __uint_as_float(yv.y & 0xffff0000u) * fast_sigmoid(g0[3]);
                    o[4] = __uint_as_float(yv.z << 16) * fast_sigmoid(g1[0]); o[5] = __uint_as_float(yv.z & 0xffff0000u) * fast_sigmoid(g1[1]);
                    o[6] = __uint_as_float(yv.w << 16) * fast_sigmoid(g1[2]); o[7] = __uint_as_float(yv.w & 0xffff0000u) * fast_sigmoid(g1[3]);
                    u32x4 w; w.x = cvt_pk_bf16(o[0], o[1]); w.y = cvt_pk_bf16(o[2], o[3]); w.z = cvt_pk_bf16(o[4], o[5]); w.w = cvt_pk_bf16(o[6], o[7]);
                    *(u32x4*)(O + r * ldo + col0 + bj * HALF) = w; } }
        }
    }
};
template <class Epi, class Sched, bool ALIGN_EPI = false, bool SP2 = false>
__device__ __forceinline__ void gemm_phase(PG8_LAS unsigned char* lds, const Gemm g, const Sched& S, const Epi& E) {
    const int tid = threadIdx.x, wid = __builtin_amdgcn_readfirstlane(tid >> 6), lane = tid & 63, wr = wid >> 2, wc = wid & 3, fr = lane & 15, fq = lane >> 4;
    const int K = g.K, nt = K / BK;
    unsigned voffA[2], voffB[2];
#pragma unroll
    for (int i = 0; i < 2; ++i) { int R, C; stage_rc(tid * 16 + i * 8192, R, C); const int Rb = Epi::PERM ? ((R & ~31) + perm32(R & 31)) : R;
        voffA[i] = (unsigned)(R * K + C) * 2u; voffB[i] = (unsigned)(Rb * K + C) * 2u; }
    const size_t kstep = (size_t)(BK * 2);
    const size_t hstep = (size_t)HALF * K * 2;
    const size_t tstep = 2 * hstep;
    const unsigned ldsw = (unsigned)wid * 1024u;
    const int aoff = lds_byte(wr * 64 + fr, fq * 8), boff = lds_byte(wc * 32 + fr, fq * 8);
#define PG8_SA(b, h) (((b) * 2 + (h)) * HTB)
#define PG8_SB(b, h) ((4 + (b) * 2 + (h)) * HTB)
#define PG8_STAGE(bufoff, gbase, voff) do { _Pragma("unroll") for (int _i = 0; _i < 2; ++_i) \
        __builtin_amdgcn_global_load_lds((const unsigned*)((const char*)(gbase) + (voff)[_i]), (PG8_LAS unsigned*)(lds + (bufoff) + ldsw + _i * 8192), 16, 0, 0); } while (0)
#define PG8_LDA(dst, b, h) do { _Pragma("unroll") for (int m = 0; m < 4; ++m) _Pragma("unroll") for (int k = 0; k < 2; ++k) dst[m][k] = *(const PG8_LAS bf16x8*)(lds + PG8_SA(b, h) + aoff + m * 2048 + k * 1024); } while (0)
#define PG8_LDB(dst, b, h) do { _Pragma("unroll") for (int n = 0; n < 2; ++n) _Pragma("unroll") for (int k = 0; k < 2; ++k) dst[n][k] = *(const PG8_LAS bf16x8*)(lds + PG8_SB(b, h) + boff + n * 2048 + k * 1024); } while (0)
#define PG8_MMA(ai, bj, At, Bt) do { __builtin_amdgcn_s_setprio(1); _Pragma("unroll") for (int m = 0; m < 4; ++m) _Pragma("unroll") for (int n = 0; n < 2; ++n) _Pragma("unroll") for (int k = 0; k < 2; ++k) \
        acc[ai][bj][m][n] = __builtin_amdgcn_mfma_f32_16x16x32_bf16(Bt[n][k], At[m][k], acc[ai][bj][m][n], 0, 0, 0); __builtin_amdgcn_s_setprio(0); } while (0)
#define PG8_WAIT_V(n) asm volatile("s_waitcnt vmcnt(" #n ")" ::: "memory")
#define PG8_WAIT_L(n) asm volatile("s_waitcnt lgkmcnt(" #n ")" ::: "memory")
#define PG8_BAR __builtin_amdgcn_s_barrier()
#define PG8_SCHED __builtin_amdgcn_sched_barrier(0)
    Unit cur, nxt; int ui = 0;
    if (!S.next(0, cur)) return;
    f32x4 acc[2][2][4][2];
#pragma unroll
    for (int a = 0; a < 2; ++a)
#pragma unroll
        for (int b = 0; b < 2; ++b)
#pragma unroll
            for (int m = 0; m < 4; ++m)
#pragma unroll
                for (int n = 0; n < 2; ++n) acc[a][b][m][n] = (f32x4){0.f, 0.f, 0.f, 0.f};
    bf16x8 At[4][2], B0[2][2], B1[2][2];
    const char* cA = (const char*)g.A + (size_t)cur.pm * tstep; const char* cB = (const char*)g.Bt + (size_t)cur.pn * tstep;
    S.a_ready(cur);
    if constexpr (SP2) {
        PG8_STAGE(PG8_SB(0, 0), cB, voffB); PG8_STAGE(PG8_SB(0, 1), cB + hstep, voffB); PG8_STAGE(PG8_SA(0, 0), cA, voffA); PG8_STAGE(PG8_SA(0, 1), cA + hstep, voffA);
        if (wr == 1) PG8_BAR;
        PG8_WAIT_V(2); PG8_BAR;
        PG8_STAGE(PG8_SB(1, 0), cB + kstep, voffB); PG8_STAGE(PG8_SA(1, 0), cA + kstep, voffA); PG8_STAGE(PG8_SB(1, 1), cB + hstep + kstep, voffB);
        PG8_WAIT_V(6); PG8_BAR;
    } else {
        PG8_STAGE(PG8_SB(0, 0), cB, voffB); PG8_STAGE(PG8_SA(0, 0), cA, voffA); PG8_STAGE(PG8_SB(0, 1), cB + hstep, voffB); PG8_STAGE(PG8_SA(0, 1), cA + hstep, voffA);
        if (wr == 1) PG8_BAR;
        PG8_WAIT_V(4); PG8_BAR;
        PG8_STAGE(PG8_SB(1, 0), cB + kstep, voffB); PG8_STAGE(PG8_SA(1, 0), cA + kstep, voffA); PG8_STAGE(PG8_SB(1, 1), cB + hstep + kstep, voffB);
        PG8_WAIT_V(6); PG8_BAR;
    }
    for (;;) {
        const bool has_next = S.next(ui + 1, nxt);
        const char* nA = has_next ? (const char*)g.A + (size_t)nxt.pm * tstep : cA; const char* nB = has_next ? (const char*)g.Bt + (size_t)nxt.pn * tstep : cB;
        for (int t = 0; t < nt; t += 2) {
            const bool last = (t == nt - 2);
            const char* a1 = cA + (size_t)(t + 1) * kstep;
            const char* a2 = last ? nA : cA + (size_t)(t + 2) * kstep; const char* b2 = last ? nB : cB + (size_t)(t + 2) * kstep;
            const char* a3 = a2 + kstep; const char* b3 = b2 + kstep;
            if (last && has_next) S.a_ready(nxt);
            if constexpr (SP2) {
            PG8_LDB(B0, 0, 0); PG8_LDB(B1, 0, 1); PG8_SCHED; PG8_LDA(At, 0, 0); PG8_STAGE(PG8_SA(1, 1), a1 + hstep, voffA);
            PG8_WAIT_V(8); PG8_WAIT_L(0); PG8_BAR; PG8_MMA(0, 0, At, B0); PG8_MMA(0, 1, At, B1); PG8_BAR; PG8_SCHED;
            PG8_LDA(At, 0, 1); PG8_STAGE(PG8_SB(0, 0), b2, voffB); PG8_STAGE(PG8_SB(0, 1), b2 + hstep, voffB); PG8_STAGE(PG8_SA(0, 0), a2, voffA);
            PG8_WAIT_V(8); PG8_WAIT_L(0); PG8_BAR; PG8_MMA(1, 0, At, B0); PG8_MMA(1, 1, At, B1); PG8_BAR; PG8_SCHED;
            PG8_LDB(B0, 1, 0); PG8_LDB(B1, 1, 1); PG8_SCHED; PG8_LDA(At, 1, 0); PG8_STAGE(PG8_SA(0, 1), a2 + hstep, voffA);
            PG8_WAIT_V(8); PG8_WAIT_L(0); PG8_BAR; PG8_MMA(0, 0, At, B0); PG8_MMA(0, 1, At, B1); PG8_BAR; PG8_SCHED;
            PG8_LDA(At, 1, 1); PG8_STAGE(PG8_SB(1, 0), b3, voffB); PG8_STAGE(PG8_SB(1, 1), b3 + hstep, voffB); PG8_STAGE(PG8_SA(1, 0), a3, voffA);
            PG8_WAIT_V(8); PG8_WAIT_L(0); PG8_BAR; PG8_MMA(1, 0, At, B0); PG8_MMA(1, 1, At, B1); PG8_BAR; PG8_SCHED;
            } else {
            PG8_LDB(B0, 0, 0); PG8_SCHED; PG8_LDA(At, 0, 0); PG8_STAGE(PG8_SA(1, 1), a1 + hstep, voffA);
            PG8_WAIT_L(8); PG8_BAR; PG8_WAIT_L(0); PG8_MMA(0, 0, At, B0); PG8_BAR; PG8_SCHED;
            PG8_LDB(B1, 0, 1); PG8_STAGE(PG8_SB(0, 0), b2, voffB);
            PG8_BAR; PG8_WAIT_L(0); PG8_MMA(0, 1, At, B1); PG8_BAR;
            PG8_LDA(At, 0, 1); PG8_STAGE(PG8_SA(0, 0), a2, voffA);
            PG8_BAR; PG8_WAIT_L(0); PG8_MMA(1, 0, At, B0); PG8_BAR; PG8_SCHED;
            PG8_STAGE(PG8_SB(0, 1), b2 + hstep, voffB);
            PG8_WAIT_V(6); PG8_BAR; PG8_MMA(1, 1, At, B1); PG8_BAR;
            PG8_LDB(B0, 1, 0); PG8_SCHED; PG8_LDA(At, 1, 0); PG8_STAGE(PG8_SA(0, 1), a2 + hstep, voffA);
            PG8_WAIT_L(8); PG8_BAR; PG8_WAIT_L(0); PG8_MMA(0, 0, At, B0); PG8_BAR; PG8_SCHED;
            PG8_LDB(B1, 1, 1); PG8_STAGE(PG8_SB(1, 0), b3, voffB);
            PG8_BAR; PG8_WAIT_L(0); PG8_MMA(0, 1, At, B1); PG8_BAR;
            PG8_LDA(At, 1, 1); PG8_STAGE(PG8_SA(1, 0), a3, voffA);
            PG8_BAR; PG8_WAIT_L(0); PG8_MMA(1, 0, At, B0); PG8_BAR; PG8_SCHED;
            PG8_STAGE(PG8_SB(1, 1), b3 + hstep, voffB);
            PG8_WAIT_V(6); PG8_BAR; PG8_MMA(1, 1, At, B1); PG8_BAR;
            }
        }
        if constexpr (ALIGN_EPI) { if (wr == 0) PG8_BAR; }
        if constexpr (!Epi::AFTER_DRAIN) { E(acc, cur, wr, wc, fr, fq); S.done(cur); }
        if (!has_next) break;
#pragma unroll
        for (int a = 0; a < 2; ++a)
#pragma unroll
            for (int b = 0; b < 2; ++b)
#pragma unroll
                for (int m = 0; m < 4; ++m)
#pragma unroll
                    for (int n = 0; n < 2; ++n) acc[a][b][m][n] = (f32x4){0.f, 0.f, 0.f, 0.f};
        cur = nxt; cA = nA; cB = nB; ++ui;
        if constexpr (ALIGN_EPI) { if (wr == 1) PG8_BAR; }
    }
    PG8_WAIT_V(0);
    if constexpr (!ALIGN_EPI) { if (wr == 0) PG8_BAR; }
    PG8_BAR;
    if constexpr (Epi::AFTER_DRAIN) { E.fused(acc, cur, wr, wc, fr, fq, lds, wid, lane); S.done(cur); }
#undef PG8_SA
#undef PG8_SB
#undef PG8_STAGE
#undef PG8_LDA
#undef PG8_LDB
#undef PG8_MMA
#undef PG8_WAIT_V
#undef PG8_WAIT_L
#undef PG8_BAR
#undef PG8_SCHED
}
}

constexpr int NWAVES = 8;
constexpr int D = 2048, BATCH = 8, SEQ = 4096, M = BATCH * SEQ, FF = 5632;
constexpr int N_IN0 = 4632, N_IN1 = 4624, N_INP = 4640, N_MAIN = 4608;
constexpr float RMS_EPS = 1e-6f;
constexpr int NPHASE = 18;

constexpr size_t MiB = 1u << 20;
constexpr size_t WS_CTL = 0, CTL_ZERO_BYTES = 1 * MiB;
constexpr size_t WS_TAB = 1 * MiB;
constexpr size_t WS_WIN0 = 8 * MiB, WS_WOUT0 = 27 * MiB, WS_W13_0 = 35 * MiB, WS_W2_0 = 79 * MiB;
constexpr size_t WS_WIN1 = 101 * MiB, WS_WOUT1 = 120 * MiB, WS_W13_1 = 128 * MiB, WS_W2_1 = 172 * MiB, WS_GLUW = 194 * MiB;
constexpr size_t WS_A = 200 * MiB;
constexpr size_t WS_B = 360 * MiB;
constexpr size_t WS_U = WS_B, WS_Z = WS_B + 32 * MiB, WS_XBC = WS_B + 128 * MiB, WS_DT = WS_B + 288 * MiB, WS_YPRE = WS_B + 292 * MiB, WS_YSSD = WS_XBC;
constexpr size_t WS_Q = WS_B, WS_K = WS_B + 64 * MiB, WS_V = WS_B + 80 * MiB, WS_QD = WS_B + 96 * MiB, WS_KD = WS_B + 128 * MiB, WS_VD = WS_B + 160 * MiB,
                 WS_GOUT = WS_B + 224 * MiB, WS_GLR = WS_B + 288 * MiB, WS_GLAO = WS_B + 292 * MiB;
constexpr size_t WS_QT = 328 * MiB;
constexpr size_t WS_KTT = WS_B + 356 * MiB, WS_ATT = WS_B + 388 * MiB, WS_DEC = WS_B + 404 * MiB;
constexpr size_t WS_H = WS_B;
constexpr size_t WS_HB = 768 * MiB;
constexpr size_t WS_HB5 = 896 * MiB;
constexpr size_t WS_END = (XMANT < 7 ? 1024 : 896) * MiB;
constexpr int CW_BAR = 4096;
constexpr size_t WS_SS = 131072;
constexpr size_t WS_SS0 = 8 * MiB - 262144;
constexpr size_t TAB_TOEP = 0, TAB_QM = 4 * MiB, TAB_ABARD = 6 * MiB, TAB_BTD = 6 * MiB + 65536, TAB_A16 = 6 * MiB + 65536 + 524288;
constexpr size_t WS_PM = 195 * MiB;
constexpr size_t WS_POW = 198 * MiB;

constexpr int RING_OFF = 0, RING_BYTES = 131072;
constexpr int LDS_BYTES = 147456;
constexpr int MISC_OFF = LDS_BYTES - 1024;
constexpr int PT_OFF = MISC_OFF + 512;

#define GAS __attribute__((address_space(1)))
#define LAS __attribute__((address_space(3)))
typedef unsigned short bf16;
typedef unsigned v4u __attribute__((ext_vector_type(4)));
typedef unsigned v2u __attribute__((ext_vector_type(2)));
typedef float f32x4 __attribute__((ext_vector_type(4)));
typedef float f32x2 __attribute__((ext_vector_type(2)));
typedef GAS unsigned gu32;
#define RLX_AGENT __ATOMIC_RELAXED, __HIP_MEMORY_SCOPE_AGENT
#define LDS_WAIT() asm volatile("s_waitcnt lgkmcnt(0)" ::: "memory")
#define VM_WAIT() asm volatile("s_waitcnt vmcnt(0)" ::: "memory")
#define DI __device__ __forceinline__
#define BAR_LDS() do { asm volatile("s_waitcnt lgkmcnt(0)" ::: "memory"); __builtin_amdgcn_s_barrier(); asm volatile("" ::: "memory"); } while (0)
DI unsigned f2bf(float f) { unsigned u = __builtin_bit_cast(unsigned, f); return (u + 0x7fffu + ((u >> 16) & 1u)) >> 16; }
DI unsigned pk2(float lo, float hi) { return f2bf(lo) | (f2bf(hi) << 16); }
typedef __bf16 bf16x2_t __attribute__((ext_vector_type(2)));
DI unsigned cvtpk(float lo, float hi) { const f32x2 v = {lo, hi}; const bf16x2_t b = __builtin_convertvector(v, bf16x2_t); return __builtin_bit_cast(unsigned, b); }
DI float bflo(unsigned w) { return __uint_as_float(w << 16); }
DI float bfhi(unsigned w) { return __uint_as_float(w & 0xffff0000u); }
DI float bf2f(bf16 b) { return __uint_as_float((unsigned)b << 16); }
DI float wave_sum(float v) {
#pragma unroll
    for (int o = 1; o < 64; o <<= 1) v += __shfl_xor(v, o);
    return v;
}
DI float wave_max(float v) {
#pragma unroll
    for (int o = 1; o < 64; o <<= 1) v = fmaxf(v, __shfl_xor(v, o));
    return v;
}
DI float silu_f(float x) { return x * __builtin_amdgcn_rcpf(1.0f + __expf(-x)); }
DI float gelu_tanh_f(float x) { const float z = 0.7978845608028654f * (x + 0.044715f * x * x * x); const float t = 1.0f - 2.0f * __builtin_amdgcn_rcpf(__expf(2.0f * z) + 1.0f); return 0.5f * x * (1.0f + t); }
DI float softplus_f(float x) { const float e = __expf(-fabsf(x)); const float l = e < 0.01f ? e * (1.0f - e * (0.5f - e * 0.33333333f)) : __logf(1.0f + e); return fmaxf(x, 0.f) + l; }

typedef short v4i16_t __attribute__((ext_vector_type(4)));
DI v2u tr16(const LAS bf16* p) { return __builtin_bit_cast(v2u, __builtin_amdgcn_ds_read_tr16_b64_v4i16((LAS v4i16_t*)p)); }
struct InTab { const LAS unsigned long long* t;
    DI const float* operator[](int i) const { const unsigned long long v = t[i];
        const unsigned lo = __builtin_amdgcn_readfirstlane((unsigned)v), hi = __builtin_amdgcn_readfirstlane((unsigned)(v >> 32));
        return (const float*)(const GAS float*)(((unsigned long long)hi << 32) | lo); } };
#define XB_TMO      128
#define XB_XCNT(j)  (256  + 64 * (j))
#define XB_XSUB(j)  (1280 + 64 * (j))
#define XB_XGEN(j)  (2304 + 64 * (j))
#define XB_TOP      3328
#define XB_TOPGEN   3392
#define XCD_BAR_WORDS 3456
#define XB_SPIN_CAP (1u << 18)

__device__ __forceinline__ unsigned xb_ld(unsigned* p)              { return __hip_atomic_load(p, __ATOMIC_RELAXED, __HIP_MEMORY_SCOPE_AGENT); }
__device__ __forceinline__ unsigned xb_add(unsigned* p, unsigned v) { return __hip_atomic_fetch_add(p, v, __ATOMIC_RELAXED, __HIP_MEMORY_SCOPE_AGENT); }
__device__ __forceinline__ unsigned xb_xcc_id() { return (unsigned)__builtin_amdgcn_s_getreg((3 << 11) | 20) & 0xFu; }
#define XB_SPIN(cond, bar) do { unsigned _sp = 0; while (cond) { __builtin_amdgcn_s_sleep(1); \
    if ((++_sp & 255u) == 0u) { if (xb_ld(&(bar)[XB_TMO])) break; if (_sp > XB_SPIN_CAP) { atomicAdd(&(bar)[XB_TMO], 1u); break; } } } } while (0)

struct XcdBarrier {
    unsigned* bar; unsigned x;
    volatile LAS unsigned* st;
};

__device__ __forceinline__ XcdBarrier xcd_barrier_post(unsigned* bar, volatile LAS unsigned* st) {
    XcdBarrier b; b.bar = bar; b.x = xb_xcc_id(); b.st = st;
    if (threadIdx.x == 0) (void)xb_add(&bar[XB_XCNT(b.x)], 1u);
    return b;
}
__device__ __forceinline__ void xcd_barrier_complete(unsigned* bar, unsigned x, unsigned& nloc, unsigned& nx) {
    const unsigned G = gridDim.x * gridDim.y * gridDim.z;
    unsigned sum, cnt, mine, sp = 0u;
    for (;;) {
        sum = 0u; cnt = 0u; mine = 0u;
#pragma unroll
        for (unsigned j = 0; j < 16; ++j) { const unsigned c = xb_ld(&bar[XB_XCNT(j)]); sum += c; cnt += (c > 0u) ? 1u : 0u; mine = (j == x) ? c : mine; }
        if (sum == G) break;
        __builtin_amdgcn_s_sleep(1);
        if ((++sp & 255u) == 0u) { if (xb_ld(&bar[XB_TMO])) break; if (sp > XB_SPIN_CAP) { atomicAdd(&bar[XB_TMO], 1u); break; } }
    }
    nloc = mine > 0u ? mine : 1u; nx = cnt > 0u ? cnt : 1u;
}

__device__ __forceinline__ void xcd_barrier(const XcdBarrier& b) {
    asm volatile("s_waitcnt vmcnt(0)" ::: "memory");
    __syncthreads();
    if (threadIdx.x == 0) {
        unsigned* bar = b.bar;
        __builtin_amdgcn_s_waitcnt(0);
        unsigned nloc = b.st[0], nx = b.st[1];
        if (nloc == 0u) { xcd_barrier_complete(bar, b.x, nloc, nx); b.st[0] = nloc; b.st[1] = nx; }
        const unsigned old = xb_add(&bar[XB_XSUB(b.x)], 1u);
        const unsigned gen = old / nloc;
        if (old + 1u == (gen + 1u) * nloc) {
            __builtin_amdgcn_fence(__ATOMIC_RELEASE, "agent");
            asm volatile("s_waitcnt vmcnt(0)" ::: "memory");
            const unsigned og = xb_add(&bar[XB_TOP], 1u);
            const unsigned tg = og / nx;
            if (og + 1u == (tg + 1u) * nx) xb_add(&bar[XB_TOPGEN], 1u);
            else XB_SPIN(xb_ld(&bar[XB_TOPGEN]) == tg, bar);
            __builtin_amdgcn_fence(__ATOMIC_ACQUIRE, "agent");
            xb_add(&bar[XB_XGEN(b.x)], 1u);
            asm volatile("s_waitcnt vmcnt(0)" ::: "memory");
        } else {
            XB_SPIN(xb_ld(&bar[XB_XGEN(b.x)]) == gen, bar);
            __builtin_amdgcn_fence(__ATOMIC_ACQUIRE, "agent");
            asm volatile("s_waitcnt vmcnt(0)" ::: "memory");
        }
    }
    __syncthreads();
}

template <int MB> DI unsigned f2bfm(float f) { constexpr int sh = 16 + (7 - MB); unsigned u = __builtin_bit_cast(unsigned, f); u = (u + ((1u << (sh - 1)) - 1u) + ((u >> sh) & 1u)) & ~((1u << sh) - 1u); return u >> 16; }
template <int MB> DI unsigned pk2m(float lo, float hi) { return f2bfm<MB>(lo) | (f2bfm<MB>(hi) << 16); }
template <int MB = 7> DI void transpose_item(const float* W, int K, int N, bf16* WT, int mode, LAS float* scr, int item, int nblk, int lane, const float* gain = nullptr) {
    const int kb = item / nblk, nb = item % nblk, k0 = 64 * kb, n0 = 32 * nb;
    const int nn = n0 + (lane & 31); const bool ok = nn < N;
    float wv[32];
#pragma unroll
    for (int i = 0; i < 32; ++i) { const int kk = 2 * i + (lane >> 5); wv[i] = ok ? W[(size_t)(k0 + kk) * N + nn] : 0.f; }
    if (gain) {
#pragma unroll
        for (int i = 0; i < 32; ++i) wv[i] *= gain[k0 + 2 * i + (lane >> 5)]; }
#pragma unroll
    for (int i = 0; i < 32; ++i) scr[(2 * i + (lane >> 5)) * 33 + (lane & 31)] = wv[i];
    LDS_WAIT(); asm volatile("" ::: "memory");
    const int c = lane & 7;
    const int drow0 = (mode == 0) ? n0 : (256 * (n0 >> 7) + (n0 & 127) + (mode == 2 ? 128 : 0));
#pragma unroll
    for (int j = 0; j < 4; ++j) { const int n = (lane >> 3) + 8 * j; const LAS float* s = scr + (8 * c) * 33 + n;
        v4u o; o.x = pk2m<MB>(s[0 * 33], s[1 * 33]); o.y = pk2m<MB>(s[2 * 33], s[3 * 33]); o.z = pk2m<MB>(s[4 * 33], s[5 * 33]); o.w = pk2m<MB>(s[6 * 33], s[7 * 33]);
        *(v4u*)(WT + (size_t)(drow0 + n) * K + k0 + 8 * c) = o; }
    LDS_WAIT(); asm volatile("" ::: "memory");
}
DI void prologue(const InTab in, unsigned char* ws, LAS unsigned char* lds, int gw, int NGW, int lane, int wave) {
    LAS float* scr = (LAS float*)(lds + RING_OFF + wave * 16384);
    constexpr int I_IN = (D / 64) * (N_INP / 32), I_OUT = (D / 64) * (D / 32), I_W1 = (D / 64) * (FF / 32), I_W2 = (FF / 64) * (D / 32), I_GLU = (512 / 64) * (512 / 32);
    constexpr int I_LAYER = I_IN + I_OUT + 2 * I_W1 + I_W2;
    constexpr int NITEMS = 2 * I_LAYER + I_GLU;
    for (int it = gw; it < NITEMS; it += NGW) {
        int r = it;
        if (r >= 2 * I_LAYER) { r -= 2 * I_LAYER; transpose_item(in[11], 512, 512, (bf16*)(ws + WS_GLUW), 0, scr, r, 512 / 32, lane); continue; }
        const int layer = r >= I_LAYER; if (layer) r -= I_LAYER;
        const float* win = layer ? in[25] : in[2]; const float* wout = layer ? in[32] : in[19];
        const float* w1 = layer ? in[34] : in[21]; const float* w3 = layer ? in[35] : in[22]; const float* w2 = layer ? in[36] : in[23];
        const float* gmix = layer ? in[24] : in[1]; const float* gffn = layer ? in[33] : in[20];
        bf16* WIN = (bf16*)(ws + (layer ? WS_WIN1 : WS_WIN0)); bf16* WOUT = (bf16*)(ws + (layer ? WS_WOUT1 : WS_WOUT0));
        bf16* W13 = (bf16*)(ws + (layer ? WS_W13_1 : WS_W13_0)); bf16* W2 = (bf16*)(ws + (layer ? WS_W2_1 : WS_W2_0));
        if (r < I_IN) { transpose_item<WM_IN>(win, D, layer ? N_IN1 : N_IN0, WIN, 0, scr, r, N_INP / 32, lane, gmix); continue; } r -= I_IN;
        if (r < I_OUT) { transpose_item<WM_OUT>(wout, D, D, WOUT, 0, scr, r, D / 32, lane); continue; } r -= I_OUT;
        if (r < I_W1) { transpose_item<WM_FFN>(w1, D, FF, W13, 1, scr, r, FF / 32, lane, gffn); continue; } r -= I_W1;
        if (r < I_W1) { transpose_item<WM_FFN>(w3, D, FF, W13, 2, scr, r, FF / 32, lane, gffn); continue; } r -= I_W1;
        transpose_item<WM_FFN>(w2, FF, D, W2, 0, scr, r, D / 32, lane);
    }
}
DI void s5_tables(const InTab in, unsigned char* ws, int gt) {
    if (gt >= 32 * 64) return;
    const int g = gt >> 6;
    const double are = (double)in[3][gt], aim = (double)in[4][gt], dt = exp((double)in[5][g]);
    const double mag = exp(are * dt), abr = mag * cos(aim * dt), abi = mag * sin(aim * dt);
    const double er = abr - 1.0, ei = abi, den = are * are + aim * aim;
    const double cr = (er * are + ei * aim) / den, ci = (ei * are - er * aim) / den;
    double* ABARD = (double*)(ws + WS_TAB + TAB_ABARD); double* BTD = (double*)(ws + WS_TAB + TAB_BTD); float* A16 = (float*)(ws + WS_TAB + TAB_A16);
    ABARD[gt * 2] = abr; ABARD[gt * 2 + 1] = abi;
    { double* POW = (double*)(ws + WS_POW) + (size_t)gt * 34; double qr = 1.0, qi = 0.0; POW[0] = 1.0; POW[1] = 0.0;
      for (int p = 1; p <= 16; ++p) { const double nr = qr * abr - qi * abi, ni = qr * abi + qi * abr; qr = nr; qi = ni; POW[2 * p] = qr; POW[2 * p + 1] = qi; } }
    double pr = abr, pi = abi;
#pragma unroll
    for (int i = 0; i < 4; ++i) { const double nr = pr * pr - pi * pi, ni = 2.0 * pr * pi; pr = nr; pi = ni; }
    A16[gt * 2] = (float)pr; A16[gt * 2 + 1] = (float)pi;
    for (int c = 0; c < 16; ++c) { const double br = (double)in[6][gt * 16 + c], bi = (double)in[7][gt * 16 + c];
        BTD[(gt * 16 + c) * 2] = cr * br - ci * bi; BTD[(gt * 16 + c) * 2 + 1] = cr * bi + ci * br; }
}
DI void cpow(double ar, double ai, int p, double& pr, double& pi) { pr = 1.0; pi = 0.0; for (int i = 0; i < p; ++i) { const double nr = pr * ar - pi * ai, ni = pr * ai + pi * ar; pr = nr; pi = ni; } }
DI void s5_tables2(const InTab in, unsigned char* ws, LAS unsigned char* lds, int bx, int G, int tid) {
    bf16* TOEP = (bf16*)(ws + WS_TAB + TAB_TOEP); bf16* QM = (bf16*)(ws + WS_TAB + TAB_QM); bf16* PM = (bf16*)(ws + WS_PM);
    LAS double* POW = (LAS double*)(lds + RING_OFF);
    LAS double* BTD = POW + 64 * 34;
    LAS float* Crl = (LAS float*)(BTD + 64 * 32);
    LAS float* Cil = Crl + 16 * 64;
    for (int gi = bx; gi < 32 * 8; gi += G) {
        const int g = gi >> 3, idx = (gi & 7) * 512 + tid;
        __syncthreads();
        { const v4u* s0 = (const v4u*)((const double*)(ws + WS_POW) + (size_t)g * 64 * 34); LAS v4u* d0 = (LAS v4u*)POW;
          for (int k = tid; k < 64 * 34 * 8 / 16; k += 512) d0[k] = s0[k];
          const v4u* s1 = (const v4u*)((const double*)(ws + WS_TAB + TAB_BTD) + (size_t)g * 64 * 32); LAS v4u* d1 = (LAS v4u*)BTD;
          for (int k = tid; k < 64 * 32 * 8 / 16; k += 512) d1[k] = s1[k];
          if (tid < 256) ((LAS v4u*)Crl)[tid] = ((const v4u*)(in[8] + (size_t)g * 16 * 64))[tid];
          else ((LAS v4u*)Cil)[tid - 256] = ((const v4u*)(in[9] + (size_t)g * 16 * 64))[tid - 256]; }
        __syncthreads();
        {   const int d = idx >> 8, cp = (idx >> 4) & 15, c = idx & 15;
            double sum = 0.0;
            for (int n = 0; n < 64; ++n) { const double pr = POW[n * 34 + 2 * d], pi = POW[n * 34 + 2 * d + 1];
                const double br = BTD[(n * 16 + c) * 2], bi = BTD[(n * 16 + c) * 2 + 1], xr = pr * br - pi * bi, xi = pr * bi + pi * br;
                sum += (double)Crl[cp * 64 + n] * xr - (double)Cil[cp * 64 + n] * xi; }
            if (d == 0 && cp == c) sum += (double)in[10][g * 16 + c];
            const bf16 v = (bf16)f2bf((float)sum);
            for (int s = 0; s + d < 16; ++s) { const int j = s + d;
                TOEP[((size_t)(g * 256 + 16 * j + cp)) * 256 + 16 * s + c] = v;
                if (d > 0) TOEP[((size_t)(g * 256 + 16 * s + cp)) * 256 + 16 * j + c] = (bf16)0; } }
        {   const int np = (idx >> 5) & 127, s = (idx >> 1) & 15, half = idx & 1, n = np & 63;
            const double pr = POW[n * 34 + 2 * (15 - s)], pi = POW[n * 34 + 2 * (15 - s) + 1];
            float v[8];
#pragma unroll
            for (int e = 0; e < 8; ++e) { const int c = half * 8 + e; const double br = BTD[(n * 16 + c) * 2], bi = BTD[(n * 16 + c) * 2 + 1];
                v[e] = (float)((np < 64) ? (pr * br - pi * bi) : (pr * bi + pi * br)); }
            v4u o; o.x = pk2(v[0], v[1]); o.y = pk2(v[2], v[3]); o.z = pk2(v[4], v[5]); o.w = pk2(v[6], v[7]);
            *(v4u*)(QM + ((size_t)(g * 128 + np)) * 256 + 16 * s + 8 * half) = o; }
        {   const int j = idx >> 8, cp = (idx >> 4) & 15, o8 = idx & 15;
            float v[8];
#pragma unroll
            for (int e = 0; e < 8; ++e) { const int kp = o8 * 8 + e, n = kp & 63; const double pr = POW[n * 34 + 2 * (j + 1)], pi = POW[n * 34 + 2 * (j + 1) + 1];
                const double cr = (double)Crl[cp * 64 + n], ci = (double)Cil[cp * 64 + n];
                v[e] = (float)((kp < 64) ? (cr * pr - ci * pi) : -(cr * pi + ci * pr)); }
            v4u o; o.x = pk2(v[0], v[1]); o.y = pk2(v[2], v[3]); o.z = pk2(v[4], v[5]); o.w = pk2(v[6], v[7]);
            *(v4u*)(PM + ((size_t)(g * 256 + 16 * j + cp)) * 128 + o8 * 8) = o; }
    }
}
DI void x_to_hb_phase(const float* x, bf16* HB, pg8::ssq_t* ss, int gw, int NGW, int lane) {
    for (int m = gw; m < M; m += NGW) {
        const f32x4* xr = (const f32x4*)(x + (size_t)m * D) + lane;
        f32x4 v[8]; float s = 0.f;
#pragma unroll
        for (int j = 0; j < 8; ++j) { v[j] = xr[64 * j]; s += (v[j].x * v[j].x + v[j].y * v[j].y) + (v[j].z * v[j].z + v[j].w * v[j].w); }
        s = wave_sum(s);
        v2u* o8 = (v2u*)(HB + (size_t)m * D) + lane;
#pragma unroll
        for (int j = 0; j < 8; ++j) { v2u w; w.x = cvtpk(pg8::rnd_am(v[j].x), pg8::rnd_am(v[j].y)); w.y = cvtpk(pg8::rnd_am(v[j].z), pg8::rnd_am(v[j].w)); o8[64 * j] = w; }
        if (lane == 0) ss[m] = pg8::ssq_from_f(s);
    }
}

DI void s5_fast(const InTab in, unsigned char* ws, LAS unsigned char* lds, int u0, int u1, int ustep, int tid, int lane, int wave) {
    typedef short bf16x8 __attribute__((ext_vector_type(8)));
    const bf16* U = (const bf16*)(ws + WS_U); bf16* YPRE = (bf16*)(ws + WS_YPRE);
    const bf16* TOEP = (const bf16*)(ws + WS_TAB + TAB_TOEP); const bf16* QM = (const bf16*)(ws + WS_TAB + TAB_QM); const bf16* PM = (const bf16*)(ws + WS_PM);
    const float* A16 = (const float*)(ws + WS_TAB + TAB_A16);
    LAS float* Sf = (LAS float*)(lds + RING_OFF);
    const int fr = lane & 15, fq = lane >> 4;
    for (int unit = u0; unit < u1; unit += ustep) {
        const int b = unit >> 5, g = unit & 31;
        const bf16* Ub = U + (size_t)b * SEQ * 512 + g * 16;
        bf16x8 af[2][8];
#pragma unroll
        for (int rb = 0; rb < 2; ++rb)
#pragma unroll
            for (int ks = 0; ks < 8; ++ks) { const int token = (32 * wave + 16 * rb + fr) * 16 + 2 * ks + (fq >> 1);
                af[rb][ks] = *(const bf16x8*)(Ub + (size_t)token * 512 + 8 * (fq & 1)); }
        __syncthreads();
        {
            bf16x8 bq[2][8];
#pragma unroll
            for (int ks = 0; ks < 8; ++ks) bq[0][ks] = *(const bf16x8*)(QM + ((size_t)(g * 128 + fr)) * 256 + 32 * ks + 8 * fq);
#pragma unroll
            for (int nb = 0; nb < 8; ++nb) {
                if (nb + 1 < 8) {
#pragma unroll
                    for (int ks = 0; ks < 8; ++ks) bq[(nb + 1) & 1][ks] = *(const bf16x8*)(QM + ((size_t)(g * 128 + 16 * (nb + 1) + fr)) * 256 + 32 * ks + 8 * fq); }
                f32x4 a0 = {0.f, 0.f, 0.f, 0.f}, a1 = {0.f, 0.f, 0.f, 0.f};
#pragma unroll
                for (int ks = 0; ks < 8; ++ks) { a0 = __builtin_amdgcn_mfma_f32_16x16x32_bf16(af[0][ks], bq[nb & 1][ks], a0, 0, 0, 0); a1 = __builtin_amdgcn_mfma_f32_16x16x32_bf16(af[1][ks], bq[nb & 1][ks], a1, 0, 0, 0); }
#pragma unroll
                for (int e = 0; e < 4; ++e) { Sf[(32 * wave + 4 * fq + e) * 132 + 16 * nb + fr] = a0[e]; Sf[(32 * wave + 16 + 4 * fq + e) * 132 + 16 * nb + fr] = a1[e]; }
            }
        }
        __syncthreads();
        if (wave == 0) {
            const float ar = A16[(g * 64 + lane) * 2], ai = A16[(g * 64 + lane) * 2 + 1];
            float hr = 0.f, hi = 0.f;
            for (int c0 = 0; c0 < 256; c0 += 16) {
                float sr[16], si[16];
#pragma unroll
                for (int i = 0; i < 16; ++i) { sr[i] = Sf[(c0 + i) * 132 + lane]; si[i] = Sf[(c0 + i) * 132 + 64 + lane]; }
#pragma unroll
                for (int i = 0; i < 16; ++i) { Sf[(c0 + i) * 132 + lane] = hr; Sf[(c0 + i) * 132 + 64 + lane] = hi;
                    const float nhr = ar * hr - ai * hi + sr[i], nhi = ar * hi + ai * hr + si[i]; hr = nhr; hi = nhi; }
            }
        }
        __syncthreads();
        bf16x8 hf[2][4];
#pragma unroll
        for (int rb = 0; rb < 2; ++rb)
#pragma unroll
            for (int ks = 0; ks < 4; ++ks) { const LAS f32x4* hp = (const LAS f32x4*)(Sf + (32 * wave + 16 * rb + fr) * 132 + 32 * ks + 8 * fq); const f32x4 h0 = hp[0], h1 = hp[1];
                v4u w; w.x = cvtpk(h0[0], h0[1]); w.y = cvtpk(h0[2], h0[3]); w.z = cvtpk(h1[0], h1[1]); w.w = cvtpk(h1[2], h1[3]);
                hf[rb][ks] = __builtin_bit_cast(bf16x8, w); }
        {
            bf16x8 bt[2][8], bp[2][4];
            bt[0][0] = *(const bf16x8*)(TOEP + ((size_t)(g * 256 + fr)) * 256 + 8 * fq);
#pragma unroll
            for (int ks = 0; ks < 4; ++ks) bp[0][ks] = *(const bf16x8*)(PM + ((size_t)(g * 256 + fr)) * 128 + 32 * ks + 8 * fq);
#pragma unroll
            for (int nb = 0; nb < 16; ++nb) {
                if (nb + 1 < 16) {
#pragma unroll
                    for (int ks = 0; ks < 8; ++ks) if (2 * ks <= nb + 1) bt[(nb + 1) & 1][ks] = *(const bf16x8*)(TOEP + ((size_t)(g * 256 + 16 * (nb + 1) + fr)) * 256 + 32 * ks + 8 * fq);
#pragma unroll
                    for (int ks = 0; ks < 4; ++ks) bp[(nb + 1) & 1][ks] = *(const bf16x8*)(PM + ((size_t)(g * 256 + 16 * (nb + 1) + fr)) * 128 + 32 * ks + 8 * fq); }
                f32x4 a0 = {0.f, 0.f, 0.f, 0.f}, a1 = {0.f, 0.f, 0.f, 0.f};
#pragma unroll
                for (int ks = 0; ks < 8; ++ks) if (2 * ks <= nb) { a0 = __builtin_amdgcn_mfma_f32_16x16x32_bf16(af[0][ks], bt[nb & 1][ks], a0, 0, 0, 0); a1 = __builtin_amdgcn_mfma_f32_16x16x32_bf16(af[1][ks], bt[nb & 1][ks], a1, 0, 0, 0); }
#pragma unroll
                for (int ks = 0; ks < 4; ++ks) { a0 = __builtin_amdgcn_mfma_f32_16x16x32_bf16(hf[0][ks], bp[nb & 1][ks], a0, 0, 0, 0); a1 = __builtin_amdgcn_mfma_f32_16x16x32_bf16(hf[1][ks], bp[nb & 1][ks], a1, 0, 0, 0); }
#pragma unroll
                for (int e = 0; e < 4; ++e) {
                    const size_t t0 = (size_t)b * SEQ + (size_t)(32 * wave + 4 * fq + e) * 16 + nb, t1 = t0 + 256;
                    YPRE[t0 * 512 + g * 16 + fr] = (bf16)f2bf(gelu_tanh_f(a0[e]));
                    YPRE[t1 * 512 + g * 16 + fr] = (bf16)f2bf(gelu_tanh_f(a1[e])); }
            }
        }
    }
}
DI void conv_phase(const InTab in, unsigned char* ws, int gt, int NGT) {
    const bf16* XBC = (const bf16*)(ws + WS_XBC); bf16* XC = (bf16*)(ws + WS_A);
    const float* cw = in[13]; const float* cb = in[14];
    for (int i = gt; i < (M / 8) * 320; i += NGT) {
        const int tb = i / 320, c8 = (i % 320) * 8, t0 = tb * 8, ts0 = t0 & (SEQ - 1);
        v4u r[11];
#pragma unroll
        for (int k = 0; k < 11; ++k) { r[k] = (v4u){0u, 0u, 0u, 0u}; if (ts0 - 3 + k >= 0) r[k] = *(const v4u*)(XBC + (size_t)(t0 - 3 + k) * 2560 + c8); }
        float w[4][8], bs[8];
#pragma unroll
        for (int k = 0; k < 4; ++k) { const f32x4 w0 = *(const f32x4*)(cw + k * 2560 + c8), w1 = *(const f32x4*)(cw + k * 2560 + c8 + 4);
            w[k][0] = w0.x; w[k][1] = w0.y; w[k][2] = w0.z; w[k][3] = w0.w; w[k][4] = w1.x; w[k][5] = w1.y; w[k][6] = w1.z; w[k][7] = w1.w; }
        { const f32x4 b0 = *(const f32x4*)(cb + c8), b1 = *(const f32x4*)(cb + c8 + 4); bs[0] = b0.x; bs[1] = b0.y; bs[2] = b0.z; bs[3] = b0.w; bs[4] = b1.x; bs[5] = b1.y; bs[6] = b1.z; bs[7] = b1.w; }
        float x[11][8];
#pragma unroll
        for (int k = 0; k < 11; ++k) { x[k][0] = bflo(r[k].x); x[k][1] = bfhi(r[k].x); x[k][2] = bflo(r[k].y); x[k][3] = bfhi(r[k].y); x[k][4] = bflo(r[k].z); x[k][5] = bfhi(r[k].z); x[k][6] = bflo(r[k].w); x[k][7] = bfhi(r[k].w); }
#pragma unroll
        for (int j = 0; j < 8; ++j) { float acc[8];
#pragma unroll
            for (int e = 0; e < 8; ++e) acc[e] = bs[e] + w[0][e] * x[j][e] + w[1][e] * x[j + 1][e] + w[2][e] * x[j + 2][e] + w[3][e] * x[j + 3][e];
            v4u o; o.x = cvtpk(silu_f(acc[0]), silu_f(acc[1])); o.y = cvtpk(silu_f(acc[2]), silu_f(acc[3])); o.z = cvtpk(silu_f(acc[4]), silu_f(acc[5])); o.w = cvtpk(silu_f(acc[6]), silu_f(acc[7]));
            *(v4u*)(XC + (size_t)(t0 + j) * 2560 + c8) = o; }
    }
}
DI void ssd_fast(const InTab in, unsigned char* ws, LAS unsigned char* lds, int bx, int G, int tid, int lane, int wave) {
    typedef short bf16x8 __attribute__((ext_vector_type(8)));
    const bf16* XC = (const bf16*)(ws + WS_A); const float* DT = (const float*)(ws + WS_DT); const bf16* Z = (const bf16*)(ws + WS_Z); bf16* YS = (bf16*)(ws + WS_YSSD);
    constexpr int SET = 64 * 136 * 2 + 64 * 72 * 2 + 256;
    LAS bf16* T0 = (LAS bf16*)(lds + RING_OFF);
    LAS bf16* Sl = T0 + 2 * SET;
    const int fr = lane & 15, fq = lane >> 4, lb = wave & 3, ph = wave >> 2, tq = fr >> 2, tp = fr & 3;
    const float LOG2E = 1.4426950408889634f;
    for (int unit = bx; unit < BATCH * 24; unit += G) {
        const int b = unit / 24, h = unit % 24, grp = h / 6;
        const float A = -__expf(in[16][h]), Dh = in[17][h], dtb = in[15][h];
        f32x4 st[4];
#pragma unroll
        for (int i = 0; i < 4; ++i) st[i] = (f32x4){0.f, 0.f, 0.f, 0.f};
        __syncthreads();
        for (int i = tid; i < 64 * 136 / 2; i += 512) ((LAS unsigned*)Sl)[i] = 0u;
        v4u rB[2], rC[2], rX; float rdt;
#define SSD_FETCH(chunk) do { const size_t r0_ = (size_t)b * SEQ + (size_t)(chunk) * 64; \
            _Pragma("unroll") for (int i = 0; i < 2; ++i) { const int pc = tid + 512 * i, s = pc >> 4, n0 = (pc & 15) * 8; \
                rB[i] = *(const v4u*)(XC + (r0_ + s) * 2560 + 1536 + grp * 128 + n0); rC[i] = *(const v4u*)(XC + (r0_ + s) * 2560 + 2048 + grp * 128 + n0); } \
            rX = *(const v4u*)(XC + (r0_ + (tid >> 3)) * 2560 + h * 64 + (tid & 7) * 8); \
            rdt = DT[(r0_ + lane) * 32 + h]; } while (0)
#define SSD_STAGE(set) do { LAS bf16* Bl_ = T0 + (set) * SET; LAS bf16* Cl_ = Bl_ + 64 * 136; LAS bf16* Xl_ = Cl_ + 64 * 136; LAS bf16* Xw_ = Xl_ + 64 * 72; LAS float* cs_ = (LAS float*)(Xw_ + 64 * 72); \
            const float dt = softplus_f(rdt + dtb); float cs = dt * A; \
            _Pragma("unroll") for (int off = 1; off < 64; off <<= 1) { const float t = __shfl_up(cs, off); if (lane >= off) cs += t; } \
            const float cs_last = __shfl(cs, 63); const float wgt = __expf(cs_last - cs) * dt; \
            if (wave == 0) { cs_[lane] = cs; cs_[64 + lane] = dt; } \
            _Pragma("unroll") for (int i = 0; i < 2; ++i) { const int pc = tid + 512 * i, s = pc >> 4, n0 = (pc & 15) * 8; \
                *(LAS v4u*)(Bl_ + s * 136 + n0) = rB[i]; *(LAS v4u*)(Cl_ + s * 136 + n0) = rC[i]; } \
            { const int l = tid >> 3, p0 = (tid & 7) * 8; const float wl = __shfl(wgt, l); \
              *(LAS v4u*)(Xl_ + l * 72 + p0) = rX; \
              v4u xs; xs.x = cvtpk(bflo(rX.x) * wl, bfhi(rX.x) * wl); xs.y = cvtpk(bflo(rX.y) * wl, bfhi(rX.y) * wl); xs.z = cvtpk(bflo(rX.z) * wl, bfhi(rX.z) * wl); xs.w = cvtpk(bflo(rX.w) * wl, bfhi(rX.w) * wl); \
              *(LAS v4u*)(Xw_ + l * 72 + p0) = xs; } } while (0)
        SSD_FETCH(0); SSD_STAGE(0); SSD_FETCH(1);
        __syncthreads();
        for (int ch = 0; ch < SEQ / 64; ++ch) {
            const size_t row0 = (size_t)b * SEQ + ch * 64;
            const LAS bf16* Bl = T0 + (ch & 1) * SET; const LAS bf16* Cl = Bl + 64 * 136; const LAS bf16* Xl = Cl + 64 * 136; const LAS bf16* Xw = Xl + 64 * 72; const LAS float* csl = (const LAS float*)(Xw + 64 * 72);
            const LAS bf16* Scur = Sl + (ch & 1) * (64 * 136); LAS bf16* Snxt = Sl + ((ch + 1) & 1) * (64 * 136);
            const size_t row = row0 + 16 * lb + fr;
            v2u zw[2];
#pragma unroll
            for (int pi = 0; pi < 2; ++pi) zw[pi] = *(const v2u*)(Z + row * 1536 + h * 64 + 16 * (2 * ph + pi) + 4 * fq);
            bf16x8 cf[4];
#pragma unroll
            for (int ks = 0; ks < 4; ++ks) cf[ks] = *(const LAS bf16x8*)(Cl + (16 * lb + fr) * 136 + 32 * ks + 8 * fq);
            const float cs_l = csl[16 * lb + fr];
            f32x4 gt[4];
#pragma unroll
            for (int sb = 0; sb < 4; ++sb) { gt[sb] = (f32x4){0.f, 0.f, 0.f, 0.f};
                if (sb <= lb) {
#pragma unroll
                    for (int ks = 0; ks < 4; ++ks) { const bf16x8 a = *(const LAS bf16x8*)(Bl + (16 * sb + fr) * 136 + 32 * ks + 8 * fq);
                        gt[sb] = __builtin_amdgcn_mfma_f32_16x16x32_bf16(a, cf[ks], gt[sb], 0, 0, 0); }
                    const f32x4 css = *(const LAS f32x4*)(csl + 16 * sb + 4 * fq), dts = *(const LAS f32x4*)(csl + 64 + 16 * sb + 4 * fq);
#pragma unroll
                    for (int e = 0; e < 4; ++e) { const int s = 16 * sb + 4 * fq + e, l = 16 * lb + fr;
                        gt[sb][e] = (s <= l) ? gt[sb][e] * __builtin_amdgcn_exp2f((cs_l - css[e]) * LOG2E) * dts[e] : 0.f; }
                } }
            bf16x8 mt[2];
#pragma unroll
            for (int kk = 0; kk < 2; ++kk) { v4u w; w.x = cvtpk(gt[2 * kk][0], gt[2 * kk][1]); w.y = cvtpk(gt[2 * kk][2], gt[2 * kk][3]);
                w.z = cvtpk(gt[2 * kk + 1][0], gt[2 * kk + 1][1]); w.w = cvtpk(gt[2 * kk + 1][2], gt[2 * kk + 1][3]); mt[kk] = __builtin_bit_cast(bf16x8, w); }
            const float el = __builtin_amdgcn_exp2f(cs_l * LOG2E);
#pragma unroll
            for (int pi = 0; pi < 2; ++pi) { const int pb = 2 * ph + pi;
                f32x4 y = {0.f, 0.f, 0.f, 0.f};
#pragma unroll
                for (int ks = 0; ks < 4; ++ks) { const bf16x8 a = *(const LAS bf16x8*)(Scur + (16 * pb + fr) * 136 + 32 * ks + 8 * fq);
                    y = __builtin_amdgcn_mfma_f32_16x16x32_bf16(a, cf[ks], y, 0, 0, 0); }
                y = y * el;
#pragma unroll
                for (int kk = 0; kk < 2; ++kk) if (2 * kk <= lb) {
                    const v2u lo = tr16(Xl + (32 * kk + 4 * fq + tq) * 72 + 16 * pb + 4 * tp), hi = tr16(Xl + (32 * kk + 16 + 4 * fq + tq) * 72 + 16 * pb + 4 * tp);
                    v4u aw; aw.x = lo.x; aw.y = lo.y; aw.z = hi.x; aw.w = hi.y;
                    y = __builtin_amdgcn_mfma_f32_16x16x32_bf16(__builtin_bit_cast(bf16x8, aw), mt[kk], y, 0, 0, 0); }
                const v2u xw = *(const LAS v2u*)(Xl + (16 * lb + fr) * 72 + 16 * pb + 4 * fq);
                const float o0 = (y[0] + Dh * bflo(xw.x)) * pg8::fast_silu(bflo(zw[pi].x)), o1 = (y[1] + Dh * bfhi(xw.x)) * pg8::fast_silu(bfhi(zw[pi].x));
                const float o2 = (y[2] + Dh * bflo(xw.y)) * pg8::fast_silu(bflo(zw[pi].y)), o3 = (y[3] + Dh * bfhi(xw.y)) * pg8::fast_silu(bfhi(zw[pi].y));
                v2u ow; ow.x = cvtpk(o0, o1); ow.y = cvtpk(o2, o3);
                *(v2u*)(YS + row * 1536 + h * 64 + 16 * pb + 4 * fq) = ow;
            }
            const float dec = __builtin_amdgcn_exp2f(csl[63] * LOG2E);
            bf16x8 ba[2];
#pragma unroll
            for (int ks = 0; ks < 2; ++ks) { const v2u lo = tr16(Bl + (32 * ks + 8 * fq + tq) * 136 + 16 * wave + 4 * tp), hi = tr16(Bl + (32 * ks + 8 * fq + 4 + tq) * 136 + 16 * wave + 4 * tp);
                v4u aw; aw.x = lo.x; aw.y = lo.y; aw.z = hi.x; aw.w = hi.y; ba[ks] = __builtin_bit_cast(bf16x8, aw); }
#pragma unroll
            for (int pb = 0; pb < 4; ++pb) { st[pb] = st[pb] * dec;
#pragma unroll
                for (int ks = 0; ks < 2; ++ks) { const v2u lo = tr16(Xw + (32 * ks + 8 * fq + tq) * 72 + 16 * pb + 4 * tp), hi = tr16(Xw + (32 * ks + 8 * fq + 4 + tq) * 72 + 16 * pb + 4 * tp);
                    v4u xv; xv.x = lo.x; xv.y = lo.y; xv.z = hi.x; xv.w = hi.y;
                    st[pb] = __builtin_amdgcn_mfma_f32_16x16x32_bf16(ba[ks], __builtin_bit_cast(bf16x8, xv), st[pb], 0, 0, 0); }
                v2u sw; sw.x = cvtpk(st[pb][0], st[pb][1]); sw.y = cvtpk(st[pb][2], st[pb][3]);
                *(LAS v2u*)(Snxt + (16 * pb + fr) * 136 + 16 * wave + 4 * fq) = sw; }
            if (ch + 1 < SEQ / 64) { SSD_STAGE((ch + 1) & 1); if (ch + 2 < SEQ / 64) SSD_FETCH(ch + 2); }
            BAR_LDS();
        }
#undef SSD_FETCH
#undef SSD_STAGE
    }
}
DI void ssd_finalize(const InTab in, unsigned char* ws, int gw, int NGW, int lane) {
    const bf16* YS = (const bf16*)(ws + WS_YSSD); bf16* Y = (bf16*)(ws + WS_A); const float* nw = in[18];
    for (int m = 2 * gw; m < M; m += 2 * NGW) {
        unsigned w[2][4][3];
#pragma unroll
        for (int r = 0; r < 2; ++r)
#pragma unroll
            for (int grp = 0; grp < 4; ++grp) { const unsigned* src = (const unsigned*)(YS + (size_t)(m + r) * 1536 + grp * 384) + lane * 3; w[r][grp][0] = src[0]; w[r][grp][1] = src[1]; w[r][grp][2] = src[2]; }
#pragma unroll
        for (int r = 0; r < 2; ++r)
#pragma unroll
            for (int grp = 0; grp < 4; ++grp) {
                const float v[6] = {bflo(w[r][grp][0]), bfhi(w[r][grp][0]), bflo(w[r][grp][1]), bfhi(w[r][grp][1]), bflo(w[r][grp][2]), bfhi(w[r][grp][2])};
                float s = 0.f;
#pragma unroll
                for (int j = 0; j < 6; ++j) s += v[j] * v[j];
                const float rstd = __builtin_amdgcn_rsqf(wave_sum(s) * (1.f / 384.f) + RMS_EPS);
                const float* g = nw + grp * 384 + lane * 6;
                unsigned* dst = (unsigned*)(Y + (size_t)(m + r) * D + 512 + grp * 384) + lane * 3;
                dst[0] = cvtpk(v[0] * rstd * g[0], v[1] * rstd * g[1]); dst[1] = cvtpk(v[2] * rstd * g[2], v[3] * rstd * g[3]); dst[2] = cvtpk(v[4] * rstd * g[4], v[5] * rstd * g[5]);
            }
    }
}
DI void swa_fast(const InTab in, unsigned char* ws, LAS unsigned char* lds, int bx, int G, int tid, int lane, int wave) {
    typedef short bf16x8 __attribute__((ext_vector_type(8)));
    const bf16* Q = (const bf16*)(ws + WS_Q); const bf16* Kb = (const bf16*)(ws + WS_K); const bf16* Vb = (const bf16*)(ws + WS_V); bf16* Y = (bf16*)(ws + WS_A);
    LAS bf16* Kl = (LAS bf16*)(lds + RING_OFF);
    LAS bf16* Vl = (LAS bf16*)(lds + RING_OFF + 192 * 144);
    const int fr = lane & 15, fq = lane >> 4, piece = tid & 7, tq = fr >> 2, tp = fr & 3;
    const int hql = wave >> 1, qo = (wave & 1) * 32, kb0 = qo >> 4;
    const float LOG2E = 1.4426950408889634f;
    float wk8[8], wq0[8], wq1[8];
#pragma unroll
    for (int j = 0; j < 8; ++j) { wk8[j] = in[27][piece * 8 + j]; wq0[j] = in[26][fq * 8 + j]; wq1[j] = in[26][32 + fq * 8 + j]; }
    v4u kw[3], vw[3], qw[2][2];
#define SWA_FETCH(u_) do { const int b_ = (u_) >> 8, kvh_ = ((u_) >> 6) & 3, t0_ = ((u_) & 63) * 64; \
        _Pragma("unroll") for (int i = 0; i < 3; ++i) { const int idx_ = (tid + 512 * i) >> 3, pos_ = t0_ - 128 + idx_; kw[i] = (v4u){0u, 0u, 0u, 0u}; vw[i] = (v4u){0u, 0u, 0u, 0u}; \
            if (pos_ >= 0) { const size_t r_ = (size_t)b_ * SEQ + pos_; kw[i] = *(const v4u*)(Kb + r_ * 256 + kvh_ * 64 + piece * 8); vw[i] = *(const v4u*)(Vb + r_ * 256 + kvh_ * 64 + piece * 8); } } \
        _Pragma("unroll") for (int qb = 0; qb < 2; ++qb) { const size_t r_ = (size_t)b_ * SEQ + t0_ + qo + qb * 16 + fr; \
            qw[qb][0] = *(const v4u*)(Q + r_ * 1024 + (kvh_ * 4 + hql) * 64 + fq * 8); qw[qb][1] = *(const v4u*)(Q + r_ * 1024 + (kvh_ * 4 + hql) * 64 + 32 + fq * 8); } } while (0)
    if (bx < BATCH * 4 * 64) SWA_FETCH(bx);
    for (int unit = bx; unit < BATCH * 4 * 64; unit += G) {
        const int b = unit >> 8, kvh = (unit >> 6) & 3, t0 = (unit & 63) * 64;
        const size_t row0 = (size_t)b * SEQ + t0;
        __syncthreads();
#pragma unroll
        for (int i = 0; i < 3; ++i) {
            const int pc = tid + 512 * i, idx = pc >> 3;
            const float k0 = bflo(kw[i].x), k1 = bfhi(kw[i].x), k2 = bflo(kw[i].y), k3 = bfhi(kw[i].y), k4 = bflo(kw[i].z), k5 = bfhi(kw[i].z), k6 = bflo(kw[i].w), k7 = bfhi(kw[i].w);
            float ss = (k0 * k0 + k1 * k1) + (k2 * k2 + k3 * k3) + (k4 * k4 + k5 * k5) + (k6 * k6 + k7 * k7);
            ss += __shfl_xor(ss, 1); ss += __shfl_xor(ss, 2); ss += __shfl_xor(ss, 4);
            const float rs = __builtin_amdgcn_rsqf(ss * (1.f / 64.f) + RMS_EPS);
            v4u o; o.x = cvtpk(k0 * rs * wk8[0], k1 * rs * wk8[1]); o.y = cvtpk(k2 * rs * wk8[2], k3 * rs * wk8[3]);
            o.z = cvtpk(k4 * rs * wk8[4], k5 * rs * wk8[5]); o.w = cvtpk(k6 * rs * wk8[6], k7 * rs * wk8[7]);
            *(LAS v4u*)(Kl + idx * 72 + piece * 8) = o;
            *(LAS v4u*)(Vl + idx * 72 + piece * 8) = vw[i];
        }
        const int hq = kvh * 4 + hql;
        bf16x8 qf[2][2];
#pragma unroll
        for (int qb = 0; qb < 2; ++qb) {
            const v4u w0 = qw[qb][0], w1 = qw[qb][1];
            const float a0 = bflo(w0.x), a1 = bfhi(w0.x), a2 = bflo(w0.y), a3 = bfhi(w0.y), a4 = bflo(w0.z), a5 = bfhi(w0.z), a6 = bflo(w0.w), a7 = bfhi(w0.w);
            const float c0 = bflo(w1.x), c1 = bfhi(w1.x), c2 = bflo(w1.y), c3 = bfhi(w1.y), c4 = bflo(w1.z), c5 = bfhi(w1.z), c6 = bflo(w1.w), c7 = bfhi(w1.w);
            float ss = (a0 * a0 + a1 * a1) + (a2 * a2 + a3 * a3) + (a4 * a4 + a5 * a5) + (a6 * a6 + a7 * a7) + (c0 * c0 + c1 * c1) + (c2 * c2 + c3 * c3) + (c4 * c4 + c5 * c5) + (c6 * c6 + c7 * c7);
            ss += __shfl_xor(ss, 16); ss += __shfl_xor(ss, 32);
            const float sc = __builtin_amdgcn_rsqf(ss * (1.f / 64.f) + RMS_EPS) * 0.125f * LOG2E;
            v4u p0, p1;
            p0.x = cvtpk(a0 * sc * wq0[0], a1 * sc * wq0[1]); p0.y = cvtpk(a2 * sc * wq0[2], a3 * sc * wq0[3]);
            p0.z = cvtpk(a4 * sc * wq0[4], a5 * sc * wq0[5]); p0.w = cvtpk(a6 * sc * wq0[6], a7 * sc * wq0[7]);
            p1.x = cvtpk(c0 * sc * wq1[0], c1 * sc * wq1[1]); p1.y = cvtpk(c2 * sc * wq1[2], c3 * sc * wq1[3]);
            p1.z = cvtpk(c4 * sc * wq1[4], c5 * sc * wq1[5]); p1.w = cvtpk(c6 * sc * wq1[6], c7 * sc * wq1[7]);
            qf[qb][0] = __builtin_bit_cast(bf16x8, p0); qf[qb][1] = __builtin_bit_cast(bf16x8, p1);
        }
        __syncthreads();
        if (unit + G < BATCH * 4 * 64) SWA_FETCH(unit + G);
        f32x4 s[10][2];
#pragma unroll
        for (int i = 0; i < 10; ++i) { s[i][0] = (f32x4){0.f, 0.f, 0.f, 0.f}; s[i][1] = (f32x4){0.f, 0.f, 0.f, 0.f}; }
#pragma unroll
        for (int i = 0; i < 10; ++i)
#pragma unroll
            for (int ks = 0; ks < 2; ++ks) { const bf16x8 a = *(const LAS bf16x8*)(Kl + ((kb0 + i) * 16 + fr) * 72 + ks * 32 + fq * 8);
                if (i < 9) s[i][0] = __builtin_amdgcn_mfma_f32_16x16x32_bf16(a, qf[0][ks], s[i][0], 0, 0, 0);
                if (i > 0) s[i][1] = __builtin_amdgcn_mfma_f32_16x16x32_bf16(a, qf[1][ks], s[i][1], 0, 0, 0); }
        const float sinkl = in[28][hq] * LOG2E;
        float linv[2];
#pragma unroll
        for (int qb = 0; qb < 2; ++qb) {
#pragma unroll
            for (int e = 0; e < 4; ++e) { if (!(4 * fq + e > fr)) s[qb][qb][e] = -INFINITY; if (!(4 * fq + e <= fr)) s[qb + 8][qb][e] = -INFINITY; }
            if (t0 < 128) {
#pragma unroll
                for (int d = 0; d < 9; ++d)
#pragma unroll
                    for (int e = 0; e < 4; ++e) if (t0 - 128 + (kb0 + qb + d) * 16 + 4 * fq + e < 0) s[qb + d][qb][e] = -INFINITY;
            }
            float mx = sinkl;
#pragma unroll
            for (int d = 0; d < 9; ++d) mx = fmaxf(mx, fmaxf(fmaxf(s[qb + d][qb][0], s[qb + d][qb][1]), fmaxf(s[qb + d][qb][2], s[qb + d][qb][3])));
            mx = fmaxf(mx, __shfl_xor(mx, 16)); mx = fmaxf(mx, __shfl_xor(mx, 32));
            float l = 0.f;
#pragma unroll
            for (int d = 0; d < 9; ++d)
#pragma unroll
                for (int e = 0; e < 4; ++e) { const float pv = __builtin_amdgcn_exp2f(s[qb + d][qb][e] - mx); s[qb + d][qb][e] = pv; l += pv; }
            l += __shfl_xor(l, 16); l += __shfl_xor(l, 32);
            l += __builtin_amdgcn_exp2f(sinkl - mx);
            linv[qb] = 1.0f / l;
        }
        s[9][0] = (f32x4){0.f, 0.f, 0.f, 0.f}; s[0][1] = (f32x4){0.f, 0.f, 0.f, 0.f};
        f32x4 o[4][2];
#pragma unroll
        for (int hb = 0; hb < 4; ++hb) { o[hb][0] = (f32x4){0.f, 0.f, 0.f, 0.f}; o[hb][1] = (f32x4){0.f, 0.f, 0.f, 0.f}; }
#pragma unroll
        for (int st = 0; st < 5; ++st) {
            bf16x8 pf[2];
#pragma unroll
            for (int qb = 0; qb < 2; ++qb) { v4u w; w.x = cvtpk(s[2 * st][qb][0], s[2 * st][qb][1]); w.y = cvtpk(s[2 * st][qb][2], s[2 * st][qb][3]);
                w.z = cvtpk(s[2 * st + 1][qb][0], s[2 * st + 1][qb][1]); w.w = cvtpk(s[2 * st + 1][qb][2], s[2 * st + 1][qb][3]); pf[qb] = __builtin_bit_cast(bf16x8, w); }
#pragma unroll
            for (int hb = 0; hb < 4; ++hb) {
                const v2u lo = tr16(Vl + ((kb0 + 2 * st) * 16 + 4 * fq + tq) * 72 + 16 * hb + 4 * tp), hi = tr16(Vl + ((kb0 + 2 * st + 1) * 16 + 4 * fq + tq) * 72 + 16 * hb + 4 * tp);
                v4u aw; aw.x = lo.x; aw.y = lo.y; aw.z = hi.x; aw.w = hi.y;
                const bf16x8 a = __builtin_bit_cast(bf16x8, aw);
                o[hb][0] = __builtin_amdgcn_mfma_f32_16x16x32_bf16(a, pf[0], o[hb][0], 0, 0, 0);
                o[hb][1] = __builtin_amdgcn_mfma_f32_16x16x32_bf16(a, pf[1], o[hb][1], 0, 0, 0); }
        }
#pragma unroll
        for (int qb = 0; qb < 2; ++qb) { const size_t r = row0 + qo + qb * 16 + fr;
#pragma unroll
            for (int hb = 0; hb < 4; ++hb) { const f32x4 v = o[hb][qb] * linv[qb]; v2u w; w.x = cvtpk(v[0], v[1]); w.y = cvtpk(v[2], v[3]);
                *(v2u*)(Y + r * D + hq * 64 + hb * 16 + 4 * fq) = w; } }
    }
#undef SWA_FETCH
}
DI void gla_pre(const InTab in, unsigned char* ws, LAS unsigned char* lds, int bx, int G, int tid, int lane, int wave) {
    typedef short bf16x8 __attribute__((ext_vector_type(8)));
    const bf16* QD = (const bf16*)(ws + WS_QD); const bf16* KD = (const bf16*)(ws + WS_KD); const float* GLR = (const float*)(ws + WS_GLR);
    bf16* QT = (bf16*)(ws + WS_QT); bf16* KTT = (bf16*)(ws + WS_KTT); bf16* ATT = (bf16*)(ws + WS_ATT); float* DEC = (float*)(ws + WS_DEC);
    LAS bf16* Ql = (LAS bf16*)(lds + RING_OFF);
    LAS bf16* Kl = Ql + 64 * 136;
    LAS float* gl = (LAS float*)(Kl + 64 * 136);
    LAS float* tot = gl + 64 * 16;
    const int fr = lane & 15, fq = lane >> 4, kc = tid & 127, sg = tid >> 7;
    constexpr int NU = BATCH * 64 * 4;
    if (bx >= NU) return;
    float w2n[16], gbn; f32x4 rgn; bf16 rqn[16], rkn[16];
#define GP_FETCH(u_) do { const int h_ = (u_) & 3, bc2_ = (u_) >> 2; const size_t r0_ = (size_t)(bc2_ >> 6) * SEQ + (size_t)(bc2_ & 63) * 64; \
        _Pragma("unroll") for (int r = 0; r < 16; ++r) w2n[r] = in[29][r * 512 + h_ * 128 + kc]; \
        gbn = in[30][h_ * 128 + kc]; \
        rgn = *(const f32x4*)(GLR + r0_ * 16 + (tid & 255) * 4); \
        _Pragma("unroll") for (int i = 0; i < 16; ++i) { rqn[i] = QD[(r0_ + 16 * sg + i) * 512 + h_ * 128 + kc]; rkn[i] = KD[(r0_ + 16 * sg + i) * 512 + h_ * 128 + kc]; } } while (0)
    GP_FETCH(bx);
    for (int unit = bx;; unit += G) {
        const int h = unit & 3, bc_ = unit >> 2, b = bc_ >> 6, c = bc_ & 63;
        const size_t row0 = (size_t)b * SEQ + c * 64;
        float w2[16]; bf16 rq[16], rk[16];
#pragma unroll
        for (int r = 0; r < 16; ++r) { w2[r] = w2n[r]; rq[r] = rqn[r]; rk[r] = rkn[r]; }
        const float gb = gbn; const f32x4 rg = rgn;
        GP_FETCH(unit + G < NU ? unit + G : unit);
        __syncthreads();
        if (tid < 256) *(LAS f32x4*)(gl + tid * 4) = rg;
        __syncthreads();
        float pre[16]; float run = 0.f;
#pragma unroll
        for (int i = 0; i < 16; ++i) { const LAS f32x4* gp = (const LAS f32x4*)(gl + (16 * sg + i) * 16); const f32x4 g0 = gp[0], g1 = gp[1], g2 = gp[2], g3 = gp[3];
            float x = gb;
#pragma unroll
            for (int e = 0; e < 4; ++e) x += g0[e] * w2[e] + g1[e] * w2[4 + e] + g2[e] * w2[8 + e] + g3[e] * w2[12 + e];
            const float ls = fminf(x, 0.f) - __logf(1.0f + __expf(-fabsf(x)));
            run += ls * (1.0f / 16.0f); pre[i] = run; }
        tot[sg * 128 + kc] = run;
        __syncthreads();
        const float t0 = tot[kc], t1 = tot[128 + kc], t2 = tot[256 + kc], t3 = tot[384 + kc];
        const float offs = (sg > 0 ? t0 : 0.f) + (sg > 1 ? t1 : 0.f) + (sg > 2 ? t2 : 0.f), blast = (t0 + t1) + (t2 + t3);
        if (sg == 0) DEC[(size_t)unit * 128 + kc] = __expf(blast);
        float k2[16];
#pragma unroll
        for (int i = 0; i < 16; ++i) { const int t = 16 * sg + i; const float bcv = pre[i] + offs;
            const float q = bf2f(rq[i]), k = bf2f(rk[i]);
            const float qt = q * __expf(bcv) * 0.08838834764831845f, kt = k * __expf(-bcv);
            k2[i] = k * __expf(blast - bcv);
            const bf16 qb = (bf16)f2bf(qt);
            QT[(row0 + t) * 512 + h * 128 + kc] = qb; Ql[t * 136 + kc] = qb; Kl[t * 136 + kc] = (bf16)f2bf(kt); }
        { v4u o0, o1; o0.x = cvtpk(k2[0], k2[1]); o0.y = cvtpk(k2[2], k2[3]); o0.z = cvtpk(k2[4], k2[5]); o0.w = cvtpk(k2[6], k2[7]);
          o1.x = cvtpk(k2[8], k2[9]); o1.y = cvtpk(k2[10], k2[11]); o1.z = cvtpk(k2[12], k2[13]); o1.w = cvtpk(k2[14], k2[15]);
          v4u* dst = (v4u*)(KTT + ((size_t)unit * 128 + kc) * 64 + 16 * sg); dst[0] = o0; dst[1] = o1; }
        __syncthreads();
#pragma unroll
        for (int ti = 0; ti < 2; ++ti) { const int tile = wave * 2 + ti, sb = tile >> 2, lb = tile & 3;
            f32x4 acc = {0.f, 0.f, 0.f, 0.f};
            if (sb <= lb) {
#pragma unroll
                for (int ks = 0; ks < 4; ++ks) { const bf16x8 a = *(const LAS bf16x8*)(Kl + (16 * sb + fr) * 136 + 32 * ks + 8 * fq), bq = *(const LAS bf16x8*)(Ql + (16 * lb + fr) * 136 + 32 * ks + 8 * fq);
                    acc = __builtin_amdgcn_mfma_f32_16x16x32_bf16(a, bq, acc, 0, 0, 0); }
            }
            const int l = 16 * lb + fr, s0 = 16 * sb + 4 * fq;
            v2u w; w.x = cvtpk(s0 <= l ? acc[0] : 0.f, s0 + 1 <= l ? acc[1] : 0.f); w.y = cvtpk(s0 + 2 <= l ? acc[2] : 0.f, s0 + 3 <= l ? acc[3] : 0.f);
            *(v2u*)(ATT + ((size_t)unit * 64 + l) * 64 + s0) = w; }
        if (unit + G >= NU) break;
    }
#undef GP_FETCH
}
DI void gla_seq(const InTab in, unsigned char* ws, LAS unsigned char* lds, int bx, int G, int tid, int lane, int wave) {
    typedef short bf16x8 __attribute__((ext_vector_type(8)));
    const bf16* VD = (const bf16*)(ws + WS_VD); const bf16* QT = (const bf16*)(ws + WS_QT); const bf16* KTT = (const bf16*)(ws + WS_KTT); const bf16* ATT = (const bf16*)(ws + WS_ATT);
    const float* DEC = (const float*)(ws + WS_DEC); bf16* GO = (bf16*)(ws + WS_GLAO);
    LAS bf16* vl0 = (LAS bf16*)(lds + RING_OFF);
    LAS bf16* ST = vl0 + 2 * 64 * 40;
    const int fr = lane & 15, fq = lane >> 4, lb = wave & 3, tq = fr >> 2, tp = fr & 3; const bool owave = wave < 4;
    for (int unit = bx; unit < BATCH * 32; unit += G) {
        const int b = unit >> 5, h = (unit >> 3) & 3, sl = unit & 7;
        f32x4 st[2]; st[0] = (f32x4){0.f, 0.f, 0.f, 0.f}; st[1] = (f32x4){0.f, 0.f, 0.f, 0.f};
        __syncthreads();
        for (int i = tid; i < 32 * 136 / 2; i += 512) ((LAS unsigned*)ST)[i] = 0u;
        v4u rV[2]; bf16x8 rA[2][2], rQ[2][4], rK[2][2]; f32x4 rD[2];
        rV[0] = rV[1] = (v4u){0u, 0u, 0u, 0u};
#pragma unroll
        for (int s_ = 0; s_ < 2; ++s_) {
#pragma unroll
            for (int ks = 0; ks < 2; ++ks) rA[s_][ks] = (bf16x8){0, 0, 0, 0, 0, 0, 0, 0};
#pragma unroll
            for (int ks = 0; ks < 4; ++ks) rQ[s_][ks] = (bf16x8){0, 0, 0, 0, 0, 0, 0, 0}; }
#define GLA_FETCH(set, chunk) do { const size_t r0_ = (size_t)b * SEQ + (size_t)(chunk) * 64; const size_t cu_ = (size_t)(b * 64 + (chunk)) * 4 + h; \
            if (tid < 256) rV[set] = *(const v4u*)(VD + (r0_ + (tid >> 2)) * 1024 + h * 256 + sl * 32 + (tid & 3) * 8); \
            _Pragma("unroll") for (int ks = 0; ks < 2; ++ks) rK[set][ks] = *(const bf16x8*)(KTT + (cu_ * 128 + 16 * wave + fr) * 64 + 32 * ks + 8 * fq); \
            if (owave) { _Pragma("unroll") for (int ks = 0; ks < 2; ++ks) rA[set][ks] = *(const bf16x8*)(ATT + (cu_ * 64 + 16 * lb + fr) * 64 + 32 * ks + 8 * fq); \
                _Pragma("unroll") for (int ks = 0; ks < 4; ++ks) rQ[set][ks] = *(const bf16x8*)(QT + (r0_ + 16 * lb + fr) * 512 + h * 128 + 32 * ks + 8 * fq); } \
            rD[set] = *(const f32x4*)(DEC + cu_ * 128 + 16 * wave + 4 * fq); } while (0)
#define GLA_STEP(set, chunk) do { const int ch_ = (chunk); const size_t row0 = (size_t)b * SEQ + (size_t)ch_ * 64; \
            const LAS bf16* vl = vl0 + (ch_ & 1) * (64 * 40); \
            bf16x8 wA[2], wQ[4], wK[2]; const f32x4 wD = rD[set]; \
            _Pragma("unroll") for (int ks = 0; ks < 2; ++ks) { wA[ks] = rA[set][ks]; wK[ks] = rK[set][ks]; } \
            _Pragma("unroll") for (int ks = 0; ks < 4; ++ks) wQ[ks] = rQ[set][ks]; \
            if (ch_ + 2 < SEQ / 64) GLA_FETCH(set, ch_ + 2); \
            const LAS bf16* Scur = ST + (ch_ & 1) * (32 * 136); LAS bf16* Snxt = ST + ((ch_ + 1) & 1) * (32 * 136); \
            bf16x8 vf[2][2]; \
            _Pragma("unroll") for (int d2 = 0; d2 < 2; ++d2) _Pragma("unroll") for (int ks = 0; ks < 2; ++ks) { \
                const v2u lo = tr16(vl + (32 * ks + 8 * fq + tq) * 40 + 16 * d2 + 4 * tp), hi = tr16(vl + (32 * ks + 8 * fq + 4 + tq) * 40 + 16 * d2 + 4 * tp); \
                v4u aw; aw.x = lo.x; aw.y = lo.y; aw.z = hi.x; aw.w = hi.y; vf[d2][ks] = __builtin_bit_cast(bf16x8, aw); } \
            if (owave) { _Pragma("unroll") for (int d2 = 0; d2 < 2; ++d2) { f32x4 o = {0.f, 0.f, 0.f, 0.f}, o2 = {0.f, 0.f, 0.f, 0.f}; \
                _Pragma("unroll") for (int ks = 0; ks < 2; ++ks) if (2 * ks <= lb) o = __builtin_amdgcn_mfma_f32_16x16x32_bf16(vf[d2][ks], wA[ks], o, 0, 0, 0); \
                _Pragma("unroll") for (int ks = 0; ks < 4; ++ks) { const bf16x8 a = *(const LAS bf16x8*)(Scur + (16 * d2 + fr) * 136 + 32 * ks + 8 * fq); \
                    if (ks & 1) o2 = __builtin_amdgcn_mfma_f32_16x16x32_bf16(a, wQ[ks], o2, 0, 0, 0); else o = __builtin_amdgcn_mfma_f32_16x16x32_bf16(a, wQ[ks], o, 0, 0, 0); } \
                o = o + o2; \
                v2u w; w.x = cvtpk(o[0], o[1]); w.y = cvtpk(o[2], o[3]); \
                *(v2u*)(GO + (row0 + 16 * lb + fr) * 1024 + h * 256 + sl * 32 + 16 * d2 + 4 * fq) = w; } } \
            _Pragma("unroll") for (int d2 = 0; d2 < 2; ++d2) { st[d2] = st[d2] * wD; \
                _Pragma("unroll") for (int ks = 0; ks < 2; ++ks) st[d2] = __builtin_amdgcn_mfma_f32_16x16x32_bf16(wK[ks], vf[d2][ks], st[d2], 0, 0, 0); \
                v2u sw; sw.x = cvtpk(st[d2][0], st[d2][1]); sw.y = cvtpk(st[d2][2], st[d2][3]); \
                *(LAS v2u*)(Snxt + (16 * d2 + fr) * 136 + 16 * wave + 4 * fq) = sw; } \
            if (tid < 256) *(LAS v4u*)(vl0 + ((ch_ + 1) & 1) * (64 * 40) + (tid >> 2) * 40 + (tid & 3) * 8) = rV[(set) ^ 1];     \
            BAR_LDS(); } while (0)
        GLA_FETCH(0, 0); GLA_FETCH(1, 1);
        if (tid < 256) *(LAS v4u*)(vl0 + (tid >> 2) * 40 + (tid & 3) * 8) = rV[0];
        __syncthreads();
        for (int ch = 0; ch < SEQ / 64; ch += 2) { GLA_STEP(0, ch); GLA_STEP(1, ch + 1); }
#undef GLA_FETCH
#undef GLA_STEP
    }
}
DI void gla_finalize(const InTab in, unsigned char* ws, int gw, int NGW, int lane) {
    const bf16* GO = (const bf16*)(ws + WS_GLAO); const bf16* GOUT = (const bf16*)(ws + WS_GOUT); bf16* Y = (bf16*)(ws + WS_A);
    const f32x4 g = *(const f32x4*)(in[31] + lane * 4);
    for (int m = 2 * gw; m < M; m += 2 * NGW) {
        v2u wo[2][4], wg[2][4];
#pragma unroll
        for (int r = 0; r < 2; ++r)
#pragma unroll
            for (int h = 0; h < 4; ++h) { wo[r][h] = *(const v2u*)(GO + (size_t)(m + r) * 1024 + h * 256 + lane * 4); wg[r][h] = *(const v2u*)(GOUT + (size_t)(m + r) * 1024 + h * 256 + lane * 4); }
#pragma unroll
        for (int r = 0; r < 2; ++r)
#pragma unroll
            for (int h = 0; h < 4; ++h) {
                const float v0 = bflo(wo[r][h].x), v1 = bfhi(wo[r][h].x), v2 = bflo(wo[r][h].y), v3 = bfhi(wo[r][h].y);
                const float rstd = __builtin_amdgcn_rsqf(wave_sum(v0 * v0 + v1 * v1 + v2 * v2 + v3 * v3) * (1.f / 256.f) + RMS_EPS);
                v2u o; o.x = cvtpk(v0 * rstd * g.x * silu_f(bflo(wg[r][h].x)), v1 * rstd * g.y * silu_f(bfhi(wg[r][h].x)));
                o.y = cvtpk(v2 * rstd * g.z * silu_f(bflo(wg[r][h].y)), v3 * rstd * g.w * silu_f(bfhi(wg[r][h].y)));
                *(v2u*)(Y + (size_t)(m + r) * D + 1024 + h * 256 + lane * 4) = o;
            }
    }
}
#define RT(base, first, ld) {(unsigned long long)(base) + 512ull * (unsigned long long)(first), (ld), 0}
__device__ const pg8::Route ROUTES[2][19] = {
  { RT(WS_U, 0, 512), RT(WS_U, 1, 512),
    RT(WS_Z, 0, 1536), RT(WS_Z, 1, 1536), RT(WS_Z, 2, 1536), RT(WS_Z, 3, 1536), RT(WS_Z, 4, 1536), RT(WS_Z, 5, 1536),
    RT(WS_XBC, 0, 2560), RT(WS_XBC, 1, 2560), RT(WS_XBC, 2, 2560), RT(WS_XBC, 3, 2560), RT(WS_XBC, 4, 2560), RT(WS_XBC, 5, 2560), RT(WS_XBC, 6, 2560), RT(WS_XBC, 7, 2560), RT(WS_XBC, 8, 2560), RT(WS_XBC, 9, 2560),
    RT(WS_DT, 0, 32) },
  { RT(WS_Q, 0, 1024), RT(WS_Q, 1, 1024), RT(WS_Q, 2, 1024), RT(WS_Q, 3, 1024),
    RT(WS_K, 0, 256), RT(WS_V, 0, 256),
    RT(WS_QD, 0, 512), RT(WS_QD, 1, 512), RT(WS_KD, 0, 512), RT(WS_KD, 1, 512),
    RT(WS_VD, 0, 1024), RT(WS_VD, 1, 1024), RT(WS_VD, 2, 1024), RT(WS_VD, 3, 1024),
    RT(WS_GOUT, 0, 1024), RT(WS_GOUT, 1, 1024), RT(WS_GOUT, 2, 1024), RT(WS_GOUT, 3, 1024),
    RT(WS_GLR, 0, 16) } };
#undef RT
template <int NB>
DI void tail_pass(const bf16* A, const bf16* Bt, float* out, int ldo, int ncols, const pg8::ssq_t* ss, LAS unsigned char* lds, int bx, int G, int lane, int wave) {
    typedef short bf16x8 __attribute__((ext_vector_type(8)));
    const int fr = lane & 15, fq = lane >> 4;
    LAS f32x4* P = (LAS f32x4*)(lds + RING_OFF);
    for (int job = bx; job < M / 128; job += G) {
        const int row_base = job * 128, kbase = wave * 256;
        f32x4 c[8][NB];
#pragma unroll
        for (int rb = 0; rb < 8; ++rb)
#pragma unroll
            for (int nb = 0; nb < NB; ++nb) c[rb][nb] = (f32x4){0.f, 0.f, 0.f, 0.f};
        const bf16* ap = A + (size_t)(row_base + fr) * 2048 + kbase + 8 * fq; const bf16* bp = Bt + (size_t)fr * 2048 + kbase + 8 * fq;
#pragma unroll 1
        for (int j0 = 0; j0 < 8; j0 += 2) {
            bf16x8 a[2][8], bb[2][NB];
#pragma unroll
            for (int j = 0; j < 2; ++j) {
#pragma unroll
                for (int rb = 0; rb < 8; ++rb) a[j][rb] = *(const bf16x8*)(ap + (size_t)rb * 16 * 2048 + 32 * (j0 + j));
#pragma unroll
                for (int nb = 0; nb < NB; ++nb) bb[j][nb] = *(const bf16x8*)(bp + (size_t)nb * 16 * 2048 + 32 * (j0 + j)); }
#pragma unroll
            for (int j = 0; j < 2; ++j)
#pragma unroll
                for (int rb = 0; rb < 8; ++rb)
#pragma unroll
                    for (int nb = 0; nb < NB; ++nb) c[rb][nb] = __builtin_amdgcn_mfma_f32_16x16x32_bf16(a[j][rb], bb[j][nb], c[rb][nb], 0, 0, 0);
        }
        __syncthreads();
#pragma unroll
        for (int rb = 0; rb < 8; ++rb)
#pragma unroll
            for (int nb = 0; nb < NB; ++nb) P[((wave * 8 + rb) * NB + nb) * 64 + lane] = c[rb][nb];
        __syncthreads();
        {   const int rb = wave;
#pragma unroll
            for (int nb = 0; nb < NB; ++nb) { f32x4 t = P[((0 * 8 + rb) * NB + nb) * 64 + lane];
#pragma unroll
                for (int w = 1; w < 8; ++w) t = t + P[((w * 8 + rb) * NB + nb) * 64 + lane];
#pragma unroll
                for (int e = 0; e < 4; ++e) { const int row = row_base + 16 * rb + 4 * fq + e, col = 16 * nb + fr;
                    const float rs = __builtin_amdgcn_rsqf(pg8::ssq_to_f(ss[row]) * (1.0f / D) + RMS_EPS);
                    if (col < ncols) out[(size_t)row * ldo + col] = t[e] * rs; } } }
    }
}
constexpr bool USE_HB5 = XMANT < 7;
DI pg8::ssq_t* ssq(unsigned char* ws, int k) { return k == 0 ? (pg8::ssq_t*)(ws + WS_SS0) : (pg8::ssq_t*)(ws + WS_SS) + (size_t)(k - 1) * M; }
struct Args { const float* in[37]; float* out; unsigned char* ws; int ph_lo, ph_hi; };
#define IN(k) (lo <= (k) && (k) < hi)
#define SEAM(k) do { if (IN(k) && IN((k) + 1)) xcd_barrier(bar); } while (0)
template <int LAYER, int HF>
DI void ffn_half(const InTab in, float* out, unsigned char* ws, LAS unsigned char* lds, const XcdBarrier& bar, int G, int bx) {
    constexpr int MH = M / 2; constexpr size_t R0 = (size_t)HF * MH;
    bf16* HB = (bf16*)(ws + WS_HB) + R0 * D; bf16* Hh = (bf16*)(ws + WS_H) + R0 * FF;
    const bf16* W13 = (const bf16*)(ws + (LAYER ? WS_W13_1 : WS_W13_0)); const bf16* W2 = (const bf16*)(ws + (LAYER ? WS_W2_1 : WS_W2_0));
    { pg8::Gemm g{USE_HB5 ? (const bf16*)(ws + WS_HB5) + R0 * D : HB, W13, MH, 2 * FF, D}; pg8::RevOrder S; S.init(MH, 2 * FF, G, bx);
      pg8::EpiSwiGLU E{Hh, FF, ssq(ws, LAYER ? 3 : 1) + R0, 1.0f / D, RMS_EPS};
      pg8::gemm_phase<pg8::EpiSwiGLU, pg8::RevOrder, true, true>(lds + RING_OFF, g, S, E); }
    xcd_barrier(bar);
    { pg8::Gemm g{Hh, W2, MH, D, FF}; pg8::StaticOrder S; S.init(MH, D, G, bx);
      if (LAYER == 0) { pg8::EpiResidBf<false> E{nullptr, HB, D, ssq(ws, 2) + R0, nullptr};
          pg8::gemm_phase<pg8::EpiResidBf<false>, pg8::StaticOrder, true, true>(lds + RING_OFF, g, S, E); }
      else { pg8::EpiResidOut E{HB, out + R0 * D, D};
          pg8::gemm_phase<pg8::EpiResidOut, pg8::StaticOrder, true, true>(lds + RING_OFF, g, S, E); } }
}
template <int LAYER>
DI void layer_body(const InTab in, float* out, unsigned char* ws, LAS unsigned char* lds, const XcdBarrier& bar, int lo, int hi, int tid, int lane, int wave, int G, int bx) {
    constexpr int pb = LAYER * 9;
    const int gw = bx * NWAVES + wave, NGW = G * NWAVES, gt = bx * NWAVES * 64 + tid, NGT = G * NWAVES * 64;
    bf16* HB = (bf16*)(ws + WS_HB); bf16* YM = (bf16*)(ws + WS_A);
    const bf16* WIN = (const bf16*)(ws + (LAYER ? WS_WIN1 : WS_WIN0)); const bf16* WOUT = (const bf16*)(ws + (LAYER ? WS_WOUT1 : WS_WOUT0));
    const bf16* W13 = (const bf16*)(ws + (LAYER ? WS_W13_1 : WS_W13_0)); const bf16* W2 = (const bf16*)(ws + (LAYER ? WS_W2_1 : WS_W2_0));
    if (LAYER == 0) {
        if (IN(pb + 0)) { prologue(in, ws, lds, gw, NGW, lane, wave); s5_tables(in, ws, gt); x_to_hb_phase(in[0], HB, ssq(ws, 0), gw, NGW, lane); }
        SEAM(pb + 0);
    }
    if (IN(pb + 1)) {
        if (LAYER == 0) { s5_tables2(in, ws, lds, bx, G, tid); __syncthreads(); }
        pg8::Gemm g{HB, WIN, M, N_MAIN, D};
        pg8::EpiRoute E; E.ws = ws; E.tab = ROUTES[LAYER]; E.ftile = -1; E.fbase = nullptr; E.fld = 0; E.fcols = 0; E.ss = ssq(ws, LAYER ? 2 : 0); E.inv_n = 1.0f / D; E.eps = RMS_EPS;
        pg8::TailOrder<LAYER == 0 ? 2 : 1> S; S.init(M, N_MAIN, G, bx); S.A = HB; S.Bt = WIN + (size_t)N_MAIN * D; S.tail_pn = -1  ; S.ss = ssq(ws, LAYER ? 2 : 0); S.inv_n = 1.0f / D; S.eps = RMS_EPS;
        if (LAYER == 0) { S.out = (float*)(ws + WS_DT); S.ldo = 32; S.ncols = 24; }
        else { S.out = (float*)(ws + WS_GLR); S.ldo = 16; S.ncols = 16; }
        pg8::gemm_phase<pg8::EpiRoute, pg8::TailOrder<LAYER == 0 ? 2 : 1>, true, true>(lds + RING_OFF, g, S, E);
        tail_pass<LAYER == 0 ? 2 : 1>(HB, WIN + (size_t)N_MAIN * D, S.out, S.ldo, S.ncols, ssq(ws, LAYER ? 2 : 0), lds, bx, G, lane, wave);
    }
    SEAM(pb + 1);
    if (IN(pb + 2)) {
        if (LAYER == 0) {
            const int ha = G / 4;
            if (bx < ha) s5_fast(in, ws, lds, bx, 64, ha, tid, lane, wave);
            else conv_phase(in, ws, (bx - ha) * NWAVES * 64 + tid, (G - ha) * NWAVES * 64);
        }
        else { gla_pre(in, ws, lds, bx, G, tid, lane, wave); __syncthreads(); swa_fast(in, ws, lds, bx, G, tid, lane, wave); }
    }
    SEAM(pb + 2);
    if (IN(pb + 3)) {
        if (LAYER == 0) { ssd_fast(in, ws, lds, bx, G, tid, lane, wave);
            const bool spare = G > 192;
            if (!spare || bx >= 192) s5_fast(in, ws, lds, 64 + (spare ? bx - 192 : bx), 256, spare ? G - 192 : G, tid, lane, wave); }
        else gla_seq(in, ws, lds, bx, G, tid, lane, wave);
    }
    SEAM(pb + 3);
    if (IN(pb + 4)) {
        if (LAYER == 0) {
            if (!(bx & 1)) { ssd_finalize(in, ws, gw, NGW, lane); __syncthreads(); }
            { pg8::Gemm g{(const bf16*)(ws + WS_YPRE), (const bf16*)(ws + WS_GLUW), M, 512, 512}; pg8::StaticOrder S; S.init(M, 512, G, bx);
              pg8::EpiGLU E{(const bf16*)(ws + WS_YPRE), 512, YM, D, in[12]};
              pg8::gemm_phase<pg8::EpiGLU, pg8::StaticOrder, true, true>(lds + RING_OFF, g, S, E); }
            if (bx & 1) { __syncthreads(); ssd_finalize(in, ws, gw, NGW, lane); }
        } else gla_finalize(in, ws, gw, NGW, lane);
    }
    SEAM(pb + 4);
    if (IN(pb + 5)) {
        pg8::Gemm g{YM, WOUT, M, D, D}; pg8::StaticOrder S; S.init(M, D, G, bx);
        pg8::EpiResidBf<false, USE_HB5> E{nullptr, HB, D, ssq(ws, LAYER ? 3 : 1), (bf16*)(ws + WS_HB5)};
        pg8::gemm_phase<pg8::EpiResidBf<false, USE_HB5>, pg8::StaticOrder, true, true>(lds + RING_OFF, g, S, E);
    }
    if (IN(pb + 5) && IN(pb + 7)) xcd_barrier(bar);
    if (IN(pb + 7)) {
        ffn_half<LAYER, 0>(in, out, ws, lds, bar, G, bx);
        ffn_half<LAYER, 1>(in, out, ws, lds, bar, G, bx);
    }
    if (LAYER == 0) { if (IN(pb + 7) && IN(pb + 10)) xcd_barrier(bar); }
}
__global__ void __launch_bounds__(NWAVES * 64, 2) fwd(Args args) {
    extern __shared__ __attribute__((aligned(16))) unsigned char lds_raw[];
    LAS unsigned char* lds = (LAS unsigned char*)lds_raw;
    volatile LAS unsigned* MISC = (volatile LAS unsigned*)(lds + MISC_OFF);
    const int tid = threadIdx.x, lane = tid & 63, wave = __builtin_amdgcn_readfirstlane(tid >> 6);
    const int G = gridDim.x, bx = blockIdx.x;
    unsigned char* ws = args.ws;
    if (tid < 32) MISC[tid] = 0u;
    if (tid < 37) ((LAS unsigned long long*)(lds + PT_OFF))[tid] = (unsigned long long)args.in[tid];
    __syncthreads();
    InTab in; in.t = (const LAS unsigned long long*)(lds + PT_OFF);
    const int lo = args.ph_lo, hi = args.ph_hi;
    XcdBarrier bar; bar.bar = (unsigned*)(ws + WS_CTL) + CW_BAR; bar.x = 0; bar.st = nullptr;
    if (hi - lo > 1) bar = xcd_barrier_post((unsigned*)(ws + WS_CTL) + CW_BAR, MISC + 8);
    layer_body<0>(in, args.out, ws, lds, bar, lo, hi, tid, lane, wave, G, bx);
    layer_body<1>(in, args.out, ws, lds, bar, lo, hi, tid, lane, wave, G, bx);
}
#undef IN
#undef SEAM

extern "C" void kernel_launch(void* const* d_in, const int* in_sizes, int n_in, void* d_out, int out_size, void* d_ws, size_t ws_size, hipStream_t stream) {
    static int grid = 0;
    if (grid == 0) {
        if (n_in != 37 || in_sizes[0] != M * D || out_size != M * D || ws_size < WS_END) { fprintf(stderr, "kernel_launch: unexpected shapes (n_in %d, in0 %d, out %d, ws %zu)\n", n_in, n_in > 0 ? in_sizes[0] : -1, out_size, ws_size); grid = -1; return; }
        int dev = 0, cus = 0;
        if (hipGetDevice(&dev) != hipSuccess || hipDeviceGetAttribute(&cus, hipDeviceAttributeMultiprocessorCount, dev) != hipSuccess) { grid = -1; return; }
        if (hipFuncSetAttribute((const void*)fwd, hipFuncAttributeMaxDynamicSharedMemorySize, LDS_BYTES) != hipSuccess) { fprintf(stderr, "kernel_launch: hipFuncSetAttribute failed\n"); grid = -1; return; }
        int per_cu = 0;
        if (hipOccupancyMaxActiveBlocksPerMultiprocessor(&per_cu, (const void*)fwd, NWAVES * 64, LDS_BYTES) != hipSuccess || per_cu < 1) fprintf(stderr, "kernel_launch: occupancy query reports %d\n", per_cu);
        (void)hipGetLastError();
        grid = cus;
    }
    if (grid < 0) return;
    if (hipMemsetAsync((char*)d_ws + WS_CTL, 0, CTL_ZERO_BYTES, stream) != hipSuccess) return;
    Args a{};
    for (int i = 0; i < 37; ++i) a.in[i] = (const float*)d_in[i];
    a.out = (float*)d_out; a.ws = (unsigned char*)d_ws;
    a.ph_lo = 0; a.ph_hi = NPHASE;
    hipLaunchKernelGGL(fwd, dim3(grid), dim3(NWAVES * 64), LDS_BYTES, stream, a);
}
```
